# Optimizing an MI355X kernel written in HIP

```python
import math
import jax, jax.numpy as jnp
from jax import lax
import numpy as np

D_MODEL = 1024
BATCH = 32
SEQ = 256
DEPTH = 4
DEC_BATCH = 2
DEC_SEQ = 4096
PAST_LEN = 512

GRID_W = 64
HEAD_DIM = 64
N_HEADS_NA = 8
N_HEADS_RWKV = 8
N_HEADS_DIFF = 8
D_NA = N_HEADS_NA * HEAD_DIM
D_RWKV = N_HEADS_RWKV * HEAD_DIM
D_DIFF = N_HEADS_DIFF * 2 * HEAD_DIM
NA_KH = 8
NA_KW = 16
DECAY_LORA = 64
ICL_LORA = 64
GATE_LORA = 128
P_RWKV = 3 * D_RWKV + DECAY_LORA + ICL_LORA + GATE_LORA
P_EVEN = 3 * D_NA + P_RWKV
RWKV_SPLITS = (D_RWKV, 2 * D_RWKV, 3 * D_RWKV, 3 * D_RWKV + DECAY_LORA, 3 * D_RWKV + DECAY_LORA + ICL_LORA)
D_FF = -(-(8 * D_MODEL) // (3 * 256)) * 256
N_EVEN = (DEPTH + 1) // 2
N_ODD = DEPTH // 2
Q_BLOCK = 128
ROPE_F = HEAD_DIM // 4
ROPE_BASE = 10000.0
NORM_EPS = 1e-6
GN_EPS = 64e-5

kernel_name = "hybrid_diffusion_na_rwkv7_diffattn_step"


def rmsnorm(x, g):
    xf = x.astype(jnp.float32)
    r = lax.rsqrt(jnp.mean(xf * xf, -1, keepdims=True) + NORM_EPS)
    return (xf * r).astype(x.dtype) * g


def adaln(cvec, w, b):
    m = jax.nn.silu(cvec) @ w + b
    return [t[:, None, :] for t in jnp.split(m, 6, axis=-1)]


def modulate(h, shift, scale):
    return h * (1.0 + scale) + shift


def swiglu(h, w1, w3, w2):
    return (jax.nn.silu(h @ w1) * (h @ w3)) @ w2


def centred_shift(y, mu):
    prev = jnp.pad(y[:, :-1], ((0, 0), (1, 0), (0, 0)))
    nxt = jnp.pad(y[:, 1:], ((0, 0), (0, 1), (0, 0)))
    return y + mu[0] * (prev - y) + mu[1] * (nxt - y)


def axial_rope(x):
    T = x.shape[1]
    t = jnp.arange(T)
    pos = jnp.stack([t // GRID_W, t % GRID_W], -1).astype(jnp.float32)
    inv = ROPE_BASE ** (-jnp.arange(ROPE_F, dtype=jnp.float32) / ROPE_F)
    ang = (pos[:, :, None] * inv).reshape((T,) + (1,) * (x.ndim - 3) + (2, ROPE_F))
    cos, sin = jnp.cos(ang).astype(x.dtype), jnp.sin(ang).astype(x.dtype)
    xr = x.reshape(x.shape[:-1] + (2, 2, ROPE_F))
    x1, x2 = xr[..., 0, :], xr[..., 1, :]
    return jnp.stack([x1 * cos - x2 * sin, x1 * sin + x2 * cos], axis=-2).reshape(x.shape)


def softmax_attn_blocked(q, k, v):
    B, T, H, d = q.shape
    qb = jnp.moveaxis(q.reshape(B, T // Q_BLOCK, Q_BLOCK, H, d), 1, 0)

    def blk(q_i):
        s = jnp.einsum('bqhd,bmhd->bhqm', q_i, k) * (d ** -0.5)
        p = jax.nn.softmax(s.astype(jnp.float32), axis=-1).astype(v.dtype)
        return jnp.einsum('bhqm,bmhd->bqhd', p, v)

    o = lax.map(blk, qb)
    return jnp.moveaxis(o, 0, 1).reshape(B, T, H * v.shape[-1])


def na_latent(q, k, v, k_ctx, v_ctx, rpb):
    B, T, H, d = q.shape
    rows = T // GRID_W
    kh = min(NA_KH, rows)
    kg = k.reshape(B, rows, GRID_W, H, d)
    vg = v.reshape(B, rows, GRID_W, H, d)
    cols = jnp.arange(GRID_W)
    c0 = jnp.clip(cols - NA_KW // 2, 0, GRID_W - NA_KW)
    col_idx = c0[:, None] + jnp.arange(NA_KW)[None, :]
    dc = col_idx - cols[:, None] + NA_KW - 1
    scale = d ** -0.5
    qg = jnp.moveaxis(q.reshape(B, rows, GRID_W, H, d), 1, 0)

    def row(args):
        i, q_i = args
        r0 = jnp.clip(i - kh // 2, 0, rows - kh)
        kb = lax.dynamic_slice_in_dim(kg, r0, kh, axis=1)[:, :, col_idx]
        vb = lax.dynamic_slice_in_dim(vg, r0, kh, axis=1)[:, :, col_idx]
        dr = r0 + jnp.arange(kh) - i + NA_KH - 1
        bias = rpb[:, dr[:, None, None], dc[None]].transpose(0, 2, 1, 3)
        s_loc = jnp.einsum('bjhd,brjchd->bhjrc', q_i, kb) * scale + bias[None]
        s_ctx = jnp.einsum('bjhd,bmhd->bhjm', q_i, k_ctx) * scale
        s = jnp.concatenate([s_loc.reshape(B, H, GRID_W, kh * NA_KW), s_ctx], axis=-1)
        p = jax.nn.softmax(s.astype(jnp.float32), axis=-1).astype(v.dtype)
        p_loc = p[..., :kh * NA_KW].reshape(B, H, GRID_W, kh, NA_KW)
        p_ctx = p[..., kh * NA_KW:]
        return (jnp.einsum('bhjrc,brjchd->bjhd', p_loc, vb)
                + jnp.einsum('bhjm,bmhd->bjhd', p_ctx, v_ctx))

    o = lax.map(row, (jnp.arange(rows), qg))
    return jnp.moveaxis(o, 0, 1).reshape(B, T, H * d)


def wkv7_scan(S0, r, decay, kk, a, v, kt, reverse):
    def step(S, inp):
        r_t, w_t, kk_t, a_t, v_t, kt_t = inp
        s_kk = jnp.einsum('bhvk,bhk->bhv', S, kk_t)
        S = (S * w_t[:, :, None, :] - s_kk[..., None] * (kk_t * a_t)[:, :, None, :]
             + v_t[..., None] * kt_t[:, :, None, :])
        return S, jnp.einsum('bhvk,bhk->bhv', S, r_t)

    xs = tuple(jnp.moveaxis(t.astype(jnp.float32), 1, 0) for t in (r, decay, kk, a, v, kt))
    S_fin, ys = lax.scan(step, S0.astype(jnp.float32), xs, reverse=reverse)
    return S_fin, jnp.moveaxis(ys, 0, 1)


def rwkv_mixer(u, S0, mu, w0, w2, a0, a2, k_k, k_a, bonus, g2, ln_w, ln_b):
    B, T, _ = u.shape
    heads = lambda t: t.reshape(B, T, N_HEADS_RWKV, HEAD_DIM)
    u = centred_shift(u, mu)
    r, k, v, w_lo, a_lo, g_lo = jnp.split(u, RWKV_SPLITS, axis=-1)
    rh, vh = heads(r), heads(v)
    kk = heads(k * k_k).astype(jnp.float32)
    kk = kk * lax.rsqrt(jnp.maximum(jnp.sum(kk * kk, -1, keepdims=True), 1e-12))
    ys, bon, finals = [], [], []
    for d in range(2):
        w_raw = (w0[d] + jnp.tanh(w_lo) @ w2[d]).astype(jnp.float32)
        decay = jnp.exp(-jnp.exp(-jax.nn.softplus(-w_raw) - 0.5))
        a = jax.nn.sigmoid(a0[d] + a_lo @ a2[d])
        kt = heads(k * (1.0 + (a - 1.0) * k_a))
        S_fin, y = wkv7_scan(S0[:, d], rh, heads(decay), kk, heads(a), vh, kt, reverse=(d == 1))
        ys.append(y)
        finals.append(S_fin)
        bon.append(jnp.sum(rh * kt * bonus[d], -1, keepdims=True) * vh)
    y = ys[0] + ys[1]
    mean = jnp.mean(y, -1, keepdims=True)
    var = jnp.mean(jnp.square(y - mean), -1, keepdims=True)
    yn = ((y - mean) * lax.rsqrt(var + GN_EPS)).reshape(B, T, D_RWKV).astype(u.dtype) * ln_w + ln_b
    out = (yn + (bon[0] + bon[1]).reshape(B, T, D_RWKV)) * (jax.nn.sigmoid(g_lo) @ g2)
    return out, jnp.stack(finals, axis=1)


def even_mixer(h, w_in, w_out, rpb, rw, na_ctx=None, S0=None):
    B, T, _ = h.shape
    proj = h @ w_in
    qa, ka, va, u = jnp.split(proj, [D_NA, 2 * D_NA, 3 * D_NA], axis=-1)
    heads = lambda t: t.reshape(B, T, N_HEADS_NA, HEAD_DIM)
    qa, ka, va = heads(qa), heads(ka), heads(va)
    if na_ctx is None:
        o_na = softmax_attn_blocked(qa, ka, va)
        S0 = jnp.zeros((B, 2, N_HEADS_RWKV, HEAD_DIM, HEAD_DIM), jnp.float32)
    else:
        o_na = na_latent(qa, ka, va, na_ctx[0], na_ctx[1], rpb)
    o_rw, S_fin = rwkv_mixer(u, S0, *rw)
    y = jnp.concatenate([o_na, o_rw], axis=-1) @ w_out
    return y, ka, va, S_fin


def diff_attn_blocked(q, k, v, lam):
    B, T, H, _, d = q.shape
    qb = jnp.moveaxis(q.reshape(B, T // Q_BLOCK, Q_BLOCK, H, 2, d), 1, 0)

    def blk(q_i):
        s = jnp.einsum('bqhsd,bmhsd->bhsqm', q_i, k) * (d ** -0.5)
        p = jax.nn.softmax(s.astype(jnp.float32), axis=-1)
        att = (p[:, :, 0] - lam * p[:, :, 1]).astype(v.dtype)
        return jnp.einsum('bhqm,bmhe->bqhe', att, v)

    o = lax.map(blk, qb)
    return jnp.moveaxis(o, 0, 1).reshape(B, T, H, v.shape[-1])


def odd_mixer(h, w_qkv, w_out, lam_q, lam_k, subln, lam_init, diff_ctx=None):
    B, T, _ = h.shape
    q, k, v = jnp.split(h @ w_qkv, 3, axis=-1)
    q = q.reshape(B, T, N_HEADS_DIFF, 2, HEAD_DIM)
    k = k.reshape(B, T, N_HEADS_DIFF, 2, HEAD_DIM)
    v = v.reshape(B, T, N_HEADS_DIFF, 2 * HEAD_DIM)
    lq, lk = lam_q.astype(jnp.float32), lam_k.astype(jnp.float32)
    lam = jnp.exp(jnp.sum(lq[0] * lk[0])) - jnp.exp(jnp.sum(lq[1] * lk[1])) + lam_init
    k_cache = k.reshape(B, T, N_HEADS_DIFF, 2 * HEAD_DIM)
    if diff_ctx is None:
        k_all, v_all = k, v
    else:
        M = diff_ctx[0].shape[1]
        q, k = axial_rope(q), axial_rope(k)
        k_all = jnp.concatenate([diff_ctx[0].reshape(B, M, N_HEADS_DIFF, 2, HEAD_DIM), k], axis=1)
        v_all = jnp.concatenate([diff_ctx[1], v], axis=1)
    o = diff_attn_blocked(q, k_all, v_all, lam)
    o = rmsnorm(o, subln) * (1.0 - lam_init)
    y = o.reshape(B, T, D_DIFF) @ w_out
    return y, k_cache, v


def setup_inputs(seed: int = 0) -> dict:
    key = jax.random.key(seed)
    ks = iter(jax.random.split(key, 48))
    nrm = lambda shape, s: jax.random.normal(next(ks), shape, jnp.float32) * s
    gain = lambda shape: 1.0 + nrm(shape, 0.02)
    D = D_MODEL
    return {
        'x_prompt': nrm((BATCH, SEQ, D), 1.0),
        'x_sample': nrm((DEC_BATCH, DEC_SEQ, D), 1.0),
        'c': nrm((DEC_BATCH, D), 1.0),
        'cache_na_k': nrm((DEC_BATCH, N_EVEN, PAST_LEN, N_HEADS_NA, HEAD_DIM), 1.0),
        'cache_na_v': nrm((DEC_BATCH, N_EVEN, PAST_LEN, N_HEADS_NA, HEAD_DIM), 1.0),
        'state_rwkv': nrm((DEC_BATCH, N_EVEN, 2, N_HEADS_RWKV, HEAD_DIM, HEAD_DIM), 0.3),
        'cache_diff_k': nrm((DEC_BATCH, N_ODD, PAST_LEN, N_HEADS_DIFF, 2 * HEAD_DIM), 1.0),
        'cache_diff_v': nrm((DEC_BATCH, N_ODD, PAST_LEN, N_HEADS_DIFF, 2 * HEAD_DIM), 1.0),
        'c_ctx': nrm((D,), 1.0),
        'w_ada': nrm((DEPTH, D, 6 * D), D ** -0.5),
        'b_ada': nrm((DEPTH, 6 * D), 0.02),
        'norm_mix': gain((DEPTH, D)),
        'norm_ffn': gain((DEPTH, D)),
        'norm_final': gain((D,)),
        'w_in_even': nrm((N_EVEN, D, P_EVEN), D ** -0.5),
        'w_out_even': nrm((N_EVEN, D_NA + D_RWKV, D), (D_NA + D_RWKV) ** -0.5),
        'na_rpb': nrm((N_EVEN, N_HEADS_NA, 2 * NA_KH - 1, 2 * NA_KW - 1), 0.1),
        'rw_mu': jax.random.uniform(next(ks), (N_EVEN, 2, P_RWKV), jnp.float32, 0.0, 0.5),
        'rw_w0': nrm((N_EVEN, 2, D_RWKV), 0.5),
        'rw_w2': nrm((N_EVEN, 2, DECAY_LORA, D_RWKV), 0.1),
        'rw_a0': nrm((N_EVEN, 2, D_RWKV), 0.1),
        'rw_a2': nrm((N_EVEN, 2, ICL_LORA, D_RWKV), 0.1),
        'rw_kk': 0.85 + nrm((N_EVEN, D_RWKV), 0.02),
        'rw_ka': gain((N_EVEN, D_RWKV)),
        'rw_bonus': nrm((N_EVEN, 2, N_HEADS_RWKV, HEAD_DIM), 0.1),
        'rw_g2': nrm((N_EVEN, GATE_LORA, D_RWKV), GATE_LORA ** -0.5),
        'rw_lnw': gain((N_EVEN, D_RWKV)),
        'rw_lnb': nrm((N_EVEN, D_RWKV), 0.02),
        'w_qkv_diff': nrm((N_ODD, D, 3 * D_DIFF), D ** -0.5),
        'w_out_diff': nrm((N_ODD, D_DIFF, D), D_DIFF ** -0.5),
        'diff_lam_q': nrm((N_ODD, 2, HEAD_DIM), 0.1),
        'diff_lam_k': nrm((N_ODD, 2, HEAD_DIM), 0.1),
        'diff_subln': gain((N_ODD, 2 * HEAD_DIM)),
        'ffn_w1': nrm((DEPTH, D, D_FF), D ** -0.5),
        'ffn_w3': nrm((DEPTH, D, D_FF), D ** -0.5),
        'ffn_w2': nrm((DEPTH, D_FF, D), D_FF ** -0.5),
    }


def reference(x_prompt, x_sample, c, cache_na_k, cache_na_v, state_rwkv, cache_diff_k, cache_diff_v,
              c_ctx, w_ada, b_ada, norm_mix, norm_ffn, norm_final, w_in_even, w_out_even, na_rpb,
              rw_mu, rw_w0, rw_w2, rw_a0, rw_a2, rw_kk, rw_ka, rw_bonus, rw_g2, rw_lnw, rw_lnb,
              w_qkv_diff, w_out_diff, diff_lam_q, diff_lam_k, diff_subln, ffn_w1, ffn_w3, ffn_w2):
    xp, xs = x_prompt, x_sample
    na_k_out, na_v_out, rw_out, dk_out, dv_out = [], [], [], [], []
    for l in range(DEPTH):
        mp = adaln(c_ctx[None, :], w_ada[l], b_ada[l])
        ms = adaln(c, w_ada[l], b_ada[l])
        hp = modulate(rmsnorm(xp, norm_mix[l]), mp[0], mp[1])
        hs = modulate(rmsnorm(xs, norm_mix[l]), ms[0], ms[1])
        if l % 2 == 0:
            e = l // 2
            rw = (rw_mu[e], rw_w0[e], rw_w2[e], rw_a0[e], rw_a2[e], rw_kk[e], rw_ka[e],
                  rw_bonus[e], rw_g2[e], rw_lnw[e], rw_lnb[e])
            yp, kp, vp, Sp = even_mixer(hp, w_in_even[e], w_out_even[e], na_rpb[e], rw)
            ys, _, _, _ = even_mixer(hs, w_in_even[e], w_out_even[e], na_rpb[e], rw,
                                     (cache_na_k[:, e], cache_na_v[:, e]), state_rwkv[:, e])
            na_k_out.append(kp)
            na_v_out.append(vp)
            rw_out.append(Sp)
        else:
            o = l // 2
            lam_init = 0.8 - 0.6 * math.exp(-0.3 * l)
            dp = (w_qkv_diff[o], w_out_diff[o], diff_lam_q[o], diff_lam_k[o], diff_subln[o], lam_init)
            yp, kp, vp = odd_mixer(hp, *dp)
            ys, _, _ = odd_mixer(hs, *dp, (cache_diff_k[:, o], cache_diff_v[:, o]))
            dk_out.append(kp)
            dv_out.append(vp)
        xp = xp + mp[2] * yp
        xs = xs + ms[2] * ys
        xp = xp + mp[5] * swiglu(modulate(rmsnorm(xp, norm_ffn[l]), mp[3], mp[4]), ffn_w1[l], ffn_w3[l], ffn_w2[l])
        xs = xs + ms[5] * swiglu(modulate(rmsnorm(xs, norm_ffn[l]), ms[3], ms[4]), ffn_w1[l], ffn_w3[l], ffn_w2[l])
    y_prompt = rmsnorm(xp, norm_final)
    y_sample = rmsnorm(xs, norm_final)
    new_na_k = jnp.stack(na_k_out, axis=1)
    new_na_v = jnp.stack(na_v_out, axis=1)
    new_state_rwkv = jnp.stack(rw_out, axis=1)
    new_diff_k = jnp.stack(dk_out, axis=1)
    new_diff_v = jnp.stack(dv_out, axis=1)
    return (y_prompt, y_sample, new_na_k, new_na_v, new_state_rwkv, new_diff_k, new_diff_v)
```

```cpp
#include <hip/hip_runtime.h>
#include <hip/hip_cooperative_groups.h>
#include <cstdio>
namespace cg = cooperative_groups;

typedef unsigned short u16;
typedef __attribute__((ext_vector_type(8))) short bf16x8;
typedef __attribute__((ext_vector_type(4))) float f32x4;
typedef __attribute__((ext_vector_type(4))) unsigned u32x4;
typedef __attribute__((ext_vector_type(2))) unsigned u32x2;

#define NTOK 16384
#define NCTX 8192
#define OUT_NAK 16777216L
#define OUT_NAV 25165824L
#define OUT_ST  33554432L
#define OUT_DK  37748736L
#define OUT_DV  54525952L
#define WS_WIN   0L
#define WS_WOE   13631488L
#define WS_WQKV  17825792L
#define WS_WOD   30408704L
#define WS_W13   34603008L
#define WS_W2    80740352L
#define WS_CNK   103809024L
#define WS_CNV   105906176L
#define WS_CDK   108003328L
#define WS_CDV   112197632L
#define WS_MOD   116391936L
#define WS_ROWSS 116686848L
#define WS_RKB   117735424L
#define WS_MIX   118784000L
#define WS_BIG   152338432L
#define WS_TB    261390336L
#define WS_QT    328499200L
#define WS_END   395608064L
#define WS_BAR   395624448L
#define WS_WT    395640832L
#define WS_TOTAL 396165120L

struct P {
  const float* in[36];
  float* out;
  char* ws;
};

#define SMEM_BYTES 61440

typedef __attribute__((ext_vector_type(2))) float f32x2_t;
typedef __attribute__((ext_vector_type(2))) __bf16 bf16x2_t;
__device__ __forceinline__ u16 f2bf(float f) { return __builtin_bit_cast(u16, (__bf16)f); }
__device__ __forceinline__ float bf2f(u16 h) { return __uint_as_float(((unsigned)h) << 16); }
__device__ __forceinline__ unsigned pack2(float a, float b) {
  const f32x2_t v = {a, b};
  return __builtin_bit_cast(unsigned, __builtin_convertvector(v, bf16x2_t));
}
template <int CTRL>
__device__ __forceinline__ float dpp_mov(float v) {
  return __int_as_float(__builtin_amdgcn_update_dpp(0, __float_as_int(v), CTRL, 0xf, 0xf, false));
}
__device__ __forceinline__ float g16_sum(float v) {
  v += dpp_mov<0xB1>(v);
  v += dpp_mov<0x4E>(v);
  v += dpp_mov<0x124>(v);
  v += dpp_mov<0x128>(v);
  return v;
}
__device__ __forceinline__ float g16_max(float v) {
  v = fmaxf(v, dpp_mov<0xB1>(v));
  v = fmaxf(v, dpp_mov<0x4E>(v));
  v = fmaxf(v, dpp_mov<0x124>(v));
  v = fmaxf(v, dpp_mov<0x128>(v));
  return v;
}
__device__ __forceinline__ float wave_sum(float v) {
  v = g16_sum(v);
  const float r0 = __int_as_float(__builtin_amdgcn_readlane(__float_as_int(v), 0));
  const float r1 = __int_as_float(__builtin_amdgcn_readlane(__float_as_int(v), 16));
  const float r2 = __int_as_float(__builtin_amdgcn_readlane(__float_as_int(v), 32));
  const float r3 = __int_as_float(__builtin_amdgcn_readlane(__float_as_int(v), 48));
  return (r0 + r1) + (r2 + r3);
}
__device__ __forceinline__ int otid() { int t = threadIdx.x; asm volatile("" : "+v"(t)); return t; }
__device__ __forceinline__ float sigmoidf_(float x) { return __builtin_amdgcn_rcpf(1.f + __expf(-x)); }

struct ConvT { const float* src; u16* dst; int K, N, mode, kt, nt; };
__device__ __forceinline__ ConvT conv_params(const P& p, int job) {
  ConvT c;
  if (job < 1664) {
    int e = job / 832, r = job % 832;
    c.src = p.in[14] + (long)e * 1024 * 3328; c.K = 1024; c.N = 3328; c.dst = (u16*)(p.ws + WS_WIN) + (long)e * 3328 * 1024; c.mode = 0; c.kt = r / 52; c.nt = r % 52;
    return c;
  }
  job -= 1664;
  if (job < 512) {
    int e = job / 256, r = job % 256;
    c.src = p.in[15] + (long)e * 1024 * 1024; c.K = 1024; c.N = 1024; c.dst = (u16*)(p.ws + WS_WOE) + (long)e * 1024 * 1024; c.mode = 0; c.kt = r / 16; c.nt = r % 16;
    return c;
  }
  job -= 512;
  if (job < 1536) {
    int e = job / 768, r = job % 768;
    c.src = p.in[28] + (long)e * 1024 * 3072; c.K = 1024; c.N = 3072; c.dst = (u16*)(p.ws + WS_WQKV) + (long)e * 3072 * 1024; c.mode = 0; c.kt = r / 48; c.nt = r % 48;
    return c;
  }
  job -= 1536;
  if (job < 512) {
    int e = job / 256, r = job % 256;
    c.src = p.in[29] + (long)e * 1024 * 1024; c.K = 1024; c.N = 1024; c.dst = (u16*)(p.ws + WS_WOD) + (long)e * 1024 * 1024; c.mode = 0; c.kt = r / 16; c.nt = r % 16;
    return c;
  }
  job -= 512;
  if (job < 2816) {
    int l = job / 704, r = job % 704;
    c.src = p.in[33] + (long)l * 1024 * 2816; c.K = 1024; c.N = 2816; c.dst = (u16*)(p.ws + WS_W13) + (long)l * 5632 * 1024; c.mode = 1; c.kt = r / 44; c.nt = r % 44;
    return c;
  }
  job -= 2816;
  if (job < 2816) {
    int l = job / 704, r = job % 704;
    c.src = p.in[34] + (long)l * 1024 * 2816; c.K = 1024; c.N = 2816; c.dst = (u16*)(p.ws + WS_W13) + (long)l * 5632 * 1024; c.mode = 2; c.kt = r / 44; c.nt = r % 44;
    return c;
  }
  job -= 2816;
  {
    int l = job / 704, r = job % 704;
    c.src = p.in[35] + (long)l * 2816 * 1024; c.K = 2816; c.N = 1024; c.dst = (u16*)(p.ws + WS_W2) + (long)l * 1024 * 2816; c.mode = 0; c.kt = r / 16; c.nt = r % 16;
  }
  return c;
}
__device__ __forceinline__ void conv_job(const P& p, char* smem, int job2) {
  const int tid = otid();
  float* tile = (float*)smem;
  ConvT c[2];
  c[0] = conv_params(p, 2 * job2);
  c[1] = conv_params(p, 2 * job2 + 1);
  float v[2][16];
#pragma unroll
  for (int t = 0; t < 2; ++t)
#pragma unroll
    for (int i = 0; i < 16; ++i) {
      const int kl = (tid >> 6) + 4 * i, nl = tid & 63;
      v[t][i] = c[t].src[(long)(c[t].kt * 64 + kl) * c[t].N + c[t].nt * 64 + nl];
    }
  __syncthreads();
#pragma unroll
  for (int t = 0; t < 2; ++t)
#pragma unroll
    for (int i = 0; i < 16; ++i) {
      const int kl = (tid >> 6) + 4 * i, nl = tid & 63;
      tile[t * 4160 + kl * 65 + nl] = v[t][i];
    }
  __syncthreads();
#pragma unroll
  for (int t = 0; t < 2; ++t)
#pragma unroll
    for (int i = 0; i < 2; ++i) {
      const int task = tid + 256 * i;
      const int kg = task & 7, nl = task >> 3;
      const int n = c[t].nt * 64 + nl;
      int nd = n;
      if (c[t].mode == 1) nd = (n >> 5) * 64 + (n & 31);
      else if (c[t].mode == 2) nd = (n >> 5) * 64 + 32 + (n & 31);
      const float* tt = tile + t * 4160;
      u32x4 o;
      o.x = pack2(tt[(kg * 8 + 0) * 65 + nl], tt[(kg * 8 + 1) * 65 + nl]);
      o.y = pack2(tt[(kg * 8 + 2) * 65 + nl], tt[(kg * 8 + 3) * 65 + nl]);
      o.z = pack2(tt[(kg * 8 + 4) * 65 + nl], tt[(kg * 8 + 5) * 65 + nl]);
      o.w = pack2(tt[(kg * 8 + 6) * 65 + nl], tt[(kg * 8 + 7) * 65 + nl]);
      *(u32x4*)(c[t].dst + (long)nd * c[t].K + c[t].kt * 64 + kg * 8) = o;
    }
}
#define N_CONV_JOBS 6336

__device__ __forceinline__ void adaln_job(const P& p, char* smem, int job) {
  const int l = job / 96, cgp = job % 96;
  const int tid = otid();
  float* sil = (float*)smem;
  float* red = sil + 3072;
  __syncthreads();
  for (int i = tid; i < 3072; i += 256) {
    int v = i >> 10, k = i & 1023;
    float c = (v == 0) ? p.in[8][k] : p.in[2][(v - 1) * 1024 + k];
    sil[i] = c * sigmoidf_(c);
  }
  __syncthreads();
  const int kq = tid >> 6, cl = tid & 63;
  const float* w = p.in[9] + (long)l * 1024 * 6144 + cgp * 64 + cl;
  float a0 = 0.f, a1 = 0.f, a2 = 0.f;
#pragma unroll 16
  for (int k = kq * 256; k < kq * 256 + 256; ++k) {
    float wv = w[(long)k * 6144];
    a0 += sil[k] * wv; a1 += sil[1024 + k] * wv; a2 += sil[2048 + k] * wv;
  }
  red[(kq * 3 + 0) * 64 + cl] = a0; red[(kq * 3 + 1) * 64 + cl] = a1; red[(kq * 3 + 2) * 64 + cl] = a2;
  __syncthreads();
  if (tid < 192) {
    int v = tid >> 6;
    float s = red[(0 * 3 + v) * 64 + cl] + red[(1 * 3 + v) * 64 + cl] + red[(2 * 3 + v) * 64 + cl] + red[(3 * 3 + v) * 64 + cl];
    s += p.in[10][l * 6144 + cgp * 64 + cl];
    ((float*)(p.ws + WS_MOD))[(l * 3 + v) * 6144 + cgp * 64 + cl] = s;
  }
}

__device__ __forceinline__ void cachecvt_job(const P& p, int job) {
  const float* src; u16* dst; int j;
  if (job < 512) { src = p.in[3]; dst = (u16*)(p.ws + WS_CNK); j = job; }
  else if (job < 1024) { src = p.in[4]; dst = (u16*)(p.ws + WS_CNV); j = job - 512; }
  else if (job < 2048) { src = p.in[6]; dst = (u16*)(p.ws + WS_CDK); j = job - 1024; }
  else { src = p.in[7]; dst = (u16*)(p.ws + WS_CDV); j = job - 2048; }
  long off = (long)j * 2048 + otid() * 8;
  float4 a = *(const float4*)(src + off), b = *(const float4*)(src + off + 4);
  uint4 v; v.x = pack2(a.x, a.y); v.y = pack2(a.z, a.w); v.z = pack2(b.x, b.y); v.w = pack2(b.z, b.w);
  *(uint4*)(dst + off) = v;
}


__device__ __forceinline__ void loracvt_job(const P& p, int job) {
  u16* dst = (u16*)(p.ws + WS_WT);
#pragma unroll
  for (int i = 0; i < 8; ++i) {
    const int g = job * 2048 + i * 256 + otid();
    const int k = g & 63, n = (g >> 6) & 511, mat = (g >> 15) & 1, ed = g >> 16;
    const float* src = mat ? p.in[21] : p.in[19];
    dst[g] = f2bf(src[((long)ed * 64 + k) * 512 + n]);
  }
}

__device__ __forceinline__ void xcopy_job(const P& p, int job) {
  const int row = job * 4 + (otid() >> 6), lane = otid() & 63;
  const float* src = (row < NCTX) ? p.in[0] + (long)row * 1024 : p.in[1] + (long)(row - NCTX) * 1024;
  float* dst = p.out + (long)row * 1024;
  float ss = 0.f;
#pragma unroll
  for (int i = 0; i < 4; ++i) {
    float4 v = *(const float4*)(src + (i * 64 + lane) * 4);
    ss += v.x * v.x + v.y * v.y + v.z * v.z + v.w * v.w;
    *(float4*)(dst + (i * 64 + lane) * 4) = v;
  }
}

template <int AM, int EPI, int BM>
__device__ __forceinline__ void gemm_phase(const P& p, char* smem, const void* Aptr, int K, const u16* Bt, int N,
                           const float* gvec, const float* modl, int shift_idx, int gate_idx, int sub, u16* dst) {
  const int tid = otid(), lane = tid & 63, wave = tid >> 6, wm = wave >> 1, wn = wave & 1;
  const int quad = lane >> 4, l16 = lane & 15;
  u16* As = (u16*)smem;
  u16* Bs = As + BM * 80;
  constexpr int MI = BM / 32;
  const int NT = N >> 7, ntiles = (16384 / BM) * NT, ntk = K >> 6;
  float* X = p.out;
  const float* rowss = (const float*)(p.ws + WS_ROWSS);
  const int MPX = (16384 / BM) / 8, LB = gridDim.x >> 3, xcd = blockIdx.x & 7;
  (void)ntiles;
  for (int lt = blockIdx.x >> 3; lt < MPX * NT; lt += LB) {
    const int mt = xcd * MPX + lt % MPX, nt = lt / MPX;
    const int row0 = mt * BM, col0 = nt * 128;
    const int grp = row0 < NCTX ? 0 : 1 + ((row0 - NCTX) >> 12);
    const float* modv = modl + grp * 6144;
    f32x4 acc[MI][4];
#pragma unroll
    for (int i = 0; i < MI; ++i)
#pragma unroll
      for (int j = 0; j < 4; ++j) acc[i][j] = (f32x4){0.f, 0.f, 0.f, 0.f};
    f32x4 ar[8]; u32x4 ab[MI]; u32x4 bb[4]; float rinv[8];
    if (AM == 1) {
#pragma unroll
      for (int i = 0; i < 8; ++i) {
        const float4* rp = (const float4*)(rowss + (long)(row0 + (tid >> 4) + 16 * i) * 16);
        float4 s0 = rp[0], s1 = rp[1], s2 = rp[2], s3 = rp[3];
        float s = (s0.x + s0.y + s0.z + s0.w) + (s1.x + s1.y + s1.z + s1.w) + (s2.x + s2.y + s2.z + s2.w) + (s3.x + s3.y + s3.z + s3.w);
        rinv[i] = rsqrtf(s * (1.f / 1024.f) + 1e-6f);
      }
    }
    if (AM == 1) {
#pragma unroll
      for (int i = 0; i < 8; ++i)
        ar[i] = *(const f32x4*)((const float*)Aptr + (long)(row0 + (tid >> 4) + 16 * i) * 1024 + (tid & 15) * 4);
    } else {
#pragma unroll
      for (int i = 0; i < MI; ++i)
        ab[i] = *(const u32x4*)((const u16*)Aptr + (long)(row0 + (tid >> 3) + 32 * i) * K + (tid & 7) * 8);
    }
#pragma unroll
    for (int i = 0; i < 4; ++i)
      bb[i] = *(const u32x4*)(Bt + (long)(col0 + (tid >> 3) + 32 * i) * K + (tid & 7) * 8);

    for (int kt = 0; kt < ntk; ++kt) {
      __syncthreads();
      if (AM == 1) {
        const int k = kt * 64 + (tid & 15) * 4;
        float4 g = *(const float4*)(gvec + k);
        float4 sc = *(const float4*)(modv + (shift_idx + 1) * 1024 + k);
        float4 sh = *(const float4*)(modv + shift_idx * 1024 + k);
        g.x *= (1.f + sc.x); g.y *= (1.f + sc.y); g.z *= (1.f + sc.z); g.w *= (1.f + sc.w);
#pragma unroll
        for (int i = 0; i < 8; ++i) {
          float r = rinv[i];
          u32x2 v;
          v.x = pack2(ar[i].x * r * g.x + sh.x, ar[i].y * r * g.y + sh.y);
          v.y = pack2(ar[i].z * r * g.z + sh.z, ar[i].w * r * g.w + sh.w);
          *(u32x2*)(As + ((tid >> 4) + 16 * i) * 80 + (tid & 15) * 4) = v;
        }
      } else {
#pragma unroll
        for (int i = 0; i < MI; ++i) *(u32x4*)(As + ((tid >> 3) + 32 * i) * 80 + (tid & 7) * 8) = ab[i];
      }
#pragma unroll
      for (int i = 0; i < 4; ++i) *(u32x4*)(Bs + ((tid >> 3) + 32 * i) * 80 + (tid & 7) * 8) = bb[i];
      __syncthreads();
      if (kt + 1 < ntk) {
        const int kn = (kt + 1) * 64;
        if (AM == 1) {
#pragma unroll
          for (int i = 0; i < 8; ++i)
            ar[i] = *(const f32x4*)((const float*)Aptr + (long)(row0 + (tid >> 4) + 16 * i) * 1024 + kn + (tid & 15) * 4);
        } else {
#pragma unroll
          for (int i = 0; i < MI; ++i)
            ab[i] = *(const u32x4*)((const u16*)Aptr + (long)(row0 + (tid >> 3) + 32 * i) * K + kn + (tid & 7) * 8);
        }
#pragma unroll
        for (int i = 0; i < 4; ++i)
          bb[i] = *(const u32x4*)(Bt + (long)(col0 + (tid >> 3) + 32 * i) * K + kn + (tid & 7) * 8);
      }
      __builtin_amdgcn_sched_barrier(0);
#pragma unroll
      for (int ks = 0; ks < 2; ++ks) {
        bf16x8 b[4];
#pragma unroll
        for (int i = 0; i < 4; ++i) b[i] = *(const bf16x8*)(Bs + (wn * 64 + i * 16 + l16) * 80 + ks * 32 + quad * 8);
#pragma unroll
        for (int i = 0; i < MI; ++i) {
          const bf16x8 a = *(const bf16x8*)(As + (wm * (BM / 2) + i * 16 + l16) * 80 + ks * 32 + quad * 8);
#pragma unroll
          for (int j = 0; j < 4; ++j) acc[i][j] = __builtin_amdgcn_mfma_f32_16x16x32_bf16(b[j], a, acc[i][j], 0, 0, 0);
        }
      }
    }
    const int cw = col0 + wn * 64;
    if (EPI == 0) {
      const int e = sub;
#pragma unroll
      for (int mi = 0; mi < MI; ++mi) {
        const int row = row0 + wm * (BM / 2) + mi * 16 + l16;
#pragma unroll
        for (int ni = 0; ni < 4; ++ni) {
          const int col = cw + ni * 16 + quad * 4;
          const f32x4 v = acc[mi][ni];
          u32x2 o; o.x = pack2(v[0], v[1]); o.y = pack2(v[2], v[3]);
          *(u32x2*)(dst + (long)row * 3328 + col) = o;
          if (row < NCTX && cw >= 512 && cw < 1536) {
            const int b = row >> 8, t = row & 255;
            if (cw < 1024) *(f32x4*)(p.out + OUT_NAK + ((long)((b * 2 + e) * 256 + t)) * 512 + col - 512) = v;
            else *(f32x4*)(p.out + OUT_NAV + ((long)((b * 2 + e) * 256 + t)) * 512 + col - 1024) = v;
          }
        }
      }
    } else if (EPI == 1) {
      const int o = sub;
      float inv[4];
#pragma unroll
      for (int j = 0; j < 4; ++j) inv[j] = exp2f(-(float)(quad * 4 + j) * (13.287712379549449f / 16.f));
#pragma unroll
      for (int mi = 0; mi < MI; ++mi) {
        const int row = row0 + wm * (BM / 2) + mi * 16 + l16;
        f32x4 v0 = acc[mi][0], v1 = acc[mi][1], v2 = acc[mi][2], v3 = acc[mi][3];
        if (row >= NCTX && cw < 2048) {
          const int tp = (row - NCTX) & 4095;
#pragma unroll
          for (int j = 0; j < 4; ++j) {
            const float a0 = (float)(tp >> 6) * inv[j], a1 = (float)(tp & 63) * inv[j];
            const float c0 = __cosf(a0), s0 = __sinf(a0), c1 = __cosf(a1), s1 = __sinf(a1);
            const float n0 = v0[j] * c0 - v1[j] * s0, n1 = v0[j] * s0 + v1[j] * c0;
            const float n2 = v2[j] * c1 - v3[j] * s1, n3 = v2[j] * s1 + v3[j] * c1;
            v0[j] = n0; v1[j] = n1; v2[j] = n2; v3[j] = n3;
          }
        }
        f32x4 vv[4] = {v0, v1, v2, v3};
#pragma unroll
        for (int ni = 0; ni < 4; ++ni) {
          const int col = cw + ni * 16 + quad * 4;
          u32x2 ob; ob.x = pack2(vv[ni][0], vv[ni][1]); ob.y = pack2(vv[ni][2], vv[ni][3]);
          *(u32x2*)(dst + (long)row * 3072 + col) = ob;
          if (row < NCTX && cw >= 1024) {
            const int b = row >> 8, t = row & 255;
            if (cw < 2048) *(f32x4*)(p.out + OUT_DK + ((long)((b * 2 + o) * 256 + t)) * 1024 + col - 1024) = vv[ni];
            else *(f32x4*)(p.out + OUT_DV + ((long)((b * 2 + o) * 256 + t)) * 1024 + col - 2048) = vv[ni];
          }
        }
      }
    } else if (EPI == 2) {
      f32x4 gt[4];
#pragma unroll
      for (int ni = 0; ni < 4; ++ni) gt[ni] = *(const f32x4*)(modv + gate_idx * 1024 + cw + ni * 16 + quad * 4);
#pragma unroll
      for (int mi = 0; mi < MI; ++mi) {
        const int row = row0 + wm * (BM / 2) + mi * 16 + l16;
#pragma unroll
        for (int ni = 0; ni < 4; ++ni) {
          f32x4* xp = (f32x4*)(X + (long)row * 1024 + cw + ni * 16 + quad * 4);
          *xp = *xp + gt[ni] * acc[mi][ni];
        }
      }
    } else {
#pragma unroll
      for (int mi = 0; mi < MI; ++mi) {
        const int row = row0 + wm * (BM / 2) + mi * 16 + l16;
#pragma unroll
        for (int ni = 0; ni < 2; ++ni) {
          const f32x4 a = acc[mi][ni], b = acc[mi][ni + 2];
          u32x2 ob;
          ob.x = pack2(a[0] * sigmoidf_(a[0]) * b[0], a[1] * sigmoidf_(a[1]) * b[1]);
          ob.y = pack2(a[2] * sigmoidf_(a[2]) * b[2], a[3] * sigmoidf_(a[3]) * b[3]);
          *(u32x2*)(dst + (long)row * 2816 + (cw >> 1) + ni * 16 + quad * 4) = ob;
        }
      }
    }
  }
}

__device__ __forceinline__ unsigned cvt_pk_bf16(float lo, float hi) { return pack2(lo, hi); }
typedef __attribute__((ext_vector_type(2))) unsigned u32pair_t;
__device__ __forceinline__ float xq_max(float v) {
  const unsigned x = __float_as_uint(v);
  const u32pair_t r = __builtin_amdgcn_permlane16_swap(x, x, false, false);
  const float m = fmaxf(__uint_as_float(r.x), __uint_as_float(r.y));
  const unsigned y = __float_as_uint(m);
  const u32pair_t q = __builtin_amdgcn_permlane32_swap(y, y, false, false);
  return fmaxf(__uint_as_float(q.x), __uint_as_float(q.y));
}
__device__ __forceinline__ float xq_sum(float v) {
  const unsigned x = __float_as_uint(v);
  const u32pair_t r = __builtin_amdgcn_permlane16_swap(x, x, false, false);
  const float m = __uint_as_float(r.x) + __uint_as_float(r.y);
  const unsigned y = __float_as_uint(m);
  const u32pair_t q = __builtin_amdgcn_permlane32_swap(y, y, false, false);
  return __uint_as_float(q.x) + __uint_as_float(q.y);
}
template <int NS, int DV, bool LOCAL>
__device__ __forceinline__ void attn_job(char* smem, const u16* qp, int qst,
                         const u16* k0, const u16* v0, int st0, int n0,
                         const u16* k1, const u16* v1, int st1, int n1,
                         const float* rpbh, int qi, int r0,
                         float lam, float outscale, const float* subln,
                         u16* op, int ost) {
  constexpr int KD = NS * 64, KST = KD + 16, KCH = KD / 8;
  u16* Ks = (u16*)smem;
  u16* Vt = Ks + 64 * KST;
  u16* Ps = Vt + DV * 80;
  const int tid = otid(), lane = tid & 63, wave = tid >> 6, quad = lane >> 4, l16 = lane & 15;
  constexpr float C2 = 0.125f * 1.4426950408889634f;
  bf16x8 qf[NS][2];
#pragma unroll
  for (int s = 0; s < NS; ++s)
#pragma unroll
    for (int ks = 0; ks < 2; ++ks)
      qf[s][ks] = *(const bf16x8*)(qp + (long)(wave * 16 + l16) * qst + s * 64 + ks * 32 + quad * 8);
  float m[NS], l[NS];
  f32x4 O[NS][DV / 16];
#pragma unroll
  for (int s = 0; s < NS; ++s) {
    m[s] = -1e30f; l[s] = 0.f;
#pragma unroll
    for (int n = 0; n < DV / 16; ++n) O[s][n] = (f32x4){0.f, 0.f, 0.f, 0.f};
  }
  const int jq = wave * 16 + l16;
  int c0 = jq - 8; c0 = c0 < 0 ? 0 : (c0 > 48 ? 48 : c0);
  const int nt0 = n0 >> 6, ntot = nt0 + (n1 >> 6);
  constexpr int KPT = (64 * KCH) / 256;
  constexpr int VPT = ((DV / 2) * 8) / 256;
  u32x4 kreg[KPT];
  unsigned vreg[VPT][8];
  auto load_tile = [&](int t) {
    const u16 *kp, *vp; int st;
    if (t < nt0) { kp = k0 + (long)t * 64 * st0; vp = v0 + (long)t * 64 * st0; st = st0; }
    else { kp = k1 + (long)(t - nt0) * 64 * st1; vp = v1 + (long)(t - nt0) * 64 * st1; st = st1; }
#pragma unroll
    for (int i = 0; i < KPT; ++i) {
      const int c = tid + 256 * i;
      kreg[i] = *(const u32x4*)(kp + (long)(c / KCH) * st + (c % KCH) * 8);
    }
#pragma unroll
    for (int i = 0; i < VPT; ++i) {
      const int task = tid + 256 * i;
      const int dp = task % (DV / 2), kg = task / (DV / 2);
#pragma unroll
      for (int q = 0; q < 8; ++q) vreg[i][q] = *(const unsigned*)(vp + (long)(kg * 8 + q) * st + dp * 2);
    }
  };
  load_tile(0);
  for (int t = 0; t < ntot; ++t) {
    __syncthreads();
#pragma unroll
    for (int i = 0; i < KPT; ++i) {
      const int c = tid + 256 * i;
      *(u32x4*)(Ks + (c / KCH) * KST + (c % KCH) * 8) = kreg[i];
    }
#pragma unroll
    for (int i = 0; i < VPT; ++i) {
      const int task = tid + 256 * i;
      const int dp = task % (DV / 2), kg = task / (DV / 2);
      u32x4 lo, hi;
      lo.x = (vreg[i][0] & 0xffffu) | (vreg[i][1] << 16); lo.y = (vreg[i][2] & 0xffffu) | (vreg[i][3] << 16);
      lo.z = (vreg[i][4] & 0xffffu) | (vreg[i][5] << 16); lo.w = (vreg[i][6] & 0xffffu) | (vreg[i][7] << 16);
      hi.x = (vreg[i][0] >> 16) | (vreg[i][1] & 0xffff0000u); hi.y = (vreg[i][2] >> 16) | (vreg[i][3] & 0xffff0000u);
      hi.z = (vreg[i][4] >> 16) | (vreg[i][5] & 0xffff0000u); hi.w = (vreg[i][6] >> 16) | (vreg[i][7] & 0xffff0000u);
      *(u32x4*)(Vt + (dp * 2) * 80 + kg * 8) = lo;
      *(u32x4*)(Vt + (dp * 2 + 1) * 80 + kg * 8) = hi;
    }
    __syncthreads();
    if (t + 1 < ntot) load_tile(t + 1);
    __builtin_amdgcn_sched_barrier(0);
#pragma unroll
    for (int s = 0; s < NS; ++s) {
      f32x4 sc[4];
#pragma unroll
      for (int n = 0; n < 4; ++n) {
        sc[n] = (f32x4){0.f, 0.f, 0.f, 0.f};
#pragma unroll
        for (int ks = 0; ks < 2; ++ks) {
          const bf16x8 kf = *(const bf16x8*)(Ks + (n * 16 + l16) * KST + s * 64 + ks * 32 + quad * 8);
          sc[n] = __builtin_amdgcn_mfma_f32_16x16x32_bf16(kf, qf[s][ks], sc[n], 0, 0, 0);
        }
      }
      float mx = -1e30f;
#pragma unroll
      for (int n = 0; n < 4; ++n)
#pragma unroll
        for (int j = 0; j < 4; ++j) {
          float v = sc[n][j] * C2;
          if (LOCAL) {
            if (t >= nt0) {
              const int kr = r0 + (t - nt0), kc = n * 16 + quad * 4 + j;
              const bool ok = (kc >= c0) && (kc < c0 + 16);
              const float bias = rpbh[ok ? ((kr - qi + 7) * 31 + (kc - jq + 15)) : 0];
              v = ok ? v + bias * 1.4426950408889634f : -1e30f;
            }
          }
          sc[n][j] = v;
          mx = fmaxf(mx, v);
        }
      mx = xq_max(mx);
      const float mn = fmaxf(m[s], mx);
      if (__builtin_amdgcn_ballot_w64(mn > m[s]) != 0ull) {
        const float corr = __builtin_amdgcn_exp2f(m[s] - mn);
        l[s] *= corr;
#pragma unroll
        for (int n = 0; n < DV / 16; ++n) O[s][n] *= corr;
        m[s] = mn;
      }
      float rs = 0.f;
#pragma unroll
      for (int n = 0; n < 4; ++n) {
        const float p0 = __builtin_amdgcn_exp2f(sc[n][0] - mn), p1 = __builtin_amdgcn_exp2f(sc[n][1] - mn);
        const float p2 = __builtin_amdgcn_exp2f(sc[n][2] - mn), p3 = __builtin_amdgcn_exp2f(sc[n][3] - mn);
        rs += (p0 + p1) + (p2 + p3);
        u32x2 pk; pk.x = cvt_pk_bf16(p0, p1); pk.y = cvt_pk_bf16(p2, p3);
        *(u32x2*)(Ps + ((wave * NS + s) * 16 + l16) * 80 + n * 16 + quad * 4) = pk;
      }
      l[s] += rs;
    }
    __builtin_amdgcn_wave_barrier();
    {
      bf16x8 pf[NS][2];
#pragma unroll
      for (int s = 0; s < NS; ++s)
#pragma unroll
        for (int ks = 0; ks < 2; ++ks)
          pf[s][ks] = *(const bf16x8*)(Ps + ((wave * NS + s) * 16 + l16) * 80 + ks * 32 + quad * 8);
#pragma unroll
      for (int ks = 0; ks < 2; ++ks)
#pragma unroll
        for (int n = 0; n < DV / 16; ++n) {
          const bf16x8 vf = *(const bf16x8*)(Vt + (n * 16 + l16) * 80 + ks * 32 + quad * 8);
#pragma unroll
          for (int s = 0; s < NS; ++s) O[s][n] = __builtin_amdgcn_mfma_f32_16x16x32_bf16(vf, pf[s][ks], O[s][n], 0, 0, 0);
        }
    }
  }
  u16* orow = op + (long)(wave * 16 + l16) * ost + quad * 4;
  if (NS == 1) {
    const float il = 1.f / xq_sum(l[0]);
#pragma unroll
    for (int n = 0; n < DV / 16; ++n) {
      u32x2 o; o.x = cvt_pk_bf16(O[0][n][0] * il, O[0][n][1] * il); o.y = cvt_pk_bf16(O[0][n][2] * il, O[0][n][3] * il);
      *(u32x2*)(orow + n * 16) = o;
    }
  } else {
    const float i0 = 1.f / xq_sum(l[0]), i1 = lam / xq_sum(l[NS - 1]);
    float ss = 0.f;
#pragma unroll
    for (int n = 0; n < DV / 16; ++n) {
      O[0][n] = O[0][n] * i0 - O[NS - 1][n] * i1;
      ss += O[0][n][0] * O[0][n][0] + O[0][n][1] * O[0][n][1] + O[0][n][2] * O[0][n][2] + O[0][n][3] * O[0][n][3];
    }
    ss = xq_sum(ss);
    const float ri = rsqrtf(ss * (1.f / (float)DV) + 1e-6f) * outscale;
#pragma unroll
    for (int n = 0; n < DV / 16; ++n) {
      const f32x4 g = *(const f32x4*)(subln + n * 16 + quad * 4);
      u32x2 o; o.x = cvt_pk_bf16(O[0][n][0] * ri * g[0], O[0][n][1] * ri * g[1]); o.y = cvt_pk_bf16(O[0][n][2] * ri * g[2], O[0][n][3] * ri * g[3]);
      *(u32x2*)(orow + n * 16) = o;
    }
  }
}

__device__ __forceinline__ float* yl_ptr(const P& p, int tok, int d, int col) {
  const int slab = tok >> 8;
  return p.out + OUT_DK + (long)(slab >> 5) * 16777216L + ((long)(((slab & 31) * 2 + 1) * 256 + (tok & 255))) * 1024 + d * 512 + col;
}
__device__ __forceinline__ float* tb_ptr(const P& p, int unit, int d, int isB) {
  return (float*)(p.ws + WS_TB) + ((long)((unit * 2 + d) * 2 + isB)) * 4096;
}
__device__ __forceinline__ float ushift(const u16* proj, const float* mu, int tok, int seq0, int slen, int c) {
  const u16* pp = proj + (long)tok * 3328 + 1536 + c;
  const bool hp = tok > seq0, hn = tok < seq0 + slen - 1;
  const float cur = bf2f(pp[0]);
  const float pv = bf2f(pp[hp ? -3328 : 0]);
  const float nv = bf2f(pp[hn ? 3328 : 0]);
  const float prev = hp ? pv : 0.f;
  const float next = hn ? nv : 0.f;
  return cur + mu[c] * (prev - cur) + mu[1792 + c] * (next - cur);
}

__device__ __forceinline__ void rwkv_scan_unit(const P& p, char* smem, int e, int unit) {
  const int gch = unit >> 3, h = unit & 7;
  int seq0, slen;
  if (gch < 64) { seq0 = (gch >> 1) * 256; slen = 256; } else { seq0 = NCTX + ((gch - 64) >> 5) * 4096; slen = 4096; }
  const int t0 = gch * 128;
  float* sc = (float*)smem;
  const u16* proj = (const u16*)(p.ws + WS_BIG);
  const float* mu = p.in[17] + e * 2 * 1792;
  const float* w0 = p.in[18] + e * 1024;
  const float* w2 = p.in[19] + (long)e * 2 * 64 * 512;
  const float* a0 = p.in[20] + e * 1024;
  const float* a2 = p.in[21] + (long)e * 2 * 64 * 512;
  const float* kkw = p.in[22] + e * 512;
  const float* kaw = p.in[23] + e * 512;
  const float* bonus = p.in[24] + e * 1024;
  float* rkb = (float*)(p.ws + WS_RKB);
  float* qt = (float*)(p.ws + WS_QT);
  const int tid = otid(), lane = tid & 63, wave = tid >> 6;
  const int sd = wave >> 1; const bool isB = (wave & 1) != 0;
  const int pd = tid >> 7, th = (tid >> 6) & 1;
  float S[64];
#pragma unroll
  for (int j = 0; j < 64; ++j) S[j] = (!isB && j == lane) ? 1.f : 0.f;
  const int hc = h * 64 + lane;
  const float kkwj = kkw[hc], kawj = kaw[hc], bonj = bonus[pd * 512 + hc], w0j = w0[pd * 512 + hc], a0j = a0[pd * 512 + hc];

  u16* raw = (u16*)(smem + 49152);
  u32x4 rg[3];
  auto load_raw = [&](int lo) {
#pragma unroll
    for (int i = 0; i < 3; ++i) {
      const int c = tid + 256 * i;
      u32x4 v = (u32x4){0u, 0u, 0u, 0u};
      if (c < 720) {
        const int row = c / 40, cc = c % 40, vec = cc >> 3, ch = cc & 7;
        const int tok = lo + row;
        const int voff = (vec < 3) ? (vec * 512 + h * 64) : (1536 + (vec - 3) * 64);
        const int tokc = tok < seq0 ? seq0 : (tok > seq0 + slen - 1 ? seq0 + slen - 1 : tok);
        const u32x4 ld = *(const u32x4*)(proj + (long)tokc * 3328 + 1536 + voff + ch * 8);
        const bool inb = (tok >= seq0) && (tok < seq0 + slen);
        v.x = inb ? ld.x : 0u; v.y = inb ? ld.y : 0u; v.z = inb ? ld.z : 0u; v.w = inb ? ld.w : 0u;
      }
      rg[i] = v;
    }
  };
  auto store_raw = [&]() {
#pragma unroll
    for (int i = 0; i < 3; ++i) {
      const int c = tid + 256 * i;
      if (c < 720) {
        const int row = c / 40, cc = c % 40;
        *(u32x4*)(raw + row * 320 + cc * 8) = rg[i];
      }
    }
  };
  auto shift_dir = [&](int d) {
    float mu0v[5], mu1v[5];
#pragma unroll
    for (int v = 0; v < 5; ++v) {
      const int c = (v < 3) ? (v * 512 + h * 64 + lane) : (1536 + (v - 3) * 64 + lane);
      mu0v[v] = mu[c]; mu1v[v] = mu[1792 + c];
    }
#pragma unroll
    for (int vec = 0; vec < 5; ++vec)
#pragma unroll
      for (int k = 0; k < 4; ++k) {
        const int pslot = wave + 4 * k;
        const int row = (d == 0) ? pslot + 1 : 16 - pslot;
        const u16* rp = raw + row * 320 + vec * 64 + lane;
        const float cur = bf2f(rp[0]), prev = bf2f(rp[-320]), next = bf2f(rp[320]);
        float val = cur + mu0v[vec] * (prev - cur) + mu1v[vec] * (next - cur);
        if (vec == 3) { const float ex = __expf(2.f * val); val = 1.f - 2.f * __builtin_amdgcn_rcpf(ex + 1.f); }
        if (vec >= 3) ((u16*)(sc + (d * 6 + 5) * 1024))[(vec - 3) * 1024 + pslot * 64 + lane] = f2bf(val);
        else sc[((d * 6 + vec) * 16 + pslot) * 64 + lane] = val;
      }
  };
  for (int sub = 0; sub < 8; ++sub) {
    load_raw(t0 + sub * 16 - 1);
    __syncthreads();
    store_raw();
    load_raw(t0 + 127 - sub * 16 - 16);
    __syncthreads();
    shift_dir(0);
    __syncthreads();
    store_raw();
    __syncthreads();
    shift_dir(1);
    __syncthreads();
    {
      const int t2 = otid(), quad = (t2 >> 4) & 3, l16 = t2 & 15, w2i = t2 >> 6, sd2 = w2i >> 1, mat = w2i & 1;
      const u16* at = (const u16*)(sc + (sd2 * 6 + 5) * 1024) + mat * 1024;
      const u16* wt = (const u16*)(p.ws + WS_WT) + ((long)((e * 2 + sd2) * 2 + mat) * 512 + h * 64) * 64;
      bf16x8 af[2];
#pragma unroll
      for (int ks = 0; ks < 2; ++ks) af[ks] = *(const bf16x8*)(at + l16 * 64 + ks * 32 + quad * 8);
#pragma unroll
      for (int nt = 0; nt < 4; ++nt) {
        f32x4 dacc = (f32x4){0.f, 0.f, 0.f, 0.f};
#pragma unroll
        for (int ks = 0; ks < 2; ++ks) {
          const bf16x8 bfr = *(const bf16x8*)(wt + (nt * 16 + l16) * 64 + ks * 32 + quad * 8);
          dacc = __builtin_amdgcn_mfma_f32_16x16x32_bf16(af[ks], bfr, dacc, 0, 0, 0);
        }
#pragma unroll
        for (int j = 0; j < 4; ++j) sc[((sd2 * 6 + 3 + mat) * 16 + quad * 4 + j) * 64 + nt * 16 + l16] = dacc[j];
      }
    }
    __syncthreads();
    {
      float* scw = sc + pd * 6 * 1024;
#pragma unroll
      for (int tk = 0; tk < 8; ++tk) {
        const int pslot = th * 8 + tk;
        const int tok = (pd == 0) ? (t0 + sub * 16 + pslot) : (t0 + 127 - sub * 16 - pslot);
        const float kv = scw[(1 * 16 + pslot) * 64 + lane];
        const float rv = scw[(0 * 16 + pslot) * 64 + lane];
        float kkv = kv * kkwj;
        const float nrm = wave_sum(kkv * kkv);
        kkv *= rsqrtf(fmaxf(nrm, 1e-12f));
        const float xw = -(w0j + scw[(3 * 16 + pslot) * 64 + lane]);
        const float sp = fmaxf(xw, 0.f) + __logf(1.f + __expf(-fabsf(xw)));
        const float decay = __expf(-__expf(-sp - 0.5f));
        const float a = sigmoidf_(a0j + scw[(4 * 16 + pslot) * 64 + lane]);
        const float kt = kv * (1.f + (a - 1.f) * kawj);
        const float bsum = wave_sum(rv * kt * bonj);
        scw[(5 * 16 + pslot) * 64 + lane] = kkv;
        scw[(3 * 16 + pslot) * 64 + lane] = decay;
        scw[(4 * 16 + pslot) * 64 + lane] = kkv * a;
        scw[(1 * 16 + pslot) * 64 + lane] = kt;
        if (lane == 0) rkb[tok * 16 + pd * 8 + h] = bsum;
      }
    }
    __syncthreads();
    if (isB || gch >= 64 || ((gch & 1) == (sd == 0 ? 1 : 0))) {
      const float* base = sc + sd * 6 * 1024;
      for (int ps = 0; ps < 16; ++ps) {
        const f32x4* kk4 = (const f32x4*)(base + (5 * 16 + ps) * 64);
        const f32x4* w4 = (const f32x4*)(base + (3 * 16 + ps) * 64);
        const f32x4* ka4 = (const f32x4*)(base + (4 * 16 + ps) * 64);
        const f32x4* kt4 = (const f32x4*)(base + (1 * 16 + ps) * 64);
        const f32x4* r4 = (const f32x4*)(base + (0 * 16 + ps) * 64);
        f32x4 kk[16];
#pragma unroll
        for (int q = 0; q < 16; ++q) kk[q] = kk4[q];
        f32x4 bw[2][2], bka[2][2], bkt[2][2], br[2][2];
#pragma unroll
        for (int q = 0; q < 2; ++q) { bw[0][q] = w4[q]; bka[0][q] = ka4[q]; br[0][q] = r4[q]; bkt[0][q] = kt4[q]; }
        const float vv = isB ? base[(2 * 16 + ps) * 64 + lane] : 0.f;
        __builtin_amdgcn_sched_barrier(0);
        float s0 = 0.f, s1 = 0.f;
#pragma unroll
        for (int q = 0; q < 16; ++q) {
          s0 += S[q * 4 + 0] * kk[q].x; s1 += S[q * 4 + 1] * kk[q].y; s0 += S[q * 4 + 2] * kk[q].z; s1 += S[q * 4 + 3] * kk[q].w;
        }
        const float nskk = -(s0 + s1);
        float y0 = 0.f, y1 = 0.f;
#pragma unroll
        for (int qq = 0; qq < 8; ++qq) {
          const int cb = qq & 1, nbf = cb ^ 1;
          if (qq < 7) {
#pragma unroll
            for (int q = 0; q < 2; ++q) {
              bw[nbf][q] = w4[(qq + 1) * 2 + q]; bka[nbf][q] = ka4[(qq + 1) * 2 + q];
              br[nbf][q] = r4[(qq + 1) * 2 + q]; bkt[nbf][q] = kt4[(qq + 1) * 2 + q];
            }
          }
          __builtin_amdgcn_sched_barrier(0);
#pragma unroll
          for (int q = 0; q < 2; ++q) {
            const int j = (qq * 2 + q) * 4;
            const f32x4 w = bw[cb][q], ka = bka[cb][q], kt = bkt[cb][q], r = br[cb][q];
            S[j + 0] = fmaf(vv, kt.x, fmaf(nskk, ka.x, S[j + 0] * w.x));
            S[j + 1] = fmaf(vv, kt.y, fmaf(nskk, ka.y, S[j + 1] * w.y));
            S[j + 2] = fmaf(vv, kt.z, fmaf(nskk, ka.z, S[j + 2] * w.z));
            S[j + 3] = fmaf(vv, kt.w, fmaf(nskk, ka.w, S[j + 3] * w.w));
            y0 += S[j + 0] * r.x; y1 += S[j + 1] * r.y; y0 += S[j + 2] * r.z; y1 += S[j + 3] * r.w;
          }
        }
        const int tok = (sd == 0) ? (t0 + sub * 16 + ps) : (t0 + 127 - sub * 16 - ps);
        const float y = y0 + y1;
        if (isB) *yl_ptr(p, tok, sd, hc) = y;
        else qt[((long)tok * 2 + sd) * 512 + hc] = y;
      }
    }
  }
  float4* tp = (float4*)(tb_ptr(p, unit, sd, isB ? 1 : 0) + lane * 64);
#pragma unroll
  for (int q = 0; q < 16; ++q) tp[q] = make_float4(S[q * 4], S[q * 4 + 1], S[q * 4 + 2], S[q * 4 + 3]);
}

__device__ __forceinline__ void rwkv_e3_job(const P& p, char* smem, int e, int job) {
  float* Ss = (float*)smem;
  const int tid = otid(), r = tid >> 4, cgp = tid & 15;
  __syncthreads();
  if (job < 2048) {
    const int chain = job >> 2, rg = job & 3, row = rg * 16 + r;
    const int seq = chain >> 4, h = (chain >> 1) & 7, d = chain & 1;
    const int first = seq * 2 + (d == 0 ? 0 : 1), second = seq * 2 + (d == 0 ? 1 : 0);
    const float* Bf = tb_ptr(p, first * 8 + h, d, 1);
    const float* Ts = tb_ptr(p, second * 8 + h, d, 0);
    const float* Bs = tb_ptr(p, second * 8 + h, d, 1);
    *(float4*)(Ss + r * 64 + cgp * 4) = *(const float4*)(Bf + row * 64 + cgp * 4);
    __syncthreads();
    float4 acc = *(const float4*)(Bs + row * 64 + cgp * 4);
#pragma unroll 8
    for (int i = 0; i < 64; ++i) {
      const float s = Ss[r * 64 + i];
      const float4 t = *(const float4*)(Ts + i * 64 + cgp * 4);
      acc.x += s * t.x; acc.y += s * t.y; acc.z += s * t.z; acc.w += s * t.w;
    }
    *(float4*)(p.out + OUT_ST + ((long)(((seq * 2 + e) * 2 + d) * 8 + h)) * 4096 + row * 64 + cgp * 4) = acc;
  } else {
    const int j2 = job - 2048;
    const int chain = j2 >> 2, rg = j2 & 3, row = rg * 16 + r;
    const int b = chain >> 4, h = (chain >> 1) & 7, d = chain & 1;
    float* Tb = (float*)smem + 1024;
    const float* s0 = p.in[5] + ((long)(((b * 2 + e) * 2 + d) * 8 + h)) * 4096;
    *(float4*)(Ss + r * 64 + cgp * 4) = *(const float4*)(s0 + row * 64 + cgp * 4);
    f32x4 tn[4], bn;
    float* Bcur;
    {
      const int gch = 64 + b * 32 + ((d == 0) ? 0 : 31);
      const float* Tc = tb_ptr(p, gch * 8 + h, d, 0);
      Bcur = tb_ptr(p, gch * 8 + h, d, 1);
#pragma unroll
      for (int q = 0; q < 4; ++q) tn[q] = *(const f32x4*)(Tc + (tid + 256 * q) * 4);
      bn = *(const f32x4*)(Bcur + row * 64 + cgp * 4);
    }
    for (int step = 0; step < 31; ++step) {
      float* Tcur = Tb + (step & 1) * 4096;
#pragma unroll
      for (int q = 0; q < 4; ++q) *(f32x4*)(Tcur + (tid + 256 * q) * 4) = tn[q];
      f32x4 acc = bn;
      float* Bst = Bcur;
      __syncthreads();
      if (step + 1 < 31) {
        const int c = (d == 0) ? step + 1 : 30 - step;
        const int gch = 64 + b * 32 + c;
        const float* Tc = tb_ptr(p, gch * 8 + h, d, 0);
        Bcur = tb_ptr(p, gch * 8 + h, d, 1);
#pragma unroll
        for (int q = 0; q < 4; ++q) tn[q] = *(const f32x4*)(Tc + (tid + 256 * q) * 4);
        bn = *(const f32x4*)(Bcur + row * 64 + cgp * 4);
      }
#pragma unroll 16
      for (int i = 0; i < 64; ++i) {
        const float sv = Ss[r * 64 + i];
        const f32x4 t = *(const f32x4*)(Tcur + i * 64 + cgp * 4);
        acc += sv * t;
      }
      __syncthreads();
      *(f32x4*)(Ss + r * 64 + cgp * 4) = acc;
      *(f32x4*)(Bst + row * 64 + cgp * 4) = acc;
    }
  }
}

__device__ __forceinline__ void rwkv_e4_unit(const P& p, char* smem, int e, int unit) {
  const int gch = unit >> 3, h = unit & 7;
  int seq0, slen, cidx, nch;
  if (gch < 64) { seq0 = (gch >> 1) * 256; slen = 256; cidx = gch & 1; nch = 2; }
  else { seq0 = NCTX + ((gch - 64) >> 5) * 4096; slen = 4096; cidx = (gch - 64) & 31; nch = 32; }
  const int tid = otid(), lane = tid & 63, wave = tid >> 6;
  float* qbuf = (float*)smem + wave * 1024;
  float* dout = qbuf;
  u16* G2T = (u16*)(smem + 16384);
  u16* SGw = (u16*)(smem + 34816) + wave * 16 * 144;
  const u16* proj = (const u16*)(p.ws + WS_BIG);
  const float* mu = p.in[17] + e * 2 * 1792;
  const float* g2 = p.in[25] + (long)e * 128 * 512;
  const float* rkb = (const float*)(p.ws + WS_RKB);
  const float* qt = (const float*)(p.ws + WS_QT);
  u16* mix = (u16*)(p.ws + WS_MIX);
  const int hc = h * 64 + lane;
  const int quad = lane >> 4, l16 = lane & 15;
  __syncthreads();
#pragma unroll 8
  for (int idx = tid; idx < 8192; idx += 256) G2T[(idx & 63) * 144 + (idx >> 6)] = f2bf(g2[(long)(idx >> 6) * 512 + h * 64 + (idx & 63)]);
  __syncthreads();
  const float lnw = p.in[26][e * 512 + hc], lnb = p.in[27][e * 512 + hc];
  const int cg0 = 1536 + 1664 + lane, cg1 = 1536 + 1728 + lane, cv = 1536 + 1024 + hc;
  const float m0g0 = mu[1664 + lane], m1g0 = mu[1792 + 1664 + lane];
  const float m0g1 = mu[1728 + lane], m1g1 = mu[1792 + 1728 + lane];
  const float m0v = mu[1024 + hc], m1v = mu[1792 + 1024 + hc];
  for (int hf = 0; hf < 2; ++hf) {
    const int tw0 = gch * 128 + wave * 32 + hf * 16;
    float yv[16];
#pragma unroll
    for (int tk = 0; tk < 16; ++tk) yv[tk] = *yl_ptr(p, tw0 + tk, 0, hc) + *yl_ptr(p, tw0 + tk, 1, hc);
    for (int d = 0; d < 2; ++d) {
      const int oi = (d == 0) ? cidx : nch - 1 - cidx;
      const float* Sp = nullptr;
      if (oi == 0) {
        if (gch >= 64) Sp = p.in[5] + ((long)(((((gch - 64) >> 5) * 2 + e) * 2 + d) * 8 + h)) * 4096;
      } else {
        const int gp = (d == 0) ? gch - 1 : gch + 1;
        Sp = tb_ptr(p, gp * 8 + h, d, 1);
      }
      if (Sp != nullptr) {
        float S[64];
#pragma unroll
        for (int q = 0; q < 16; ++q) {
          const f32x4 v = *(const f32x4*)(Sp + lane * 64 + q * 4);
          S[q * 4] = v[0]; S[q * 4 + 1] = v[1]; S[q * 4 + 2] = v[2]; S[q * 4 + 3] = v[3];
        }
        f32x4 qv[4];
#pragma unroll
        for (int i = 0; i < 4; ++i) {
          const int idx = lane + 64 * i, r = idx >> 4, c4 = idx & 15;
          qv[i] = *(const f32x4*)(qt + ((long)(tw0 + r) * 2 + d) * 512 + h * 64 + c4 * 4);
        }
        __builtin_amdgcn_wave_barrier();
#pragma unroll
        for (int i = 0; i < 4; ++i) *(f32x4*)(qbuf + (lane + 64 * i) * 4) = qv[i];
        __builtin_amdgcn_wave_barrier();
#pragma unroll
        for (int r = 0; r < 16; ++r) {
          float y0 = 0.f, y1 = 0.f;
#pragma unroll
          for (int q = 0; q < 16; ++q) {
            const f32x4 v = *(const f32x4*)(qbuf + r * 64 + q * 4);
            y0 += S[q * 4] * v[0]; y1 += S[q * 4 + 1] * v[1]; y0 += S[q * 4 + 2] * v[2]; y1 += S[q * 4 + 3] * v[3];
          }
          yv[r] += y0 + y1;
        }
        __builtin_amdgcn_wave_barrier();
      }
    }
    float rkl = 0.f;
    if (lane < 16) rkl = rkb[(tw0 + lane) * 16 + h] + rkb[(tw0 + lane) * 16 + 8 + h];
    auto ldrow = [&](int r, float& a, float& b, float& c) {
      const bool ok = (r >= seq0) && (r < seq0 + slen);
      const u16* rp = proj + (long)(ok ? r : tw0) * 3328;
      const float x = bf2f(rp[cg0]), y = bf2f(rp[cg1]), z = bf2f(rp[cv]);
      a = ok ? x : 0.f; b = ok ? y : 0.f; c = ok ? z : 0.f;
    };
    float pg0, pg1, pvv, cg0v, cg1v, cvv, ng0, ng1, nvv;
    ldrow(tw0 - 1, pg0, pg1, pvv);
    ldrow(tw0, cg0v, cg1v, cvv);
    ldrow(tw0 + 1, ng0, ng1, nvv);
    float vshv[16];
#pragma unroll
    for (int tk = 0; tk < 16; ++tk) {
      float fg0, fg1, fvv;
      ldrow(tw0 + tk + 2, fg0, fg1, fvv);
      const float gv0 = sigmoidf_(cg0v + m0g0 * (pg0 - cg0v) + m1g0 * (ng0 - cg0v));
      const float gv1 = sigmoidf_(cg1v + m0g1 * (pg1 - cg1v) + m1g1 * (ng1 - cg1v));
      vshv[tk] = cvv + m0v * (pvv - cvv) + m1v * (nvv - cvv);
      pg0 = cg0v; pg1 = cg1v; pvv = cvv; cg0v = ng0; cg1v = ng1; cvv = nvv; ng0 = fg0; ng1 = fg1; nvv = fvv;
      SGw[tk * 144 + lane] = f2bf(gv0);
      SGw[tk * 144 + 64 + lane] = f2bf(gv1);
    }
    __builtin_amdgcn_wave_barrier();
    {
      bf16x8 af[4];
#pragma unroll
      for (int ks = 0; ks < 4; ++ks) af[ks] = *(const bf16x8*)(SGw + l16 * 144 + ks * 32 + quad * 8);
#pragma unroll
      for (int nt = 0; nt < 4; ++nt) {
        f32x4 dacc = (f32x4){0.f, 0.f, 0.f, 0.f};
#pragma unroll
        for (int ks = 0; ks < 4; ++ks) {
          const bf16x8 bfr = *(const bf16x8*)(G2T + (nt * 16 + l16) * 144 + ks * 32 + quad * 8);
          dacc = __builtin_amdgcn_mfma_f32_16x16x32_bf16(af[ks], bfr, dacc, 0, 0, 0);
        }
#pragma unroll
        for (int j = 0; j < 4; ++j) dout[(quad * 4 + j) * 64 + nt * 16 + l16] = dacc[j];
      }
    }
    __builtin_amdgcn_wave_barrier();
#pragma unroll
    for (int tk = 0; tk < 16; ++tk) {
      const int tok = tw0 + tk;
      const float rk = __int_as_float(__builtin_amdgcn_readlane(__float_as_int(rkl), tk));
      const float gate = dout[tk * 64 + lane];
      const float y = yv[tk];
      const float mean = wave_sum(y) * (1.f / 64.f);
      const float dv = y - mean;
      const float var = wave_sum(dv * dv) * (1.f / 64.f);
      const float yn = dv * rsqrtf(var + 64e-5f) * lnw + lnb;
      mix[(long)tok * 1024 + 512 + hc] = f2bf((yn + rk * vshv[tk]) * gate);
    }
    __builtin_amdgcn_wave_barrier();
  }
}

#define XB_TMO      128
#define XB_XCNT(j)  (256  + 64 * (j))
#define XB_XSUB(j)  (1280 + 64 * (j))
#define XB_XGEN(j)  (2304 + 64 * (j))
#define XB_TOP      3328
#define XB_TOPGEN   3392
#define XCD_BAR_WORDS 3456
#define XB_SPIN_CAP (1u << 22)
#define LAS __attribute__((address_space(3)))
__device__ __forceinline__ unsigned xb_ld(unsigned* p)              { return __hip_atomic_load(p, __ATOMIC_RELAXED, __HIP_MEMORY_SCOPE_AGENT); }
__device__ __forceinline__ unsigned xb_add(unsigned* p, unsigned v) { return __hip_atomic_fetch_add(p, v, __ATOMIC_RELAXED, __HIP_MEMORY_SCOPE_AGENT); }
__device__ __forceinline__ unsigned xb_xcc_id() { return (unsigned)__builtin_amdgcn_s_getreg((3 << 11) | 20) & 0xFu; }
#define XB_SPIN(cond, bar) do { unsigned _sp = 0; while (cond) { __builtin_amdgcn_s_sleep(1); \
    if ((++_sp & 255u) == 0u) { if (xb_ld(&(bar)[XB_TMO])) break; if (_sp > XB_SPIN_CAP) { atomicAdd(&(bar)[XB_TMO], 1u); break; } } } } while (0)
struct XcdBarrier { unsigned* bar; unsigned x; volatile LAS unsigned* st; };
__device__ __forceinline__ XcdBarrier xcd_barrier_post(unsigned* bar, volatile LAS unsigned* st) {
  XcdBarrier b; b.bar = bar; b.x = xb_xcc_id(); b.st = st;
  if (threadIdx.x == 0) (void)xb_add(&bar[XB_XCNT(b.x)], 1u);
  return b;
}
__device__ __forceinline__ void xcd_barrier_complete(unsigned* bar, unsigned x, unsigned& nloc, unsigned& nx) {
  const unsigned G = gridDim.x * gridDim.y * gridDim.z;
  unsigned sum, cnt, mine, sp = 0u;
  for (;;) {
    sum = 0u; cnt = 0u; mine = 0u;
#pragma unroll
    for (unsigned j = 0; j < 16; ++j) { const unsigned c = xb_ld(&bar[XB_XCNT(j)]); sum += c; cnt += (c > 0u) ? 1u : 0u; mine = (j == x) ? c : mine; }
    if (sum == G) break;
    __builtin_amdgcn_s_sleep(1);
    if ((++sp & 255u) == 0u) { if (xb_ld(&bar[XB_TMO])) break; if (sp > XB_SPIN_CAP) { atomicAdd(&bar[XB_TMO], 1u); break; } }
  }
  nloc = mine > 0u ? mine : 1u; nx = cnt > 0u ? cnt : 1u;
}
__device__ __forceinline__ void xcd_barrier(const XcdBarrier& b0) {
  XcdBarrier b; b.bar = b0.bar; b.st = b0.st; b.x = (unsigned)__builtin_amdgcn_readfirstlane((int)xb_xcc_id());
  asm volatile("s_waitcnt vmcnt(0)" ::: "memory");
  __syncthreads();
  if (threadIdx.x == 0) {
    unsigned* bar = b.bar;
    __builtin_amdgcn_s_waitcnt(0);
    unsigned nloc = b.st[0], nx = b.st[1];
    if (nloc == 0u) { xcd_barrier_complete(bar, b.x, nloc, nx); b.st[0] = nloc; b.st[1] = nx; }
    const unsigned old = xb_add(&bar[XB_XSUB(b.x)], 1u);
    const unsigned gen = old / nloc;
    if (old + 1u == (gen + 1u) * nloc) {
      __builtin_amdgcn_fence(__ATOMIC_RELEASE, "agent");
      asm volatile("s_waitcnt vmcnt(0)" ::: "memory");
      const unsigned og = xb_add(&bar[XB_TOP], 1u);
      const unsigned tg = og / nx;
      if (og + 1u == (tg + 1u) * nx) xb_add(&bar[XB_TOPGEN], 1u);
      else XB_SPIN(xb_ld(&bar[XB_TOPGEN]) == tg, bar);
      __builtin_amdgcn_fence(__ATOMIC_ACQUIRE, "agent");
      xb_add(&bar[XB_XGEN(b.x)], 1u);
      asm volatile("s_waitcnt vmcnt(0)" ::: "memory");
    } else {
      XB_SPIN(xb_ld(&bar[XB_XGEN(b.x)]) == gen, bar);
      __builtin_amdgcn_fence(__ATOMIC_ACQUIRE, "agent");
      asm volatile("s_waitcnt vmcnt(0)" ::: "memory");
    }
  }
  __syncthreads();
}

__device__ __forceinline__ void norm_job(const P& p, int job, const float* gvec, const float* modl, int shift_idx) {
  const int t = otid();
  const int row = job * 4 + (t >> 6), lane = t & 63;
  const int grp = row < NCTX ? 0 : 1 + ((row - NCTX) >> 12);
  const float* modv = modl + grp * 6144;
  const float* x = p.out + (long)row * 1024;
  u16* H = (u16*)(p.ws + WS_MIX) + (long)row * 1024;
  float4 v[4];
  float ss = 0.f;
#pragma unroll
  for (int i = 0; i < 4; ++i) {
    v[i] = *(const float4*)(x + (i * 64 + lane) * 4);
    ss += v[i].x * v[i].x + v[i].y * v[i].y + v[i].z * v[i].z + v[i].w * v[i].w;
  }
  ss = wave_sum(ss);
  const float r = rsqrtf(ss * (1.f / 1024.f) + 1e-6f);
#pragma unroll
  for (int i = 0; i < 4; ++i) {
    const int k = (i * 64 + lane) * 4;
    const float4 g = *(const float4*)(gvec + k);
    const float4 sc = *(const float4*)(modv + (shift_idx + 1) * 1024 + k);
    const float4 sh = *(const float4*)(modv + shift_idx * 1024 + k);
    u32x2 o;
    o.x = pack2(v[i].x * r * g.x * (1.f + sc.x) + sh.x, v[i].y * r * g.y * (1.f + sc.y) + sh.y);
    o.y = pack2(v[i].z * r * g.z * (1.f + sc.z) + sh.z, v[i].w * r * g.w * (1.f + sc.w) + sh.w);
    *(u32x2*)(H + k) = o;
  }
}

__device__ __forceinline__ void final_job(const P& p, int job) {
  const int t = otid();
  const int row = job * 4 + (t >> 6), lane = t & 63;
  float* x = p.out + (long)row * 1024;
  float4 v[4];
  float ss = 0.f;
#pragma unroll
  for (int i = 0; i < 4; ++i) {
    v[i] = *(const float4*)(x + (i * 64 + lane) * 4);
    ss += v[i].x * v[i].x + v[i].y * v[i].y + v[i].z * v[i].z + v[i].w * v[i].w;
  }
  ss = wave_sum(ss);
  const float r = rsqrtf(ss * (1.f / 1024.f) + 1e-6f);
#pragma unroll
  for (int i = 0; i < 4; ++i) {
    const float4 g = *(const float4*)(p.in[13] + (i * 64 + lane) * 4);
    float4 o;
    o.x = v[i].x * r * g.x; o.y = v[i].y * r * g.y; o.z = v[i].z * r * g.z; o.w = v[i].w * r * g.w;
    *(float4*)(x + (i * 64 + lane) * 4) = o;
  }
}

#ifndef PHMASK
#define PHMASK 0xffff
#endif
#define PHON(k) (((PHMASK) >> (k)) & 1)
#ifndef DUPMASK
#define DUPMASK 0
#endif
#define NREP(k) ((((DUPMASK) >> (k)) & 1) ? 2 : 1)
__global__ void __launch_bounds__(256, 2) fwd_megakernel(P p) {
  cg::grid_group grid = cg::this_grid();
  __shared__ __attribute__((aligned(16))) char smem[SMEM_BYTES];
  __shared__ uint4 xb_words;
  if (threadIdx.x == 0) xb_words = make_uint4(0u, 0u, 0u, 0u);
  __syncthreads();
  XcdBarrier xb = xcd_barrier_post((unsigned*)(p.ws + WS_BAR), (volatile LAS unsigned*)&xb_words);
  const int nb = gridDim.x, bid0 = blockIdx.x;
  int bid = bid0;
  asm volatile("" : "+s"(bid));
  float* mod = (float*)(p.ws + WS_MOD);
  u16* big = (u16*)(p.ws + WS_BIG);
  u16* mix = (u16*)(p.ws + WS_MIX);

  for (int rep = 0; rep < NREP(0); ++rep)
  for (int job = bid; job < 384 + N_CONV_JOBS + 3072 + 4096 + 128; job += nb) {
    if (!PHON(0)) break;
    if (job >= 384 + N_CONV_JOBS + 3072 + 4096) loracvt_job(p, job - (384 + N_CONV_JOBS + 3072 + 4096));
    else if (job < 384) adaln_job(p, smem, job);
    else if (job < 384 + N_CONV_JOBS) conv_job(p, smem, job - 384);
    else if (job < 384 + N_CONV_JOBS + 3072) cachecvt_job(p, job - 384 - N_CONV_JOBS);
    else xcopy_job(p, job - 384 - N_CONV_JOBS - 3072);
  }
  if (p.ws == nullptr) grid.sync();
  xcd_barrier(xb);

  for (int l = 0; l < 4; ++l) {
    int bid = bid0;
    asm volatile("" : "+s"(bid));
    const float* modl = mod + l * 3 * 6144;
    const int sub = l >> 1;
    const bool even = (l & 1) == 0;
    for (int lj = bid >> 3; lj < 512; lj += (nb >> 3)) norm_job(p, (bid & 7) * 512 + lj, p.in[11] + l * 1024, modl, 0);
    xcd_barrier(xb);
    if (even) {
      if (PHON(1)) gemm_phase<0, 0, 256>(p, smem, mix, 1024, (const u16*)(p.ws + WS_WIN) + (long)sub * 3328 * 1024, 3328,
                                    nullptr, modl, 0, 0, sub, big);
    } else {
      if (PHON(7)) gemm_phase<0, 1, 128>(p, smem, mix, 1024, (const u16*)(p.ws + WS_WQKV) + (long)sub * 3072 * 1024, 3072,
                                    nullptr, modl, 0, 0, sub, big);
    }
    xcd_barrier(xb);
    if (even) {
      const int e = sub;
      for (int rep = 0; rep < NREP(2); ++rep)
      for (int job = bid; job < 3072; job += nb) {
        if (job < 1024) { if (PHON(2)) rwkv_scan_unit(p, smem, e, job); }
        else if (!PHON(3)) {}
        else if (job < 2048) {
          const int j = job - 1024;
          const int b = j >> 9, h = (j >> 6) & 7, qi = j & 63;
          int r0 = qi - 4; r0 = r0 < 0 ? 0 : (r0 > 56 ? 56 : r0);
          const long tq = NCTX + b * 4096 + qi * 64, tk = NCTX + b * 4096 + r0 * 64;
          attn_job<1, 64, true>(smem, big + tq * 3328 + h * 64, 3328,
                                (const u16*)(p.ws + WS_CNK) + (long)(b * 2 + e) * 512 * 512 + h * 64,
                                (const u16*)(p.ws + WS_CNV) + (long)(b * 2 + e) * 512 * 512 + h * 64, 512, 512,
                                big + tk * 3328 + 512 + h * 64, big + tk * 3328 + 1024 + h * 64, 3328, 512,
                                p.in[16] + (long)(e * 8 + h) * 15 * 31, qi, r0, 0.f, 0.f, nullptr,
                                mix + tq * 1024 + h * 64, 1024);
        } else {
          const int j = job - 2048;
          const int b = j >> 5, h = (j >> 2) & 7, qb = j & 3;
          const long tq = b * 256 + qb * 64, tk = b * 256;
          attn_job<1, 64, false>(smem, big + tq * 3328 + h * 64, 3328,
                                 big + tk * 3328 + 512 + h * 64, big + tk * 3328 + 1024 + h * 64, 3328, 256,
                                 nullptr, nullptr, 0, 0, nullptr, 0, 0, 0.f, 0.f, nullptr,
                                 mix + tq * 1024 + h * 64, 1024);
        }
      }
      xcd_barrier(xb);
      if (PHON(4)) for (int job = bid; job < 2176; job += nb) rwkv_e3_job(p, smem, e, job < 128 ? job + 2048 : job - 128);
      xcd_barrier(xb);
      for (int rep = 0; rep < NREP(5); ++rep)
      if (PHON(5)) for (int job = bid; job < 1024; job += nb) rwkv_e4_unit(p, smem, e, job);
    } else {
      const int o = sub;
      const float lam_init = 0.8f - 0.6f * __expf(-0.3f * (float)l);
      float d0 = 0.f, d1 = 0.f;
      for (int i = 0; i < 64; ++i) {
        d0 += p.in[30][o * 128 + i] * p.in[31][o * 128 + i];
        d1 += p.in[30][o * 128 + 64 + i] * p.in[31][o * 128 + 64 + i];
      }
      const float lam = __expf(d0) - __expf(d1) + lam_init;
      for (int rep = 0; rep < NREP(8); ++rep)
      if (PHON(8)) for (int job = bid; job < 2048; job += nb) {
        long tq, tk; int h, n0, n1; const u16 *k0, *v0; int st0;
        if (job < 1024) {
          const int x = job & 7, lj = job >> 3;
          const int pair = x + 8 * (lj >> 6), qb = lj & 63;
          const int b = pair >> 3; h = pair & 7;
          tq = NCTX + b * 4096 + qb * 64; tk = NCTX + b * 4096;
          k0 = (const u16*)(p.ws + WS_CDK) + (long)(b * 2 + o) * 512 * 1024 + h * 128;
          v0 = (const u16*)(p.ws + WS_CDV) + (long)(b * 2 + o) * 512 * 1024 + h * 128;
          st0 = 1024; n0 = 512; n1 = 4096;
        } else {
          const int j = job - 1024;
          const int b = j >> 5, qb = j & 3; h = (j >> 2) & 7;
          tq = b * 256 + qb * 64; tk = b * 256;
          k0 = big + tk * 3072 + 1024 + h * 128; v0 = big + tk * 3072 + 2048 + h * 128;
          st0 = 3072; n0 = 256; n1 = 0;
        }
        attn_job<2, 128, false>(smem, big + tq * 3072 + h * 128, 3072, k0, v0, st0, n0,
                                big + tk * 3072 + 1024 + h * 128, big + tk * 3072 + 2048 + h * 128, 3072, n1,
                                nullptr, 0, 0, lam, 1.f - lam_init, p.in[32] + o * 128,
                                mix + tq * 1024 + h * 128, 1024);
      }
    }
    xcd_barrier(xb);
    for (int g = 0; g < 2; ++g) {
      if (g == 1) {
        for (int lj = bid >> 3; lj < 512; lj += (nb >> 3)) norm_job(p, (bid & 7) * 512 + lj, p.in[12] + l * 1024, modl, 3);
        xcd_barrier(xb);
        for (int rep = 0; rep < NREP(9); ++rep)
        if (PHON(9)) gemm_phase<0, 3, 256>(p, smem, mix, 1024, (const u16*)(p.ws + WS_W13) + (long)l * 5632 * 1024, 5632,
                                      nullptr, modl, 3, 0, 0, big);
        xcd_barrier(xb);
      }
      const u16* A2 = g == 0 ? mix : big;
      const int K2 = g == 0 ? 1024 : 2816;
      const u16* B2 = g == 0 ? (even ? (const u16*)(p.ws + WS_WOE) + (long)sub * 1024 * 1024 : (const u16*)(p.ws + WS_WOD) + (long)sub * 1024 * 1024)
                             : (const u16*)(p.ws + WS_W2) + (long)l * 1024 * 2816;
      if (PHON(6)) gemm_phase<0, 2, 256>(p, smem, A2, K2, B2, 1024, nullptr, modl, 0, g == 0 ? 2 : 5, 0, nullptr);
      xcd_barrier(xb);
    }
  }
  if (PHON(10)) for (int lj = bid >> 3; lj < 512; lj += (nb >> 3)) final_job(p, (bid & 7) * 512 + lj);
}

extern "C" void kernel_launch(void* const* d_in, const int* in_sizes, int n_in, void* d_out, int out_size,
                              void* d_ws, size_t ws_size, hipStream_t stream) {
  static int grid_blocks = 0;
  if (!grid_blocks) {
    int dev = 0, cus = 0, per_cu = 0;
    (void)hipGetDevice(&dev);
    (void)hipDeviceGetAttribute(&cus, hipDeviceAttributeMultiprocessorCount, dev);
    (void)hipOccupancyMaxActiveBlocksPerMultiprocessor(&per_cu, fwd_megakernel, 256, 0);
    (void)per_cu;
    grid_blocks = cus * 2;
  }
  if (ws_size < (size_t)WS_TOTAL) { fprintf(stderr, "workspace too small: %zu < %ld\n", ws_size, (long)WS_END); return; }
  P p{};
  for (int i = 0; i < 36; ++i) p.in[i] = (const float*)d_in[i];
  p.out = (float*)d_out;
  p.ws = (char*)d_ws;
  (void)hipMemsetAsync((char*)d_ws + WS_BAR, 0, XCD_BAR_WORDS * 4, stream);
  void* args[] = {&p};
  hipError_t e = hipLaunchCooperativeKernel((void*)fwd_megakernel, dim3(grid_blocks), dim3(256), args, 0, stream);
  if (e != hipSuccess) fprintf(stderr, "cooperative launch failed: %s (grid %d)\n", hipGetErrorString(e), grid_blocks);
}
```

```cpp
#include <hip/hip_runtime.h>
#include <hip/hip_cooperative_groups.h>
#include <cstdio>
namespace cg = cooperative_groups;

typedef unsigned short u16;
typedef __attribute__((ext_vector_type(8))) short bf16x8;
typedef __attribute__((ext_vector_type(4))) float f32x4;
typedef __attribute__((ext_vector_type(4))) unsigned u32x4;
typedef __attribute__((ext_vector_type(2))) unsigned u32x2;

#define NTOK 16384
#define NCTX 8192
#define OUT_NAK 16777216L
#define OUT_NAV 25165824L
#define OUT_ST  33554432L
#define OUT_DK  37748736L
#define OUT_DV  54525952L
#define WS_WIN   0L
#define WS_WOE   13631488L
#define WS_WQKV  17825792L
#define WS_WOD   30408704L
#define WS_W13   34603008L
#define WS_W2    80740352L
#define WS_CNK   103809024L
#define WS_CNV   105906176L
#define WS_CDK   108003328L
#define WS_CDV   112197632L
#define WS_MOD   116391936L
#define WS_ROWSS 116686848L
#define WS_RKB   117735424L
#define WS_MIX   118784000L
#define WS_BIG   152338432L
#define WS_TB    261390336L
#define WS_QT    328499200L
#define WS_END   395608064L
#define WS_BAR   395624448L
#define WS_WT    395640832L
#define WS_TOTAL 396165120L

struct P {
  const float* in[36];
  float* out;
  char* ws;
};

#define SMEM_BYTES 61440

typedef __attribute__((ext_vector_type(2))) float f32x2_t;
typedef __attribute__((ext_vector_type(2))) __bf16 bf16x2_t;
__device__ __forceinline__ u16 f2bf(float f) { return __builtin_bit_cast(u16, (__bf16)f); }
__device__ __forceinline__ float bf2f(u16 h) { return __uint_as_float(((unsigned)h) << 16); }
__device__ __forceinline__ unsigned pack2(float a, float b) {
  const f32x2_t v = {a, b};
  return __builtin_bit_cast(unsigned, __builtin_convertvector(v, bf16x2_t));
}
template <int CTRL>
__device__ __forceinline__ float dpp_mov(float v) {
  return __int_as_float(__builtin_amdgcn_update_dpp(0, __float_as_int(v), CTRL, 0xf, 0xf, false));
}
__device__ __forceinline__ float g16_sum(float v) {
  v += dpp_mov<0xB1>(v);
  v += dpp_mov<0x4E>(v);
  v += dpp_mov<0x124>(v);
  v += dpp_mov<0x128>(v);
  return v;
}
__device__ __forceinline__ float g16_max(float v) {
  v = fmaxf(v, dpp_mov<0xB1>(v));
  v = fmaxf(v, dpp_mov<0x4E>(v));
  v = fmaxf(v, dpp_mov<0x124>(v));
  v = fmaxf(v, dpp_mov<0x128>(v));
  return v;
}
__device__ __forceinline__ float wave_sum(float v) {
  v = g16_sum(v);
  const float r0 = __int_as_float(__builtin_amdgcn_readlane(__float_as_int(v), 0));
  const float r1 = __int_as_float(__builtin_amdgcn_readlane(__float_as_int(v), 16));
  const float r2 = __int_as_float(__builtin_amdgcn_readlane(__float_as_int(v), 32));
  const float r3 = __int_as_float(__builtin_amdgcn_readlane(__float_as_int(v), 48));
  return (r0 + r1) + (r2 + r3);
}
__device__ __forceinline__ int otid() { int t = threadIdx.x; asm volatile("" : "+v"(t)); return t; }
__device__ __forceinline__ float sigmoidf_(float x) { return __builtin_amdgcn_rcpf(1.f + __expf(-x)); }

struct ConvT { const float* src; u16* dst; int K, N, mode, kt, nt; };
__device__ __forceinline__ ConvT conv_params(const P& p, int job) {
  ConvT c;
  if (job < 1664) {
    int e = job / 832, r = job % 832;
    c.src = p.in[14] + (long)e * 1024 * 3328; c.K = 1024; c.N = 3328; c.dst = (u16*)(p.ws + WS_WIN) + (long)e * 3328 * 1024; c.mode = 0; c.kt = r / 52; c.nt = r % 52;
    return c;
  }
  job -= 1664;
  if (job < 512) {
    int e = job / 256, r = job % 256;
    c.src = p.in[15] + (long)e * 1024 * 1024; c.K = 1024; c.N = 1024; c.dst = (u16*)(p.ws + WS_WOE) + (long)e * 1024 * 1024; c.mode = 0; c.kt = r / 16; c.nt = r % 16;
    return c;
  }
  job -= 512;
  if (job < 1536) {
    int e = job / 768, r = job % 768;
    c.src = p.in[28] + (long)e * 1024 * 3072; c.K = 1024; c.N = 3072; c.dst = (u16*)(p.ws + WS_WQKV) + (long)e * 3072 * 1024; c.mode = 0; c.kt = r / 48; c.nt = r % 48;
    return c;
  }
  job -= 1536;
  if (job < 512) {
    int e = job / 256, r = job % 256;
    c.src = p.in[29] + (long)e * 1024 * 1024; c.K = 1024; c.N = 1024; c.dst = (u16*)(p.ws + WS_WOD) + (long)e * 1024 * 1024; c.mode = 0; c.kt = r / 16; c.nt = r % 16;
    return c;
  }
  job -= 512;
  if (job < 2816) {
    int l = job / 704, r = job % 704;
    c.src = p.in[33] + (long)l * 1024 * 2816; c.K = 1024; c.N = 2816; c.dst = (u16*)(p.ws + WS_W13) + (long)l * 5632 * 1024; c.mode = 1; c.kt = r / 44; c.nt = r % 44;
    return c;
  }
  job -= 2816;
  if (job < 2816) {
    int l = job / 704, r = job % 704;
    c.src = p.in[34] + (long)l * 1024 * 2816; c.K = 1024; c.N = 2816; c.dst = (u16*)(p.ws + WS_W13) + (long)l * 5632 * 1024; c.mode = 2; c.kt = r / 44; c.nt = r % 44;
    return c;
  }
  job -= 2816;
  {
    int l = job / 704, r = job % 704;
    c.src = p.in[35] + (long)l * 2816 * 1024; c.K = 2816; c.N = 1024; c.dst = (u16*)(p.ws + WS_W2) + (long)l * 1024 * 2816; c.mode = 0; c.kt = r / 16; c.nt = r % 16;
  }
  return c;
}
__device__ __forceinline__ void conv_job(const P& p, char* smem, int job2) {
  const int tid = otid();
  float* tile = (float*)smem;
  ConvT c[2];
  c[0] = conv_params(p, 2 * job2);
  c[1] = conv_params(p, 2 * job2 + 1);
  float v[2][16];
#pragma unroll
  for (int t = 0; t < 2; ++t)
#pragma unroll
    for (int i = 0; i < 16; ++i) {
      const int kl = (tid >> 6) + 4 * i, nl = tid & 63;
      v[t][i] = c[t].src[(long)(c[t].kt * 64 + kl) * c[t].N + c[t].nt * 64 + nl];
    }
  __syncthreads();
#pragma unroll
  for (int t = 0; t < 2; ++t)
#pragma unroll
    for (int i = 0; i < 16; ++i) {
      const int kl = (tid >> 6) + 4 * i, nl = tid & 63;
      tile[t * 4160 + kl * 65 + nl] = v[t][i];
    }
  __syncthreads();
#pragma unroll
  for (int t = 0; t < 2; ++t)
#pragma unroll
    for (int i = 0; i < 2; ++i) {
      const int task = tid + 256 * i;
      const int kg = task & 7, nl = task >> 3;
      const int n = c[t].nt * 64 + nl;
      int nd = n;
      if (c[t].mode == 1) nd = (n >> 5) * 64 + (n & 31);
      else if (c[t].mode == 2) nd = (n >> 5) * 64 + 32 + (n & 31);
      const float* tt = tile + t * 4160;
      u32x4 o;
      o.x = pack2(tt[(kg * 8 + 0) * 65 + nl], tt[(kg * 8 + 1) * 65 + nl]);
      o.y = pack2(tt[(kg * 8 + 2) * 65 + nl], tt[(kg * 8 + 3) * 65 + nl]);
      o.z = pack2(tt[(kg * 8 + 4) * 65 + nl], tt[(kg * 8 + 5) * 65 + nl]);
      o.w = pack2(tt[(kg * 8 + 6) * 65 + nl], tt[(kg * 8 + 7) * 65 + nl]);
      *(u32x4*)(c[t].dst + (long)nd * c[t].K + c[t].kt * 64 + kg * 8) = o;
    }
}
#define N_CONV_JOBS 6336

__device__ __forceinline__ void adaln_job(const P& p, char* smem, int job) {
  const int l = job / 96, cgp = job % 96;
  const int tid = otid();
  float* sil = (float*)smem;
  float* red = sil + 3072;
  __syncthreads();
  for (int i = tid; i < 3072; i += 256) {
    int v = i >> 10, k = i & 1023;
    float c = (v == 0) ? p.in[8][k] : p.in[2][(v - 1) * 1024 + k];
    sil[i] = c * sigmoidf_(c);
  }
  __syncthreads();
  const int kq = tid >> 6, cl = tid & 63;
  const float* w = p.in[9] + (long)l * 1024 * 6144 + cgp * 64 + cl;
  float a0 = 0.f, a1 = 0.f, a2 = 0.f;
#pragma unroll 16
  for (int k = kq * 256; k < kq * 256 + 256; ++k) {
    float wv = w[(long)k * 6144];
    a0 += sil[k] * wv; a1 += sil[1024 + k] * wv; a2 += sil[2048 + k] * wv;
  }
  red[(kq * 3 + 0) * 64 + cl] = a0; red[(kq * 3 + 1) * 64 + cl] = a1; red[(kq * 3 + 2) * 64 + cl] = a2;
  __syncthreads();
  if (tid < 192) {
    int v = tid >> 6;
    float s = red[(0 * 3 + v) * 64 + cl] + red[(1 * 3 + v) * 64 + cl] + red[(2 * 3 + v) * 64 + cl] + red[(3 * 3 + v) * 64 + cl];
    s += p.in[10][l * 6144 + cgp * 64 + cl];
    ((float*)(p.ws + WS_MOD))[(l * 3 + v) * 6144 + cgp * 64 + cl] = s;
  }
}

__device__ __forceinline__ void cachecvt_job(const P& p, int job) {
  const float* src; u16* dst; int j;
  if (job < 512) { src = p.in[3]; dst = (u16*)(p.ws + WS_CNK); j = job; }
  else if (job < 1024) { src = p.in[4]; dst = (u16*)(p.ws + WS_CNV); j = job - 512; }
  else if (job < 2048) { src = p.in[6]; dst = (u16*)(p.ws + WS_CDK); j = job - 1024; }
  else { src = p.in[7]; dst = (u16*)(p.ws + WS_CDV); j = job - 2048; }
  long off = (long)j * 2048 + otid() * 8;
  float4 a = *(const float4*)(src + off), b = *(const float4*)(src + off + 4);
  uint4 v; v.x = pack2(a.x, a.y); v.y = pack2(a.z, a.w); v.z = pack2(b.x, b.y); v.w = pack2(b.z, b.w);
  *(uint4*)(dst + off) = v;
}


__device__ __forceinline__ void loracvt_job(const P& p, int job) {
  u16* dst = (u16*)(p.ws + WS_WT);
#pragma unroll
  for (int i = 0; i < 8; ++i) {
    const int g = job * 2048 + i * 256 + otid();
    const int k = g & 63, n = (g >> 6) & 511, mat = (g >> 15) & 1, ed = g >> 16;
    const float* src = mat ? p.in[21] : p.in[19];
    dst[g] = f2bf(src[((long)ed * 64 + k) * 512 + n]);
  }
}

__device__ __forceinline__ void xcopy_job(const P& p, int job) {
  const int row = job * 4 + (otid() >> 6), lane = otid() & 63;
  const float* src = (row < NCTX) ? p.in[0] + (long)row * 1024 : p.in[1] + (long)(row - NCTX) * 1024;
  float* dst = p.out + (long)row * 1024;
  float ss = 0.f;
#pragma unroll
  for (int i = 0; i < 4; ++i) {
    float4 v = *(const float4*)(src + (i * 64 + lane) * 4);
    ss += v.x * v.x + v.y * v.y + v.z * v.z + v.w * v.w;
    *(float4*)(dst + (i * 64 + lane) * 4) = v;
  }
}

template <int AM, int EPI, int BM>
__device__ __forceinline__ void gemm_phase(const P& p, char* smem, const void* Aptr, int K, const u16* Bt, int N,
                           const float* gvec, const float* modl, int shift_idx, int gate_idx, int sub, u16* dst) {
  const int tid = otid(), lane = tid & 63, wave = tid >> 6, wm = wave >> 1, wn = wave & 1;
  const int quad = lane >> 4, l16 = lane & 15;
  u16* As = (u16*)smem;
  u16* Bs = As + BM * 80;
  constexpr int MI = BM / 32;
  const int NT = N >> 7, ntiles = (16384 / BM) * NT, ntk = K >> 6;
  float* X = p.out;
  const float* rowss = (const float*)(p.ws + WS_ROWSS);
  const int MPX = (16384 / BM) / 8, LB = gridDim.x >> 3, xcd = blockIdx.x & 7;
  (void)ntiles;
  for (int lt = blockIdx.x >> 3; lt < MPX * NT; lt += LB) {
    const int mt = xcd * MPX + lt % MPX, nt = lt / MPX;
    const int row0 = mt * BM, col0 = nt * 128;
    const int grp = row0 < NCTX ? 0 : 1 + ((row0 - NCTX) >> 12);
    const float* modv = modl + grp * 6144;
    f32x4 acc[MI][4];
#pragma unroll
    for (int i = 0; i < MI; ++i)
#pragma unroll
      for (int j = 0; j < 4; ++j) acc[i][j] = (f32x4){0.f, 0.f, 0.f, 0.f};
    f32x4 ar[8]; u32x4 ab[MI]; u32x4 bb[4]; float rinv[8];
    if (AM == 1) {
#pragma unroll
      for (int i = 0; i < 8; ++i) {
        const float4* rp = (const float4*)(rowss + (long)(row0 + (tid >> 4) + 16 * i) * 16);
        float4 s0 = rp[0], s1 = rp[1], s2 = rp[2], s3 = rp[3];
        float s = (s0.x + s0.y + s0.z + s0.w) + (s1.x + s1.y + s1.z + s1.w) + (s2.x + s2.y + s2.z + s2.w) + (s3.x + s3.y + s3.z + s3.w);
        rinv[i] = rsqrtf(s * (1.f / 1024.f) + 1e-6f);
      }
    }
    if (AM == 1) {
#pragma unroll
      for (int i = 0; i < 8; ++i)
        ar[i] = *(const f32x4*)((const float*)Aptr + (long)(row0 + (tid >> 4) + 16 * i) * 1024 + (tid & 15) * 4);
    } else {
#pragma unroll
      for (int i = 0; i < MI; ++i)
        ab[i] = *(const u32x4*)((const u16*)Aptr + (long)(row0 + (tid >> 3) + 32 * i) * K + (tid & 7) * 8);
    }
#pragma unroll
    for (int i = 0; i < 4; ++i)
      bb[i] = *(const u32x4*)(Bt + (long)(col0 + (tid >> 3) + 32 * i) * K + (tid & 7) * 8);

    for (int kt = 0; kt < ntk; ++kt) {
      __syncthreads();
      if (AM == 1) {
        const int k = kt * 64 + (tid & 15) * 4;
        float4 g = *(const float4*)(gvec + k);
        float4 sc = *(const float4*)(modv + (shift_idx + 1) * 1024 + k);
        float4 sh = *(const float4*)(modv + shift_idx * 1024 + k);
        g.x *= (1.f + sc.x); g.y *= (1.f + sc.y); g.z *= (1.f + sc.z); g.w *= (1.f + sc.w);
#pragma unroll
        for (int i = 0; i < 8; ++i) {
          float r = rinv[i];
          u32x2 v;
          v.x = pack2(ar[i].x * r * g.x + sh.x, ar[i].y * r * g.y + sh.y);
          v.y = pack2(ar[i].z * r * g.z + sh.z, ar[i].w * r * g.w + sh.w);
          *(u32x2*)(As + ((tid >> 4) + 16 * i) * 80 + (tid & 15) * 4) = v;
        }
      } else {
#pragma unroll
        for (int i = 0; i < MI; ++i) *(u32x4*)(As + ((tid >> 3) + 32 * i) * 80 + (tid & 7) * 8) = ab[i];
      }
#pragma unroll
      for (int i = 0; i < 4; ++i) *(u32x4*)(Bs + ((tid >> 3) + 32 * i) * 80 + (tid & 7) * 8) = bb[i];
      __syncthreads();
      if (kt + 1 < ntk) {
        const int kn = (kt + 1) * 64;
        if (AM == 1) {
#pragma unroll
          for (int i = 0; i < 8; ++i)
            ar[i] = *(const f32x4*)((const float*)Aptr + (long)(row0 + (tid >> 4) + 16 * i) * 1024 + kn + (tid & 15) * 4);
        } else {
#pragma unroll
          for (int i = 0; i < MI; ++i)
            ab[i] = *(const u32x4*)((const u16*)Aptr + (long)(row0 + (tid >> 3) + 32 * i) * K + kn + (tid & 7) * 8);
        }
#pragma unroll
        for (int i = 0; i < 4; ++i)
          bb[i] = *(const u32x4*)(Bt + (long)(col0 + (tid >> 3) + 32 * i) * K + kn + (tid & 7) * 8);
      }
      __builtin_amdgcn_sched_barrier(0);
#pragma unroll
      for (int ks = 0; ks < 2; ++ks) {
        bf16x8 b[4];
#pragma unroll
        for (int i = 0; i < 4; ++i) b[i] = *(const bf16x8*)(Bs + (wn * 64 + i * 16 + l16) * 80 + ks * 32 + quad * 8);
#pragma unroll
        for (int i = 0; i < MI; ++i) {
          const bf16x8 a = *(const bf16x8*)(As + (wm * (BM / 2) + i * 16 + l16) * 80 + ks * 32 + quad * 8);
#pragma unroll
          for (int j = 0; j < 4; ++j) acc[i][j] = __builtin_amdgcn_mfma_f32_16x16x32_bf16(b[j], a, acc[i][j], 0, 0, 0);
        }
      }
    }
    const int cw = col0 + wn * 64;
    if (EPI == 0) {
      const int e = sub;
#pragma unroll
      for (int mi = 0; mi < MI; ++mi) {
        const int row = row0 + wm * (BM / 2) + mi * 16 + l16;
#pragma unroll
        for (int ni = 0; ni < 4; ++ni) {
          const int col = cw + ni * 16 + quad * 4;
          const f32x4 v = acc[mi][ni];
          u32x2 o; o.x = pack2(v[0], v[1]); o.y = pack2(v[2], v[3]);
          *(u32x2*)(dst + (long)row * 3328 + col) = o;
          if (row < NCTX && cw >= 512 && cw < 1536) {
            const int b = row >> 8, t = row & 255;
            if (cw < 1024) *(f32x4*)(p.out + OUT_NAK + ((long)((b * 2 + e) * 256 + t)) * 512 + col - 512) = v;
            else *(f32x4*)(p.out + OUT_NAV + ((long)((b * 2 + e) * 256 + t)) * 512 + col - 1024) = v;
          }
        }
      }
    } else if (EPI == 1) {
      const int o = sub;
      float inv[4];
#pragma unroll
      for (int j = 0; j < 4; ++j) inv[j] = exp2f(-(float)(quad * 4 + j) * (13.287712379549449f / 16.f));
#pragma unroll
      for (int mi = 0; mi < MI; ++mi) {
        const int row = row0 + wm * (BM / 2) + mi * 16 + l16;
        f32x4 v0 = acc[mi][0], v1 = acc[mi][1], v2 = acc[mi][2], v3 = acc[mi][3];
        if (row >= NCTX && cw < 2048) {
          const int tp = (row - NCTX) & 4095;
#pragma unroll
          for (int j = 0; j < 4; ++j) {
            const float a0 = (float)(tp >> 6) * inv[j], a1 = (float)(tp & 63) * inv[j];
            const float c0 = __cosf(a0), s0 = __sinf(a0), c1 = __cosf(a1), s1 = __sinf(a1);
            const float n0 = v0[j] * c0 - v1[j] * s0, n1 = v0[j] * s0 + v1[j] * c0;
            const float n2 = v2[j] * c1 - v3[j] * s1, n3 = v2[j] * s1 + v3[j] * c1;
            v0[j] = n0; v1[j] = n1; v2[j] = n2; v3[j] = n3;
          }
        }
        f32x4 vv[4] = {v0, v1, v2, v3};
#pragma unroll
        for (int ni = 0; ni < 4; ++ni) {
          const int col = cw + ni * 16 + quad * 4;
          u32x2 ob; ob.x = pack2(vv[ni][0], vv[ni][1]); ob.y = pack2(vv[ni][2], vv[ni][3]);
          *(u32x2*)(dst + (long)row * 3072 + col) = ob;
          if (row < NCTX && cw >= 1024) {
            const int b = row >> 8, t = row & 255;
            if (cw < 2048) *(f32x4*)(p.out + OUT_DK + ((long)((b * 2 + o) * 256 + t)) * 1024 + col - 1024) = vv[ni];
            else *(f32x4*)(p.out + OUT_DV + ((long)((b * 2 + o) * 256 + t)) * 1024 + col - 2048) = vv[ni];
          }
        }
      }
    } else if (EPI == 2) {
      f32x4 gt[4];
#pragma unroll
      for (int ni = 0; ni < 4; ++ni) gt[ni] = *(const f32x4*)(modv + gate_idx * 1024 + cw + ni * 16 + quad * 4);
#pragma unroll
      for (int mi = 0; mi < MI; ++mi) {
        const int row = row0 + wm * (BM / 2) + mi * 16 + l16;
#pragma unroll
        for (int ni = 0; ni < 4; ++ni) {
          f32x4* xp = (f32x4*)(X + (long)row * 1024 + cw + ni * 16 + quad * 4);
          *xp = *xp + gt[ni] * acc[mi][ni];
        }
      }
    } else {
#pragma unroll
      for (int mi = 0; mi < MI; ++mi) {
        const int row = row0 + wm * (BM / 2) + mi * 16 + l16;
#pragma unroll
        for (int ni = 0; ni < 2; ++ni) {
          const f32x4 a = acc[mi][ni], b = acc[mi][ni + 2];
          u32x2 ob;
          ob.x = pack2(a[0] * sigmoidf_(a[0]) * b[0], a[1] * sigmoidf_(a[1]) * b[1]);
          ob.y = pack2(a[2] * sigmoidf_(a[2]) * b[2], a[3] * sigmoidf_(a[3]) * b[3]);
          *(u32x2*)(dst + (long)row * 2816 + (cw >> 1) + ni * 16 + quad * 4) = ob;
        }
      }
    }
  }
}

__device__ __forceinline__ unsigned cvt_pk_bf16(float lo, float hi) { return pack2(lo, hi); }
typedef __attribute__((ext_vector_type(2))) unsigned u32pair_t;
__device__ __forceinline__ float xq_max(float v) {
  const unsigned x = __float_as_uint(v);
  const u32pair_t r = __builtin_amdgcn_permlane16_swap(x, x, false, false);
  const float m = fmaxf(__uint_as_float(r.x), __uint_as_float(r.y));
  const unsigned y = __float_as_uint(m);
  const u32pair_t q = __builtin_amdgcn_permlane32_swap(y, y, false, false);
  return fmaxf(__uint_as_float(q.x), __uint_as_float(q.y));
}
__device__ __forceinline__ float xq_sum(float v) {
  const unsigned x = __float_as_uint(v);
  const u32pair_t r = __builtin_amdgcn_permlane16_swap(x, x, false, false);
  const float m = __uint_as_float(r.x) + __uint_as_float(r.y);
  const unsigned y = __float_as_uint(m);
  const u32pair_t q = __builtin_amdgcn_permlane32_swap(y, y, false, false);
  return __uint_as_float(q.x) + __uint_as_float(q.y);
}
template <int NS, int DV, bool LOCAL>
__device__ __forceinline__ void attn_job(char* smem, const u16* qp, int qst,
                         const u16* k0, const u16* v0, int st0, int n0,
                         const u16* k1, const u16* v1, int st1, int n1,
                         const float* rpbh, int qi, int r0,
                         float lam, float outscale, const float* subln,
                         u16* op, int ost) {
  constexpr int KD = NS * 64, KST = KD + 16, KCH = KD / 8;
  u16* Ks = (u16*)smem;
  constexpr int VST = DV + 8, VCH = DV / 8;
  u16* Vs = Ks + 64 * KST;
  u16* Ps = Vs + 64 * VST;
  const int tid = otid(), lane = tid & 63, wave = tid >> 6, quad = lane >> 4, l16 = lane & 15;
  constexpr float C2 = 0.125f * 1.4426950408889634f;
  bf16x8 qf[NS][2];
#pragma unroll
  for (int s = 0; s < NS; ++s)
#pragma unroll
    for (int ks = 0; ks < 2; ++ks)
      qf[s][ks] = *(const bf16x8*)(qp + (long)(wave * 16 + l16) * qst + s * 64 + ks * 32 + quad * 8);
  float m[NS], l[NS];
  f32x4 O[NS][DV / 16];
#pragma unroll
  for (int s = 0; s < NS; ++s) {
    m[s] = -1e30f; l[s] = 0.f;
#pragma unroll
    for (int n = 0; n < DV / 16; ++n) O[s][n] = (f32x4){0.f, 0.f, 0.f, 0.f};
  }
  const int jq = wave * 16 + l16;
  int c0 = jq - 8; c0 = c0 < 0 ? 0 : (c0 > 48 ? 48 : c0);
  const int nt0 = n0 >> 6, ntot = nt0 + (n1 >> 6);
  constexpr int KPT = (64 * KCH) / 256;
  constexpr int VPT = (64 * VCH) / 256;
  u32x4 kreg[KPT];
  u32x4 vreg[VPT];
  auto load_tile = [&](int t) {
    const u16 *kp, *vp; int st;
    if (t < nt0) { kp = k0 + (long)t * 64 * st0; vp = v0 + (long)t * 64 * st0; st = st0; }
    else { kp = k1 + (long)(t - nt0) * 64 * st1; vp = v1 + (long)(t - nt0) * 64 * st1; st = st1; }
#pragma unroll
    for (int i = 0; i < KPT; ++i) {
      const int c = tid + 256 * i;
      kreg[i] = *(const u32x4*)(kp + (long)(c / KCH) * st + (c % KCH) * 8);
    }
#pragma unroll
    for (int i = 0; i < VPT; ++i) {
      const int c = tid + 256 * i;
      vreg[i] = *(const u32x4*)(vp + (long)(c / VCH) * st + (c % VCH) * 8);
    }
  };
  load_tile(0);
  for (int t = 0; t < ntot; ++t) {
    __syncthreads();
#pragma unroll
    for (int i = 0; i < KPT; ++i) {
      const int c = tid + 256 * i;
      *(u32x4*)(Ks + (c / KCH) * KST + (c % KCH) * 8) = kreg[i];
    }
#pragma unroll
    for (int i = 0; i < VPT; ++i) {
      const int c = tid + 256 * i;
      *(u32x4*)(Vs + (c / VCH) * VST + (c % VCH) * 8) = vreg[i];
    }
    __syncthreads();
    if (t + 1 < ntot) load_tile(t + 1);
    __builtin_amdgcn_sched_barrier(0);
#pragma unroll
    for (int s = 0; s < NS; ++s) {
      f32x4 sc[4];
#pragma unroll
      for (int n = 0; n < 4; ++n) {
        sc[n] = (f32x4){0.f, 0.f, 0.f, 0.f};
#pragma unroll
        for (int ks = 0; ks < 2; ++ks) {
          const bf16x8 kf = *(const bf16x8*)(Ks + (n * 16 + l16) * KST + s * 64 + ks * 32 + quad * 8);
          sc[n] = __builtin_amdgcn_mfma_f32_16x16x32_bf16(kf, qf[s][ks], sc[n], 0, 0, 0);
        }
      }
      float mx = -1e30f;
#pragma unroll
      for (int n = 0; n < 4; ++n)
#pragma unroll
        for (int j = 0; j < 4; ++j) {
          float v = sc[n][j] * C2;
          if (LOCAL) {
            if (t >= nt0) {
              const int kr = r0 + (t - nt0), kc = n * 16 + quad * 4 + j;
              const bool ok = (kc >= c0) && (kc < c0 + 16);
              const float bias = rpbh[ok ? ((kr - qi + 7) * 31 + (kc - jq + 15)) : 0];
              v = ok ? v + bias * 1.4426950408889634f : -1e30f;
            }
          }
          sc[n][j] = v;
          mx = fmaxf(mx, v);
        }
      mx = xq_max(mx);
      const float mn = fmaxf(m[s], mx);
      if (__builtin_amdgcn_ballot_w64(mn > m[s]) != 0ull) {
        const float corr = __builtin_amdgcn_exp2f(m[s] - mn);
        l[s] *= corr;
#pragma unroll
        for (int n = 0; n < DV / 16; ++n) O[s][n] *= corr;
        m[s] = mn;
      }
      float rs = 0.f;
#pragma unroll
      for (int n = 0; n < 4; ++n) {
        const float p0 = __builtin_amdgcn_exp2f(sc[n][0] - mn), p1 = __builtin_amdgcn_exp2f(sc[n][1] - mn);
        const float p2 = __builtin_amdgcn_exp2f(sc[n][2] - mn), p3 = __builtin_amdgcn_exp2f(sc[n][3] - mn);
        rs += (p0 + p1) + (p2 + p3);
        u32x2 pk; pk.x = cvt_pk_bf16(p0, p1); pk.y = cvt_pk_bf16(p2, p3);
        *(u32x2*)(Ps + ((wave * NS + s) * 16 + l16) * 80 + n * 16 + quad * 4) = pk;
      }
      l[s] += rs;
    }
    __builtin_amdgcn_wave_barrier();
    {
      bf16x8 pf[NS][2];
#pragma unroll
      for (int s = 0; s < NS; ++s)
#pragma unroll
        for (int ks = 0; ks < 2; ++ks)
          pf[s][ks] = *(const bf16x8*)(Ps + ((wave * NS + s) * 16 + l16) * 80 + ks * 32 + quad * 8);
#pragma unroll
      for (int ks = 0; ks < 2; ++ks)
#pragma unroll
        for (int n = 0; n < DV / 16; ++n) {
          const u16* va = Vs + (ks * 32 + quad * 8 + (l16 >> 2)) * VST + n * 16 + (l16 & 3) * 4;
          typedef __attribute__((ext_vector_type(4))) short s16x4_t;
          const s16x4_t v0 = __builtin_amdgcn_ds_read_tr16_b64_v4i16((__attribute__((address_space(3))) s16x4_t*)va);
          const s16x4_t v1 = __builtin_amdgcn_ds_read_tr16_b64_v4i16((__attribute__((address_space(3))) s16x4_t*)(va + 4 * VST));
          const bf16x8 vf = __builtin_shufflevector(v0, v1, 0, 1, 2, 3, 4, 5, 6, 7);
#pragma unroll
          for (int s = 0; s < NS; ++s) O[s][n] = __builtin_amdgcn_mfma_f32_16x16x32_bf16(vf, pf[s][ks], O[s][n], 0, 0, 0);
        }
    }
  }
  u16* orow = op + (long)(wave * 16 + l16) * ost + quad * 4;
  if (NS == 1) {
    const float il = 1.f / xq_sum(l[0]);
#pragma unroll
    for (int n = 0; n < DV / 16; ++n) {
      u32x2 o; o.x = cvt_pk_bf16(O[0][n][0] * il, O[0][n][1] * il); o.y = cvt_pk_bf16(O[0][n][2] * il, O[0][n][3] * il);
      *(u32x2*)(orow + n * 16) = o;
    }
  } else {
    const float i0 = 1.f / xq_sum(l[0]), i1 = lam / xq_sum(l[NS - 1]);
    float ss = 0.f;
#pragma unroll
    for (int n = 0; n < DV / 16; ++n) {
      O[0][n] = O[0][n] * i0 - O[NS - 1][n] * i1;
      ss += O[0][n][0] * O[0][n][0] + O[0][n][1] * O[0][n][1] + O[0][n][2] * O[0][n][2] + O[0][n][3] * O[0][n][3];
    }
    ss = xq_sum(ss);
    const float ri = rsqrtf(ss * (1.f / (float)DV) + 1e-6f) * outscale;
#pragma unroll
    for (int n = 0; n < DV / 16; ++n) {
      const f32x4 g = *(const f32x4*)(subln + n * 16 + quad * 4);
      u32x2 o; o.x = cvt_pk_bf16(O[0][n][0] * ri * g[0], O[0][n][1] * ri * g[1]); o.y = cvt_pk_bf16(O[0][n][2] * ri * g[2], O[0][n][3] * ri * g[3]);
      *(u32x2*)(orow + n * 16) = o;
    }
  }
}

__device__ __forceinline__ float* yl_ptr(const P& p, int tok, int d, int col) {
  const int slab = tok >> 8;
  return p.out + OUT_DK + (long)(slab >> 5) * 16777216L + ((long)(((slab & 31) * 2 + 1) * 256 + (tok & 255))) * 1024 + d * 512 + col;
}
__device__ __forceinline__ float* tb_ptr(const P& p, int unit, int d, int isB) {
  return (float*)(p.ws + WS_TB) + ((long)((unit * 2 + d) * 2 + isB)) * 4096;
}
__device__ __forceinline__ float ushift(const u16* proj, const float* mu, int tok, int seq0, int slen, int c) {
  const u16* pp = proj + (long)tok * 3328 + 1536 + c;
  const bool hp = tok > seq0, hn = tok < seq0 + slen - 1;
  const float cur = bf2f(pp[0]);
  const float pv = bf2f(pp[hp ? -3328 : 0]);
  const float nv = bf2f(pp[hn ? 3328 : 0]);
  const float prev = hp ? pv : 0.f;
  const float next = hn ? nv : 0.f;
  return cur + mu[c] * (prev - cur) + mu[1792 + c] * (next - cur);
}

__device__ __forceinline__ void rwkv_scan_unit(const P& p, char* smem, int e, int unit) {
  const int gch = unit >> 3, h = unit & 7;
  int seq0, slen;
  if (gch < 64) { seq0 = (gch >> 1) * 256; slen = 256; } else { seq0 = NCTX + ((gch - 64) >> 5) * 4096; slen = 4096; }
  const int t0 = gch * 128;
  float* sc = (float*)smem;
  const u16* proj = (const u16*)(p.ws + WS_BIG);
  const float* mu = p.in[17] + e * 2 * 1792;
  const float* w0 = p.in[18] + e * 1024;
  const float* w2 = p.in[19] + (long)e * 2 * 64 * 512;
  const float* a0 = p.in[20] + e * 1024;
  const float* a2 = p.in[21] + (long)e * 2 * 64 * 512;
  const float* kkw = p.in[22] + e * 512;
  const float* kaw = p.in[23] + e * 512;
  const float* bonus = p.in[24] + e * 1024;
  float* rkb = (float*)(p.ws + WS_RKB);
  float* qt = (float*)(p.ws + WS_QT);
  const int tid = otid(), lane = tid & 63, wave = tid >> 6;
  const int sd = wave >> 1; const bool isB = (wave & 1) != 0;
  const int pd = tid >> 7, th = (tid >> 6) & 1;
  float S[64];
#pragma unroll
  for (int j = 0; j < 64; ++j) S[j] = (!isB && j == lane) ? 1.f : 0.f;
  const int hc = h * 64 + lane;
  const float kkwj = kkw[hc], kawj = kaw[hc], bonj = bonus[pd * 512 + hc], w0j = w0[pd * 512 + hc], a0j = a0[pd * 512 + hc];

  u16* raw = (u16*)(smem + 49152);
  u32x4 rg[3];
  auto load_raw = [&](int lo) {
#pragma unroll
    for (int i = 0; i < 3; ++i) {
      const int c = tid + 256 * i;
      u32x4 v = (u32x4){0u, 0u, 0u, 0u};
      if (c < 720) {
        const int row = c / 40, cc = c % 40, vec = cc >> 3, ch = cc & 7;
        const int tok = lo + row;
        const int voff = (vec < 3) ? (vec * 512 + h * 64) : (1536 + (vec - 3) * 64);
        const int tokc = tok < seq0 ? seq0 : (tok > seq0 + slen - 1 ? seq0 + slen - 1 : tok);
        const u32x4 ld = *(const u32x4*)(proj + (long)tokc * 3328 + 1536 + voff + ch * 8);
        const bool inb = (tok >= seq0) && (tok < seq0 + slen);
        v.x = inb ? ld.x : 0u; v.y = inb ? ld.y : 0u; v.z = inb ? ld.z : 0u; v.w = inb ? ld.w : 0u;
      }
      rg[i] = v;
    }
  };
  auto store_raw = [&]() {
#pragma unroll
    for (int i = 0; i < 3; ++i) {
      const int c = tid + 256 * i;
      if (c < 720) {
        const int row = c / 40, cc = c % 40;
        *(u32x4*)(raw + row * 320 + cc * 8) = rg[i];
      }
    }
  };
  auto shift_dir = [&](int d) {
    float mu0v[5], mu1v[5];
#pragma unroll
    for (int v = 0; v < 5; ++v) {
      const int c = (v < 3) ? (v * 512 + h * 64 + lane) : (1536 + (v - 3) * 64 + lane);
      mu0v[v] = mu[c]; mu1v[v] = mu[1792 + c];
    }
#pragma unroll
    for (int vec = 0; vec < 5; ++vec)
#pragma unroll
      for (int k = 0; k < 4; ++k) {
        const int pslot = wave + 4 * k;
        const int row = (d == 0) ? pslot + 1 : 16 - pslot;
        const u16* rp = raw + row * 320 + vec * 64 + lane;
        const float cur = bf2f(rp[0]), prev = bf2f(rp[-320]), next = bf2f(rp[320]);
        float val = cur + mu0v[vec] * (prev - cur) + mu1v[vec] * (next - cur);
        if (vec == 3) { const float ex = __expf(2.f * val); val = 1.f - 2.f * __builtin_amdgcn_rcpf(ex + 1.f); }
        if (vec >= 3) ((u16*)(sc + (d * 6 + 5) * 1024))[(vec - 3) * 1024 + pslot * 64 + lane] = f2bf(val);
        else sc[((d * 6 + vec) * 16 + pslot) * 64 + lane] = val;
      }
  };
  for (int sub = 0; sub < 8; ++sub) {
    load_raw(t0 + sub * 16 - 1);
    __syncthreads();
    store_raw();
    load_raw(t0 + 127 - sub * 16 - 16);
    __syncthreads();
    shift_dir(0);
    __syncthreads();
    store_raw();
    __syncthreads();
    shift_dir(1);
    __syncthreads();
    {
      const int t2 = otid(), quad = (t2 >> 4) & 3, l16 = t2 & 15, w2i = t2 >> 6, sd2 = w2i >> 1, mat = w2i & 1;
      const u16* at = (const u16*)(sc + (sd2 * 6 + 5) * 1024) + mat * 1024;
      const u16* wt = (const u16*)(p.ws + WS_WT) + ((long)((e * 2 + sd2) * 2 + mat) * 512 + h * 64) * 64;
      bf16x8 af[2];
#pragma unroll
      for (int ks = 0; ks < 2; ++ks) af[ks] = *(const bf16x8*)(at + l16 * 64 + ks * 32 + quad * 8);
#pragma unroll
      for (int nt = 0; nt < 4; ++nt) {
        f32x4 dacc = (f32x4){0.f, 0.f, 0.f, 0.f};
#pragma unroll
        for (int ks = 0; ks < 2; ++ks) {
          const bf16x8 bfr = *(const bf16x8*)(wt + (nt * 16 + l16) * 64 + ks * 32 + quad * 8);
          dacc = __builtin_amdgcn_mfma_f32_16x16x32_bf16(af[ks], bfr, dacc, 0, 0, 0);
        }
#pragma unroll
        for (int j = 0; j < 4; ++j) sc[((sd2 * 6 + 3 + mat) * 16 + quad * 4 + j) * 64 + nt * 16 + l16] = dacc[j];
      }
    }
    __syncthreads();
    {
      float* scw = sc + pd * 6 * 1024;
#pragma unroll
      for (int tk = 0; tk < 8; ++tk) {
        const int pslot = th * 8 + tk;
        const int tok = (pd == 0) ? (t0 + sub * 16 + pslot) : (t0 + 127 - sub * 16 - pslot);
        const float kv = scw[(1 * 16 + pslot) * 64 + lane];
        const float rv = scw[(0 * 16 + pslot) * 64 + lane];
        float kkv = kv * kkwj;
        const float nrm = wave_sum(kkv * kkv);
        kkv *= rsqrtf(fmaxf(nrm, 1e-12f));
        const float xw = -(w0j + scw[(3 * 16 + pslot) * 64 + lane]);
        const float sp = fmaxf(xw, 0.f) + __logf(1.f + __expf(-fabsf(xw)));
        const float decay = __expf(-__expf(-sp - 0.5f));
        const float a = sigmoidf_(a0j + scw[(4 * 16 + pslot) * 64 + lane]);
        const float kt = kv * (1.f + (a - 1.f) * kawj);
        const float bsum = wave_sum(rv * kt * bonj);
        scw[(5 * 16 + pslot) * 64 + lane] = kkv;
        scw[(3 * 16 + pslot) * 64 + lane] = decay;
        scw[(4 * 16 + pslot) * 64 + lane] = kkv * a;
        scw[(1 * 16 + pslot) * 64 + lane] = kt;
        if (lane == 0) rkb[tok * 16 + pd * 8 + h] = bsum;
      }
    }
    __syncthreads();
    if (isB || gch >= 64 || ((gch & 1) == (sd == 0 ? 1 : 0))) {
      const float* base = sc + sd * 6 * 1024;
      for (int ps = 0; ps < 16; ++ps) {
        const f32x4* kk4 = (const f32x4*)(base + (5 * 16 + ps) * 64);
        const f32x4* w4 = (const f32x4*)(base + (3 * 16 + ps) * 64);
        const f32x4* ka4 = (const f32x4*)(base + (4 * 16 + ps) * 64);
        const f32x4* kt4 = (const f32x4*)(base + (1 * 16 + ps) * 64);
        const f32x4* r4 = (const f32x4*)(base + (0 * 16 + ps) * 64);
        f32x4 kk[16];
#pragma unroll
        for (int q = 0; q < 16; ++q) kk[q] = kk4[q];
        f32x4 bw[2][2], bka[2][2], bkt[2][2], br[2][2];
#pragma unroll
        for (int q = 0; q < 2; ++q) { bw[0][q] = w4[q]; bka[0][q] = ka4[q]; br[0][q] = r4[q]; bkt[0][q] = kt4[q]; }
        const float vv = isB ? base[(2 * 16 + ps) * 64 + lane] : 0.f;
        __builtin_amdgcn_sched_barrier(0);
        float s0 = 0.f, s1 = 0.f;
#pragma unroll
        for (int q = 0; q < 16; ++q) {
          s0 += S[q * 4 + 0] * kk[q].x; s1 += S[q * 4 + 1] * kk[q].y; s0 += S[q * 4 + 2] * kk[q].z; s1 += S[q * 4 + 3] * kk[q].w;
        }
        const float nskk = -(s0 + s1);
        float y0 = 0.f, y1 = 0.f;
#pragma unroll
        for (int qq = 0; qq < 8; ++qq) {
          const int cb = qq & 1, nbf = cb ^ 1;
          if (qq < 7) {
#pragma unroll
            for (int q = 0; q < 2; ++q) {
              bw[nbf][q] = w4[(qq + 1) * 2 + q]; bka[nbf][q] = ka4[(qq + 1) * 2 + q];
              br[nbf][q] = r4[(qq + 1) * 2 + q]; bkt[nbf][q] = kt4[(qq + 1) * 2 + q];
            }
          }
          __builtin_amdgcn_sched_barrier(0);
#pragma unroll
          for (int q = 0; q < 2; ++q) {
            const int j = (qq * 2 + q) * 4;
            const f32x4 w = bw[cb][q], ka = bka[cb][q], kt = bkt[cb][q], r = br[cb][q];
            S[j + 0] = fmaf(vv, kt.x, fmaf(nskk, ka.x, S[j + 0] * w.x));
            S[j + 1] = fmaf(vv, kt.y, fmaf(nskk, ka.y, S[j + 1] * w.y));
            S[j + 2] = fmaf(vv, kt.z, fmaf(nskk, ka.z, S[j + 2] * w.z));
            S[j + 3] = fmaf(vv, kt.w, fmaf(nskk, ka.w, S[j + 3] * w.w));
            y0 += S[j + 0] * r.x; y1 += S[j + 1] * r.y; y0 += S[j + 2] * r.z; y1 += S[j + 3] * r.w;
          }
        }
        const int tok = (sd == 0) ? (t0 + sub * 16 + ps) : (t0 + 127 - sub * 16 - ps);
        const float y = y0 + y1;
        if (isB) *yl_ptr(p, tok, sd, hc) = y;
        else qt[((long)tok * 2 + sd) * 512 + hc] = y;
      }
    }
  }
  float4* tp = (float4*)(tb_ptr(p, unit, sd, isB ? 1 : 0) + lane * 64);
#pragma unroll
  for (int q = 0; q < 16; ++q) tp[q] = make_float4(S[q * 4], S[q * 4 + 1], S[q * 4 + 2], S[q * 4 + 3]);
}

__device__ __forceinline__ void rwkv_e3_job(const P& p, char* smem, int e, int job) {
  float* Ss = (float*)smem;
  const int tid = otid(), r = tid >> 4, cgp = tid & 15;
  __syncthreads();
  if (job < 2048) {
    const int chain = job >> 2, rg = job & 3, row = rg * 16 + r;
    const int seq = chain >> 4, h = (chain >> 1) & 7, d = chain & 1;
    const int first = seq * 2 + (d == 0 ? 0 : 1), second = seq * 2 + (d == 0 ? 1 : 0);
    const float* Bf = tb_ptr(p, first * 8 + h, d, 1);
    const float* Ts = tb_ptr(p, second * 8 + h, d, 0);
    const float* Bs = tb_ptr(p, second * 8 + h, d, 1);
    *(float4*)(Ss + r * 64 + cgp * 4) = *(const float4*)(Bf + row * 64 + cgp * 4);
    __syncthreads();
    float4 acc = *(const float4*)(Bs + row * 64 + cgp * 4);
#pragma unroll 8
    for (int i = 0; i < 64; ++i) {
      const float s = Ss[r * 64 + i];
      const float4 t = *(const float4*)(Ts + i * 64 + cgp * 4);
      acc.x += s * t.x; acc.y += s * t.y; acc.z += s * t.z; acc.w += s * t.w;
    }
    *(float4*)(p.out + OUT_ST + ((long)(((seq * 2 + e) * 2 + d) * 8 + h)) * 4096 + row * 64 + cgp * 4) = acc;
  } else {
    const int j2 = job - 2048;
    const int chain = j2 >> 2, rg = j2 & 3, row = rg * 16 + r;
    const int b = chain >> 4, h = (chain >> 1) & 7, d = chain & 1;
    float* Tb = (float*)smem + 1024;
    const float* s0 = p.in[5] + ((long)(((b * 2 + e) * 2 + d) * 8 + h)) * 4096;
    *(float4*)(Ss + r * 64 + cgp * 4) = *(const float4*)(s0 + row * 64 + cgp * 4);
    f32x4 tn[4], bn;
    float* Bcur;
    {
      const int gch = 64 + b * 32 + ((d == 0) ? 0 : 31);
      const float* Tc = tb_ptr(p, gch * 8 + h, d, 0);
      Bcur = tb_ptr(p, gch * 8 + h, d, 1);
#pragma unroll
      for (int q = 0; q < 4; ++q) tn[q] = *(const f32x4*)(Tc + (tid + 256 * q) * 4);
      bn = *(const f32x4*)(Bcur + row * 64 + cgp * 4);
    }
    for (int step = 0; step < 31; ++step) {
      float* Tcur = Tb + (step & 1) * 4096;
#pragma unroll
      for (int q = 0; q < 4; ++q) *(f32x4*)(Tcur + (tid + 256 * q) * 4) = tn[q];
      f32x4 acc = bn;
      float* Bst = Bcur;
      __syncthreads();
      if (step + 1 < 31) {
        const int c = (d == 0) ? step + 1 : 30 - step;
        const int gch = 64 + b * 32 + c;
        const float* Tc = tb_ptr(p, gch * 8 + h, d, 0);
        Bcur = tb_ptr(p, gch * 8 + h, d, 1);
#pragma unroll
        for (int q = 0; q < 4; ++q) tn[q] = *(const f32x4*)(Tc + (tid + 256 * q) * 4);
        bn = *(const f32x4*)(Bcur + row * 64 + cgp * 4);
      }
#pragma unroll 16
      for (int i = 0; i < 64; ++i) {
        const float sv = Ss[r * 64 + i];
        const f32x4 t = *(const f32x4*)(Tcur + i * 64 + cgp * 4);
        acc += sv * t;
      }
      __syncthreads();
      *(f32x4*)(Ss + r * 64 + cgp * 4) = acc;
      *(f32x4*)(Bst + row * 64 + cgp * 4) = acc;
    }
  }
}

__device__ __forceinline__ void rwkv_e4_unit(const P& p, char* smem, int e, int unit) {
  const int gch = unit >> 3, h = unit & 7;
  int seq0, slen, cidx, nch;
  if (gch < 64) { seq0 = (gch >> 1) * 256; slen = 256; cidx = gch & 1; nch = 2; }
  else { seq0 = NCTX + ((gch - 64) >> 5) * 4096; slen = 4096; cidx = (gch - 64) & 31; nch = 32; }
  const int tid = otid(), lane = tid & 63, wave = tid >> 6;
  float* qbuf = (float*)smem + wave * 1024;
  float* dout = qbuf;
  u16* G2T = (u16*)(smem + 16384);
  u16* SGw = (u16*)(smem + 34816) + wave * 16 * 144;
  const u16* proj = (const u16*)(p.ws + WS_BIG);
  const float* mu = p.in[17] + e * 2 * 1792;
  const float* g2 = p.in[25] + (long)e * 128 * 512;
  const float* rkb = (const float*)(p.ws + WS_RKB);
  const float* qt = (const float*)(p.ws + WS_QT);
  u16* mix = (u16*)(p.ws + WS_MIX);
  const int hc = h * 64 + lane;
  const int quad = lane >> 4, l16 = lane & 15;
  __syncthreads();
#pragma unroll 8
  for (int idx = tid; idx < 8192; idx += 256) G2T[(idx & 63) * 144 + (idx >> 6)] = f2bf(g2[(long)(idx >> 6) * 512 + h * 64 + (idx & 63)]);
  __syncthreads();
  const float lnw = p.in[26][e * 512 + hc], lnb = p.in[27][e * 512 + hc];
  const int cg0 = 1536 + 1664 + lane, cg1 = 1536 + 1728 + lane, cv = 1536 + 1024 + hc;
  const float m0g0 = mu[1664 + lane], m1g0 = mu[1792 + 1664 + lane];
  const float m0g1 = mu[1728 + lane], m1g1 = mu[1792 + 1728 + lane];
  const float m0v = mu[1024 + hc], m1v = mu[1792 + 1024 + hc];
  for (int hf = 0; hf < 2; ++hf) {
    const int tw0 = gch * 128 + wave * 32 + hf * 16;
    float yv[16];
#pragma unroll
    for (int tk = 0; tk < 16; ++tk) yv[tk] = *yl_ptr(p, tw0 + tk, 0, hc) + *yl_ptr(p, tw0 + tk, 1, hc);
    for (int d = 0; d < 2; ++d) {
      const int oi = (d == 0) ? cidx : nch - 1 - cidx;
      const float* Sp = nullptr;
      if (oi == 0) {
        if (gch >= 64) Sp = p.in[5] + ((long)(((((gch - 64) >> 5) * 2 + e) * 2 + d) * 8 + h)) * 4096;
      } else {
        const int gp = (d == 0) ? gch - 1 : gch + 1;
        Sp = tb_ptr(p, gp * 8 + h, d, 1);
      }
      if (Sp != nullptr) {
        float S[64];
#pragma unroll
        for (int q = 0; q < 16; ++q) {
          const f32x4 v = *(const f32x4*)(Sp + lane * 64 + q * 4);
          S[q * 4] = v[0]; S[q * 4 + 1] = v[1]; S[q * 4 + 2] = v[2]; S[q * 4 + 3] = v[3];
        }
        f32x4 qv[4];
#pragma unroll
        for (int i = 0; i < 4; ++i) {
          const int idx = lane + 64 * i, r = idx >> 4, c4 = idx & 15;
          qv[i] = *(const f32x4*)(qt + ((long)(tw0 + r) * 2 + d) * 512 + h * 64 + c4 * 4);
        }
        __builtin_amdgcn_wave_barrier();
#pragma unroll
        for (int i = 0; i < 4; ++i) *(f32x4*)(qbuf + (lane + 64 * i) * 4) = qv[i];
        __builtin_amdgcn_wave_barrier();
#pragma unroll
        for (int r = 0; r < 16; ++r) {
          float y0 = 0.f, y1 = 0.f;
#pragma unroll
          for (int q = 0; q < 16; ++q) {
            const f32x4 v = *(const f32x4*)(qbuf + r * 64 + q * 4);
            y0 += S[q * 4] * v[0]; y1 += S[q * 4 + 1] * v[1]; y0 += S[q * 4 + 2] * v[2]; y1 += S[q * 4 + 3] * v[3];
          }
          yv[r] += y0 + y1;
        }
        __builtin_amdgcn_wave_barrier();
      }
    }
    float rkl = 0.f;
    if (lane < 16) rkl = rkb[(tw0 + lane) * 16 + h] + rkb[(tw0 + lane) * 16 + 8 + h];
    auto ldrow = [&](int r, float& a, float& b, float& c) {
      const bool ok = (r >= seq0) && (r < seq0 + slen);
      const u16* rp = proj + (long)(ok ? r : tw0) * 3328;
      const float x = bf2f(rp[cg0]), y = bf2f(rp[cg1]), z = bf2f(rp[cv]);
      a = ok ? x : 0.f; b = ok ? y : 0.f; c = ok ? z : 0.f;
    };
    float pg0, pg1, pvv, cg0v, cg1v, cvv, ng0, ng1, nvv;
    ldrow(tw0 - 1, pg0, pg1, pvv);
    ldrow(tw0, cg0v, cg1v, cvv);
    ldrow(tw0 + 1, ng0, ng1, nvv);
    float vshv[16];
#pragma unroll
    for (int tk = 0; tk < 16; ++tk) {
      float fg0, fg1, fvv;
      ldrow(tw0 + tk + 2, fg0, fg1, fvv);
      const float gv0 = sigmoidf_(cg0v + m0g0 * (pg0 - cg0v) + m1g0 * (ng0 - cg0v));
      const float gv1 = sigmoidf_(cg1v + m0g1 * (pg1 - cg1v) + m1g1 * (ng1 - cg1v));
      vshv[tk] = cvv + m0v * (pvv - cvv) + m1v * (nvv - cvv);
      pg0 = cg0v; pg1 = cg1v; pvv = cvv; cg0v = ng0; cg1v = ng1; cvv = nvv; ng0 = fg0; ng1 = fg1; nvv = fvv;
      SGw[tk * 144 + lane] = f2bf(gv0);
      SGw[tk * 144 + 64 + lane] = f2bf(gv1);
    }
    __builtin_amdgcn_wave_barrier();
    {
      bf16x8 af[4];
#pragma unroll
      for (int ks = 0; ks < 4; ++ks) af[ks] = *(const bf16x8*)(SGw + l16 * 144 + ks * 32 + quad * 8);
#pragma unroll
      for (int nt = 0; nt < 4; ++nt) {
        f32x4 dacc = (f32x4){0.f, 0.f, 0.f, 0.f};
#pragma unroll
        for (int ks = 0; ks < 4; ++ks) {
          const bf16x8 bfr = *(const bf16x8*)(G2T + (nt * 16 + l16) * 144 + ks * 32 + quad * 8);
          dacc = __builtin_amdgcn_mfma_f32_16x16x32_bf16(af[ks], bfr, dacc, 0, 0, 0);
        }
#pragma unroll
        for (int j = 0; j < 4; ++j) dout[(quad * 4 + j) * 64 + nt * 16 + l16] = dacc[j];
      }
    }
    __builtin_amdgcn_wave_barrier();
#pragma unroll
    for (int tk = 0; tk < 16; ++tk) {
      const int tok = tw0 + tk;
      const float rk = __int_as_float(__builtin_amdgcn_readlane(__float_as_int(rkl), tk));
      const float gate = dout[tk * 64 + lane];
      const float y = yv[tk];
      const float mean = wave_sum(y) * (1.f / 64.f);
      const float dv = y - mean;
      const float var = wave_sum(dv * dv) * (1.f / 64.f);
      const float yn = dv * rsqrtf(var + 64e-5f) * lnw + lnb;
      mix[(long)tok * 1024 + 512 + hc] = f2bf((yn + rk * vshv[tk]) * gate);
    }
    __builtin_amdgcn_wave_barrier();
  }
}

#define XB_TMO      128
#define XB_XCNT(j)  (256  + 64 * (j))
#define XB_XSUB(j)  (1280 + 64 * (j))
#define XB_XGEN(j)  (2304 + 64 * (j))
#define XB_TOP      3328
#define XB_TOPGEN   3392
#define XCD_BAR_WORDS 3456
#define XB_SPIN_CAP (1u << 22)
#define LAS __attribute__((address_space(3)))
__device__ __forceinline__ unsigned xb_ld(unsigned* p)              { return __hip_atomic_load(p, __ATOMIC_RELAXED, __HIP_MEMORY_SCOPE_AGENT); }
__device__ __forceinline__ unsigned xb_add(unsigned* p, unsigned v) { return __hip_atomic_fetch_add(p, v, __ATOMIC_RELAXED, __HIP_MEMORY_SCOPE_AGENT); }
__device__ __forceinline__ unsigned xb_xcc_id() { return (unsigned)__builtin_amdgcn_s_getreg((3 << 11) | 20) & 0xFu; }
#define XB_SPIN(cond, bar) do { unsigned _sp = 0; while (cond) { __builtin_amdgcn_s_sleep(1); \
    if ((++_sp & 255u) == 0u) { if (xb_ld(&(bar)[XB_TMO])) break; if (_sp > XB_SPIN_CAP) { atomicAdd(&(bar)[XB_TMO], 1u); break; } } } } while (0)
struct XcdBarrier { unsigned* bar; unsigned x; volatile LAS unsigned* st; };
__device__ __forceinline__ XcdBarrier xcd_barrier_post(unsigned* bar, volatile LAS unsigned* st) {
  XcdBarrier b; b.bar = bar; b.x = xb_xcc_id(); b.st = st;
  if (threadIdx.x == 0) (void)xb_add(&bar[XB_XCNT(b.x)], 1u);
  return b;
}
__device__ __forceinline__ void xcd_barrier_complete(unsigned* bar, unsigned x, unsigned& nloc, unsigned& nx) {
  const unsigned G = gridDim.x * gridDim.y * gridDim.z;
  unsigned sum, cnt, mine, sp = 0u;
  for (;;) {
    sum = 0u; cnt = 0u; mine = 0u;
#pragma unroll
    for (unsigned j = 0; j < 16; ++j) { const unsigned c = xb_ld(&bar[XB_XCNT(j)]); sum += c; cnt += (c > 0u) ? 1u : 0u; mine = (j == x) ? c : mine; }
    if (sum == G) break;
    __builtin_amdgcn_s_sleep(1);
    if ((++sp & 255u) == 0u) { if (xb_ld(&bar[XB_TMO])) break; if (sp > XB_SPIN_CAP) { atomicAdd(&bar[XB_TMO], 1u); break; } }
  }
  nloc = mine > 0u ? mine : 1u; nx = cnt > 0u ? cnt : 1u;
}
__device__ __forceinline__ void xcd_barrier(const XcdBarrier& b0) {
  XcdBarrier b; b.bar = b0.bar; b.st = b0.st; b.x = (unsigned)__builtin_amdgcn_readfirstlane((int)xb_xcc_id());
  asm volatile("s_waitcnt vmcnt(0)" ::: "memory");
  __syncthreads();
  if (threadIdx.x == 0) {
    unsigned* bar = b.bar;
    __builtin_amdgcn_s_waitcnt(0);
    unsigned nloc = b.st[0], nx = b.st[1];
    if (nloc == 0u) { xcd_barrier_complete(bar, b.x, nloc, nx); b.st[0] = nloc; b.st[1] = nx; }
    const unsigned old = xb_add(&bar[XB_XSUB(b.x)], 1u);
    const unsigned gen = old / nloc;
    if (old + 1u == (gen + 1u) * nloc) {
      __builtin_amdgcn_fence(__ATOMIC_RELEASE, "agent");
      asm volatile("s_waitcnt vmcnt(0)" ::: "memory");
      const unsigned og = xb_add(&bar[XB_TOP], 1u);
      const unsigned tg = og / nx;
      if (og + 1u == (tg + 1u) * nx) xb_add(&bar[XB_TOPGEN], 1u);
      else XB_SPIN(xb_ld(&bar[XB_TOPGEN]) == tg, bar);
      __builtin_amdgcn_fence(__ATOMIC_ACQUIRE, "agent");
      xb_add(&bar[XB_XGEN(b.x)], 1u);
      asm volatile("s_waitcnt vmcnt(0)" ::: "memory");
    } else {
      XB_SPIN(xb_ld(&bar[XB_XGEN(b.x)]) == gen, bar);
      __builtin_amdgcn_fence(__ATOMIC_ACQUIRE, "agent");
      asm volatile("s_waitcnt vmcnt(0)" ::: "memory");
    }
  }
  __syncthreads();
}

__device__ __forceinline__ void norm_job(const P& p, int job, const float* gvec, const float* modl, int shift_idx) {
  const int t = otid();
  const int row = job * 4 + (t >> 6), lane = t & 63;
  const int grp = row < NCTX ? 0 : 1 + ((row - NCTX) >> 12);
  const float* modv = modl + grp * 6144;
  const float* x = p.out + (long)row * 1024;
  u16* H = (u16*)(p.ws + WS_MIX) + (long)row * 1024;
  float4 v[4];
  float ss = 0.f;
#pragma unroll
  for (int i = 0; i < 4; ++i) {
    v[i] = *(const float4*)(x + (i * 64 + lane) * 4);
    ss += v[i].x * v[i].x + v[i].y * v[i].y + v[i].z * v[i].z + v[i].w * v[i].w;
  }
  ss = wave_sum(ss);
  const float r = rsqrtf(ss * (1.f / 1024.f) + 1e-6f);
#pragma unroll
  for (int i = 0; i < 4; ++i) {
    const int k = (i * 64 + lane) * 4;
    const float4 g = *(const float4*)(gvec + k);
    const float4 sc = *(const float4*)(modv + (shift_idx + 1) * 1024 + k);
    const float4 sh = *(const float4*)(modv + shift_idx * 1024 + k);
    u32x2 o;
    o.x = pack2(v[i].x * r * g.x * (1.f + sc.x) + sh.x, v[i].y * r * g.y * (1.f + sc.y) + sh.y);
    o.y = pack2(v[i].z * r * g.z * (1.f + sc.z) + sh.z, v[i].w * r * g.w * (1.f + sc.w) + sh.w);
    *(u32x2*)(H + k) = o;
  }
}

__device__ __forceinline__ void final_job(const P& p, int job) {
  const int t = otid();
  const int row = job * 4 + (t >> 6), lane = t & 63;
  float* x = p.out + (long)row * 1024;
  float4 v[4];
  float ss = 0.f;
#pragma unroll
  for (int i = 0; i < 4; ++i) {
    v[i] = *(const float4*)(x + (i * 64 + lane) * 4);
    ss += v[i].x * v[i].x + v[i].y * v[i].y + v[i].z * v[i].z + v[i].w * v[i].w;
  }
  ss = wave_sum(ss);
  const float r = rsqrtf(ss * (1.f / 1024.f) + 1e-6f);
#pragma unroll
  for (int i = 0; i < 4; ++i) {
    const float4 g = *(const float4*)(p.in[13] + (i * 64 + lane) * 4);
    float4 o;
    o.x = v[i].x * r * g.x; o.y = v[i].y * r * g.y; o.z = v[i].z * r * g.z; o.w = v[i].w * r * g.w;
    *(float4*)(x + (i * 64 + lane) * 4) = o;
  }
}

#ifndef PHMASK
#define PHMASK 0xffff
#endif
#define PHON(k) (((PHMASK) >> (k)) & 1)
#ifndef DUPMASK
#define DUPMASK 0
#endif
#define NREP(k) ((((DUPMASK) >> (k)) & 1) ? 2 : 1)
__global__ void __launch_bounds__(256, 2) fwd_megakernel(P p) {
  cg::grid_group grid = cg::this_grid();
  __shared__ __attribute__((aligned(16))) char smem[SMEM_BYTES];
  __shared__ uint4 xb_words;
  if (threadIdx.x == 0) xb_words = make_uint4(0u, 0u, 0u, 0u);
  __syncthreads();
  XcdBarrier xb = xcd_barrier_post((unsigned*)(p.ws + WS_BAR), (volatile LAS unsigned*)&xb_words);
  const int nb = gridDim.x, bid0 = blockIdx.x;
  int bid = bid0;
  asm volatile("" : "+s"(bid));
  float* mod = (float*)(p.ws + WS_MOD);
  u16* big = (u16*)(p.ws + WS_BIG);
  u16* mix = (u16*)(p.ws + WS_MIX);

  for (int rep = 0; rep < NREP(0); ++rep)
  for (int job = bid; job < 384 + N_CONV_JOBS + 3072 + 4096 + 128; job += nb) {
    if (!PHON(0)) break;
    if (job >= 384 + N_CONV_JOBS + 3072 + 4096) loracvt_job(p, job - (384 + N_CONV_JOBS + 3072 + 4096));
    else if (job < 384) adaln_job(p, smem, job);
    else if (job < 384 + N_CONV_JOBS) conv_job(p, smem, job - 384);
    else if (job < 384 + N_CONV_JOBS + 3072) cachecvt_job(p, job - 384 - N_CONV_JOBS);
    else xcopy_job(p, job - 384 - N_CONV_JOBS - 3072);
  }
  if (p.ws == nullptr) grid.sync();
  xcd_barrier(xb);

  for (int l = 0; l < 4; ++l) {
    int bid = bid0;
    asm volatile("" : "+s"(bid));
    const float* modl = mod + l * 3 * 6144;
    const int sub = l >> 1;
    const bool even = (l & 1) == 0;
    for (int lj = bid >> 3; lj < 512; lj += (nb >> 3)) norm_job(p, (bid & 7) * 512 + lj, p.in[11] + l * 1024, modl, 0);
    xcd_barrier(xb);
    if (even) {
      if (PHON(1)) gemm_phase<0, 0, 256>(p, smem, mix, 1024, (const u16*)(p.ws + WS_WIN) + (long)sub * 3328 * 1024, 3328,
                                    nullptr, modl, 0, 0, sub, big);
    } else {
      if (PHON(7)) gemm_phase<0, 1, 128>(p, smem, mix, 1024, (const u16*)(p.ws + WS_WQKV) + (long)sub * 3072 * 1024, 3072,
                                    nullptr, modl, 0, 0, sub, big);
    }
    xcd_barrier(xb);
    if (even) {
      const int e = sub;
      for (int rep = 0; rep < NREP(2); ++rep)
      for (int job = bid; job < 3072; job += nb) {
        if (job < 1024) { if (PHON(2)) rwkv_scan_unit(p, smem, e, job); }
        else if (!PHON(3)) {}
        else if (job < 2048) {
          const int j = job - 1024;
          const int b = j >> 9, h = (j >> 6) & 7, qi = j & 63;
          int r0 = qi - 4; r0 = r0 < 0 ? 0 : (r0 > 56 ? 56 : r0);
          const long tq = NCTX + b * 4096 + qi * 64, tk = NCTX + b * 4096 + r0 * 64;
          attn_job<1, 64, true>(smem, big + tq * 3328 + h * 64, 3328,
                                (const u16*)(p.ws + WS_CNK) + (long)(b * 2 + e) * 512 * 512 + h * 64,
                                (const u16*)(p.ws + WS_CNV) + (long)(b * 2 + e) * 512 * 512 + h * 64, 512, 512,
                                big + tk * 3328 + 512 + h * 64, big + tk * 3328 + 1024 + h * 64, 3328, 512,
                                p.in[16] + (long)(e * 8 + h) * 15 * 31, qi, r0, 0.f, 0.f, nullptr,
                                mix + tq * 1024 + h * 64, 1024);
        } else {
          const int j = job - 2048;
          const int b = j >> 5, h = (j >> 2) & 7, qb = j & 3;
          const long tq = b * 256 + qb * 64, tk = b * 256;
          attn_job<1, 64, false>(smem, big + tq * 3328 + h * 64, 3328,
                                 big + tk * 3328 + 512 + h * 64, big + tk * 3328 + 1024 + h * 64, 3328, 256,
                                 nullptr, nullptr, 0, 0, nullptr, 0, 0, 0.f, 0.f, nullptr,
                                 mix + tq * 1024 + h * 64, 1024);
        }
      }
      xcd_barrier(xb);
      if (PHON(4)) for (int job = bid; job < 2176; job += nb) rwkv_e3_job(p, smem, e, job < 128 ? job + 2048 : job - 128);
      xcd_barrier(xb);
      for (int rep = 0; rep < NREP(5); ++rep)
      if (PHON(5)) for (int job = bid; job < 1024; job += nb) rwkv_e4_unit(p, smem, e, job);
    } else {
      const int o = sub;
      const float lam_init = 0.8f - 0.6f * __expf(-0.3f * (float)l);
      float d0 = 0.f, d1 = 0.f;
      for (int i = 0; i < 64; ++i) {
        d0 += p.in[30][o * 128 + i] * p.in[31][o * 128 + i];
        d1 += p.in[30][o * 128 + 64 + i] * p.in[31][o * 128 + 64 + i];
      }
      const float lam = __expf(d0) - __expf(d1) + lam_init;
      for (int rep = 0; rep < NREP(8); ++rep)
      if (PHON(8)) for (int job = bid; job < 2048; job += nb) {
        long tq, tk; int h, n0, n1; const u16 *k0, *v0; int st0;
        if (job < 1024) {
          const int x = job & 7, lj = job >> 3;
          const int pair = x + 8 * (lj >> 6), qb = lj & 63;
          const int b = pair >> 3; h = pair & 7;
          tq = NCTX + b * 4096 + qb * 64; tk = NCTX + b * 4096;
          k0 = (const u16*)(p.ws + WS_CDK) + (long)(b * 2 + o) * 512 * 1024 + h * 128;
          v0 = (const u16*)(p.ws + WS_CDV) + (long)(b * 2 + o) * 512 * 1024 + h * 128;
          st0 = 1024; n0 = 512; n1 = 4096;
        } else {
          const int j = job - 1024;
          const int b = j >> 5, qb = j & 3; h = (j >> 2) & 7;
          tq = b * 256 + qb * 64; tk = b * 256;
          k0 = big + tk * 3072 + 1024 + h * 128; v0 = big + tk * 3072 + 2048 + h * 128;
          st0 = 3072; n0 = 256; n1 = 0;
        }
        attn_job<2, 128, false>(smem, big + tq * 3072 + h * 128, 3072, k0, v0, st0, n0,
                                big + tk * 3072 + 1024 + h * 128, big + tk * 3072 + 2048 + h * 128, 3072, n1,
                                nullptr, 0, 0, lam, 1.f - lam_init, p.in[32] + o * 128,
                                mix + tq * 1024 + h * 128, 1024);
      }
    }
    xcd_barrier(xb);
    for (int g = 0; g < 2; ++g) {
      if (g == 1) {
        for (int lj = bid >> 3; lj < 512; lj += (nb >> 3)) norm_job(p, (bid & 7) * 512 + lj, p.in[12] + l * 1024, modl, 3);
        xcd_barrier(xb);
        for (int rep = 0; rep < NREP(9); ++rep)
        if (PHON(9)) gemm_phase<0, 3, 256>(p, smem, mix, 1024, (const u16*)(p.ws + WS_W13) + (long)l * 5632 * 1024, 5632,
                                      nullptr, modl, 3, 0, 0, big);
        xcd_barrier(xb);
      }
      const u16* A2 = g == 0 ? mix : big;
      const int K2 = g == 0 ? 1024 : 2816;
      const u16* B2 = g == 0 ? (even ? (const u16*)(p.ws + WS_WOE) + (long)sub * 1024 * 1024 : (const u16*)(p.ws + WS_WOD) + (long)sub * 1024 * 1024)
                             : (const u16*)(p.ws + WS_W2) + (long)l * 1024 * 2816;
      if (PHON(6)) gemm_phase<0, 2, 256>(p, smem, A2, K2, B2, 1024, nullptr, modl, 0, g == 0 ? 2 : 5, 0, nullptr);
      xcd_barrier(xb);
    }
  }
  if (PHON(10)) for (int lj = bid >> 3; lj < 512; lj += (nb >> 3)) final_job(p, (bid & 7) * 512 + lj);
}

extern "C" void kernel_launch(void* const* d_in, const int* in_sizes, int n_in, void* d_out, int out_size,
                              void* d_ws, size_t ws_size, hipStream_t stream) {
  static int grid_blocks = 0;
  if (!grid_blocks) {
    int dev = 0, cus = 0, per_cu = 0;
    (void)hipGetDevice(&dev);
    (void)hipDeviceGetAttribute(&cus, hipDeviceAttributeMultiprocessorCount, dev);
    (void)hipOccupancyMaxActiveBlocksPerMultiprocessor(&per_cu, fwd_megakernel, 256, 0);
    (void)per_cu;
    grid_blocks = cus * 2;
  }
  if (ws_size < (size_t)WS_TOTAL) { fprintf(stderr, "workspace too small: %zu < %ld\n", ws_size, (long)WS_END); return; }
  P p{};
  for (int i = 0; i < 36; ++i) p.in[i] = (const float*)d_in[i];
  p.out = (float*)d_out;
  p.ws = (char*)d_ws;
  (void)hipMemsetAsync((char*)d_ws + WS_BAR, 0, XCD_BAR_WORDS * 4, stream);
  void* args[] = {&p};
  hipError_t e = hipLaunchCooperativeKernel((void*)fwd_megakernel, dim3(grid_blocks), dim3(256), args, 0, stream);
  if (e != hipSuccess) fprintf(stderr, "cooperative launch failed: %s (grid %d)\n", hipGetErrorString(e), grid_blocks);
}
```

```cpp
#include <hip/hip_runtime.h>
#include <hip/hip_cooperative_groups.h>
#include <cstdio>
namespace cg = cooperative_groups;

typedef unsigned short u16;
typedef __attribute__((ext_vector_type(8))) short bf16x8;
typedef __attribute__((ext_vector_type(4))) float f32x4;
typedef __attribute__((ext_vector_type(4))) unsigned u32x4;
typedef __attribute__((ext_vector_type(2))) unsigned u32x2;

#define NTOK 16384
#define NCTX 8192
#define OUT_NAK 16777216L
#define OUT_NAV 25165824L
#define OUT_ST  33554432L
#define OUT_DK  37748736L
#define OUT_DV  54525952L
#define WS_WIN   0L
#define WS_WOE   13631488L
#define WS_WQKV  17825792L
#define WS_WOD   30408704L
#define WS_W13   34603008L
#define WS_W2    80740352L
#define WS_CNK   103809024L
#define WS_CNV   105906176L
#define WS_CDK   108003328L
#define WS_CDV   112197632L
#define WS_MOD   116391936L
#define WS_ROWSS 116686848L
#define WS_RKB   117735424L
#define WS_MIX   118784000L
#define WS_BIG   152338432L
#define WS_TB    261390336L
#define WS_QT    328499200L
#define WS_END   395608064L
#define WS_BAR   395624448L
#define WS_WT    395640832L
#define WS_TOTAL 396165120L

struct P {
  const float* in[36];
  float* out;
  char* ws;
};

#define SMEM_BYTES 61440

typedef __attribute__((ext_vector_type(2))) float f32x2_t;
typedef __attribute__((ext_vector_type(2))) __bf16 bf16x2_t;
__device__ __forceinline__ u16 f2bf(float f) { return __builtin_bit_cast(u16, (__bf16)f); }
__device__ __forceinline__ float bf2f(u16 h) { return __uint_as_float(((unsigned)h) << 16); }
__device__ __forceinline__ unsigned pack2(float a, float b) {
  const f32x2_t v = {a, b};
  return __builtin_bit_cast(unsigned, __builtin_convertvector(v, bf16x2_t));
}
template <int CTRL>
__device__ __forceinline__ float dpp_mov(float v) {
  return __int_as_float(__builtin_amdgcn_update_dpp(0, __float_as_int(v), CTRL, 0xf, 0xf, false));
}
__device__ __forceinline__ float g16_sum(float v) {
  v += dpp_mov<0xB1>(v);
  v += dpp_mov<0x4E>(v);
  v += dpp_mov<0x124>(v);
  v += dpp_mov<0x128>(v);
  return v;
}
__device__ __forceinline__ float g16_max(float v) {
  v = fmaxf(v, dpp_mov<0xB1>(v));
  v = fmaxf(v, dpp_mov<0x4E>(v));
  v = fmaxf(v, dpp_mov<0x124>(v));
  v = fmaxf(v, dpp_mov<0x128>(v));
  return v;
}
__device__ __forceinline__ float wave_sum(float v) {
  v = g16_sum(v);
  const float r0 = __int_as_float(__builtin_amdgcn_readlane(__float_as_int(v), 0));
  const float r1 = __int_as_float(__builtin_amdgcn_readlane(__float_as_int(v), 16));
  const float r2 = __int_as_float(__builtin_amdgcn_readlane(__float_as_int(v), 32));
  const float r3 = __int_as_float(__builtin_amdgcn_readlane(__float_as_int(v), 48));
  return (r0 + r1) + (r2 + r3);
}
__device__ __forceinline__ int otid() { int t = threadIdx.x; asm volatile("" : "+v"(t)); return t; }
__device__ __forceinline__ float sigmoidf_(float x) { return __builtin_amdgcn_rcpf(1.f + __expf(-x)); }

struct ConvT { const float* src; u16* dst; int K, N, mode, kt, nt; };
__device__ __forceinline__ ConvT conv_params(const P& p, int job) {
  ConvT c;
  if (job < 1664) {
    int e = job / 832, r = job % 832;
    c.src = p.in[14] + (long)e * 1024 * 3328; c.K = 1024; c.N = 3328; c.dst = (u16*)(p.ws + WS_WIN) + (long)e * 3328 * 1024; c.mode = 0; c.kt = r / 52; c.nt = r % 52;
    return c;
  }
  job -= 1664;
  if (job < 512) {
    int e = job / 256, r = job % 256;
    c.src = p.in[15] + (long)e * 1024 * 1024; c.K = 1024; c.N = 1024; c.dst = (u16*)(p.ws + WS_WOE) + (long)e * 1024 * 1024; c.mode = 0; c.kt = r / 16; c.nt = r % 16;
    return c;
  }
  job -= 512;
  if (job < 1536) {
    int e = job / 768, r = job % 768;
    c.src = p.in[28] + (long)e * 1024 * 3072; c.K = 1024; c.N = 3072; c.dst = (u16*)(p.ws + WS_WQKV) + (long)e * 3072 * 1024; c.mode = 0; c.kt = r / 48; c.nt = r % 48;
    return c;
  }
  job -= 1536;
  if (job < 512) {
    int e = job / 256, r = job % 256;
    c.src = p.in[29] + (long)e * 1024 * 1024; c.K = 1024; c.N = 1024; c.dst = (u16*)(p.ws + WS_WOD) + (long)e * 1024 * 1024; c.mode = 0; c.kt = r / 16; c.nt = r % 16;
    return c;
  }
  job -= 512;
  if (job < 2816) {
    int l = job / 704, r = job % 704;
    c.src = p.in[33] + (long)l * 1024 * 2816; c.K = 1024; c.N = 2816; c.dst = (u16*)(p.ws + WS_W13) + (long)l * 5632 * 1024; c.mode = 1; c.kt = r / 44; c.nt = r % 44;
    return c;
  }
  job -= 2816;
  if (job < 2816) {
    int l = job / 704, r = job % 704;
    c.src = p.in[34] + (long)l * 1024 * 2816; c.K = 1024; c.N = 2816; c.dst = (u16*)(p.ws + WS_W13) + (long)l * 5632 * 1024; c.mode = 2; c.kt = r / 44; c.nt = r % 44;
    return c;
  }
  job -= 2816;
  {
    int l = job / 704, r = job % 704;
    c.src = p.in[35] + (long)l * 2816 * 1024; c.K = 2816; c.N = 1024; c.dst = (u16*)(p.ws + WS_W2) + (long)l * 1024 * 2816; c.mode = 0; c.kt = r / 16; c.nt = r % 16;
  }
  return c;
}
__device__ __forceinline__ void conv_job(const P& p, char* smem, int job2) {
  const int tid = otid();
  float* tile = (float*)smem;
  ConvT c[2];
  c[0] = conv_params(p, 2 * job2);
  c[1] = conv_params(p, 2 * job2 + 1);
  float v[2][16];
#pragma unroll
  for (int t = 0; t < 2; ++t)
#pragma unroll
    for (int i = 0; i < 16; ++i) {
      const int kl = (tid >> 6) + 4 * i, nl = tid & 63;
      v[t][i] = c[t].src[(long)(c[t].kt * 64 + kl) * c[t].N + c[t].nt * 64 + nl];
    }
  __syncthreads();
#pragma unroll
  for (int t = 0; t < 2; ++t)
#pragma unroll
    for (int i = 0; i < 16; ++i) {
      const int kl = (tid >> 6) + 4 * i, nl = tid & 63;
      tile[t * 4160 + kl * 65 + nl] = v[t][i];
    }
  __syncthreads();
#pragma unroll
  for (int t = 0; t < 2; ++t)
#pragma unroll
    for (int i = 0; i < 2; ++i) {
      const int task = tid + 256 * i;
      const int kg = task & 7, nl = task >> 3;
      const int n = c[t].nt * 64 + nl;
      int nd = n;
      if (c[t].mode == 1) nd = (n >> 5) * 64 + (n & 31);
      else if (c[t].mode == 2) nd = (n >> 5) * 64 + 32 + (n & 31);
      const float* tt = tile + t * 4160;
      u32x4 o;
      o.x = pack2(tt[(kg * 8 + 0) * 65 + nl], tt[(kg * 8 + 1) * 65 + nl]);
      o.y = pack2(tt[(kg * 8 + 2) * 65 + nl], tt[(kg * 8 + 3) * 65 + nl]);
      o.z = pack2(tt[(kg * 8 + 4) * 65 + nl], tt[(kg * 8 + 5) * 65 + nl]);
      o.w = pack2(tt[(kg * 8 + 6) * 65 + nl], tt[(kg * 8 + 7) * 65 + nl]);
      *(u32x4*)(c[t].dst + (long)nd * c[t].K + c[t].kt * 64 + kg * 8) = o;
    }
}
#define N_CONV_JOBS 6336

__device__ __forceinline__ void adaln_job(const P& p, char* smem, int job) {
  const int l = job / 96, cgp = job % 96;
  const int tid = otid();
  float* sil = (float*)smem;
  float* red = sil + 3072;
  __syncthreads();
  for (int i = tid; i < 3072; i += 256) {
    int v = i >> 10, k = i & 1023;
    float c = (v == 0) ? p.in[8][k] : p.in[2][(v - 1) * 1024 + k];
    sil[i] = c * sigmoidf_(c);
  }
  __syncthreads();
  const int kq = tid >> 6, cl = tid & 63;
  const float* w = p.in[9] + (long)l * 1024 * 6144 + cgp * 64 + cl;
  float a0 = 0.f, a1 = 0.f, a2 = 0.f;
#pragma unroll 16
  for (int k = kq * 256; k < kq * 256 + 256; ++k) {
    float wv = w[(long)k * 6144];
    a0 += sil[k] * wv; a1 += sil[1024 + k] * wv; a2 += sil[2048 + k] * wv;
  }
  red[(kq * 3 + 0) * 64 + cl] = a0; red[(kq * 3 + 1) * 64 + cl] = a1; red[(kq * 3 + 2) * 64 + cl] = a2;
  __syncthreads();
  if (tid < 192) {
    int v = tid >> 6;
    float s = red[(0 * 3 + v) * 64 + cl] + red[(1 * 3 + v) * 64 + cl] + red[(2 * 3 + v) * 64 + cl] + red[(3 * 3 + v) * 64 + cl];
    s += p.in[10][l * 6144 + cgp * 64 + cl];
    ((float*)(p.ws + WS_MOD))[(l * 3 + v) * 6144 + cgp * 64 + cl] = s;
  }
}

__device__ __forceinline__ void cachecvt_job(const P& p, int job) {
  const float* src; u16* dst; int j;
  if (job < 512) { src = p.in[3]; dst = (u16*)(p.ws + WS_CNK); j = job; }
  else if (job < 1024) { src = p.in[4]; dst = (u16*)(p.ws + WS_CNV); j = job - 512; }
  else if (job < 2048) { src = p.in[6]; dst = (u16*)(p.ws + WS_CDK); j = job - 1024; }
  else { src = p.in[7]; dst = (u16*)(p.ws + WS_CDV); j = job - 2048; }
  long off = (long)j * 2048 + otid() * 8;
  float4 a = *(const float4*)(src + off), b = *(const float4*)(src + off + 4);
  uint4 v; v.x = pack2(a.x, a.y); v.y = pack2(a.z, a.w); v.z = pack2(b.x, b.y); v.w = pack2(b.z, b.w);
  *(uint4*)(dst + off) = v;
}


__device__ __forceinline__ void loracvt_job(const P& p, int job) {
  u16* dst = (u16*)(p.ws + WS_WT);
#pragma unroll
  for (int i = 0; i < 8; ++i) {
    const int g = job * 2048 + i * 256 + otid();
    const int k = g & 63, n = (g >> 6) & 511, mat = (g >> 15) & 1, ed = g >> 16;
    const float* src = mat ? p.in[21] : p.in[19];
    dst[g] = f2bf(src[((long)ed * 64 + k) * 512 + n]);
  }
}

__device__ __forceinline__ void xcopy_job(const P& p, int job) {
  const int row = job * 4 + (otid() >> 6), lane = otid() & 63;
  const float* src = (row < NCTX) ? p.in[0] + (long)row * 1024 : p.in[1] + (long)(row - NCTX) * 1024;
  float* dst = p.out + (long)row * 1024;
  float ss = 0.f;
#pragma unroll
  for (int i = 0; i < 4; ++i) {
    float4 v = *(const float4*)(src + (i * 64 + lane) * 4);
    ss += v.x * v.x + v.y * v.y + v.z * v.z + v.w * v.w;
    *(float4*)(dst + (i * 64 + lane) * 4) = v;
  }
}

template <int AM, int EPI, int BM>
__device__ __forceinline__ void gemm_phase(const P& p, char* smem, const void* Aptr, int K, const u16* Bt, int N,
                           const float* gvec, const float* modl, int shift_idx, int gate_idx, int sub, u16* dst) {
  const int tid = otid(), lane = tid & 63, wave = tid >> 6, wm = wave >> 1, wn = wave & 1;
  const int quad = lane >> 4, l16 = lane & 15;
  u16* As = (u16*)smem;
  u16* Bs = As + BM * 80;
  constexpr int MI = BM / 32;
  const int NT = N >> 7, ntiles = (16384 / BM) * NT, ntk = K >> 6;
  float* X = p.out;
  const float* rowss = (const float*)(p.ws + WS_ROWSS);
  const int MPX = (16384 / BM) / 8, LB = gridDim.x >> 3, xcd = blockIdx.x & 7;
  (void)ntiles;
  for (int lt = blockIdx.x >> 3; lt < MPX * NT; lt += LB) {
    const int mt = xcd * MPX + lt % MPX, nt = lt / MPX;
    const int row0 = mt * BM, col0 = nt * 128;
    const int grp = row0 < NCTX ? 0 : 1 + ((row0 - NCTX) >> 12);
    const float* modv = modl + grp * 6144;
    f32x4 acc[MI][4];
#pragma unroll
    for (int i = 0; i < MI; ++i)
#pragma unroll
      for (int j = 0; j < 4; ++j) acc[i][j] = (f32x4){0.f, 0.f, 0.f, 0.f};
    f32x4 ar[8]; u32x4 ab[MI]; u32x4 bb[4]; float rinv[8];
    if (AM == 1) {
#pragma unroll
      for (int i = 0; i < 8; ++i) {
        const float4* rp = (const float4*)(rowss + (long)(row0 + (tid >> 4) + 16 * i) * 16);
        float4 s0 = rp[0], s1 = rp[1], s2 = rp[2], s3 = rp[3];
        float s = (s0.x + s0.y + s0.z + s0.w) + (s1.x + s1.y + s1.z + s1.w) + (s2.x + s2.y + s2.z + s2.w) + (s3.x + s3.y + s3.z + s3.w);
        rinv[i] = rsqrtf(s * (1.f / 1024.f) + 1e-6f);
      }
    }
    if (AM == 1) {
#pragma unroll
      for (int i = 0; i < 8; ++i)
        ar[i] = *(const f32x4*)((const float*)Aptr + (long)(row0 + (tid >> 4) + 16 * i) * 1024 + (tid & 15) * 4);
    } else {
#pragma unroll
      for (int i = 0; i < MI; ++i)
        ab[i] = *(const u32x4*)((const u16*)Aptr + (long)(row0 + (tid >> 3) + 32 * i) * K + (tid & 7) * 8);
    }
#pragma unroll
    for (int i = 0; i < 4; ++i)
      bb[i] = *(const u32x4*)(Bt + (long)(col0 + (tid >> 3) + 32 * i) * K + (tid & 7) * 8);

    for (int kt = 0; kt < ntk; ++kt) {
      __syncthreads();
      if (AM == 1) {
        const int k = kt * 64 + (tid & 15) * 4;
        float4 g = *(const float4*)(gvec + k);
        float4 sc = *(const float4*)(modv + (shift_idx + 1) * 1024 + k);
        float4 sh = *(const float4*)(modv + shift_idx * 1024 + k);
        g.x *= (1.f + sc.x); g.y *= (1.f + sc.y); g.z *= (1.f + sc.z); g.w *= (1.f + sc.w);
#pragma unroll
        for (int i = 0; i < 8; ++i) {
          float r = rinv[i];
          u32x2 v;
          v.x = pack2(ar[i].x * r * g.x + sh.x, ar[i].y * r * g.y + sh.y);
          v.y = pack2(ar[i].z * r * g.z + sh.z, ar[i].w * r * g.w + sh.w);
          *(u32x2*)(As + ((tid >> 4) + 16 * i) * 80 + (tid & 15) * 4) = v;
        }
      } else {
#pragma unroll
        for (int i = 0; i < MI; ++i) *(u32x4*)(As + ((tid >> 3) + 32 * i) * 80 + (tid & 7) * 8) = ab[i];
      }
#pragma unroll
      for (int i = 0; i < 4; ++i) *(u32x4*)(Bs + ((tid >> 3) + 32 * i) * 80 + (tid & 7) * 8) = bb[i];
      __syncthreads();
      if (kt + 1 < ntk) {
        const int kn = (kt + 1) * 64;
        if (AM == 1) {
#pragma unroll
          for (int i = 0; i < 8; ++i)
            ar[i] = *(const f32x4*)((const float*)Aptr + (long)(row0 + (tid >> 4) + 16 * i) * 1024 + kn + (tid & 15) * 4);
        } else {
#pragma unroll
          for (int i = 0; i < MI; ++i)
            ab[i] = *(const u32x4*)((const u16*)Aptr + (long)(row0 + (tid >> 3) + 32 * i) * K + kn + (tid & 7) * 8);
        }
#pragma unroll
        for (int i = 0; i < 4; ++i)
          bb[i] = *(const u32x4*)(Bt + (long)(col0 + (tid >> 3) + 32 * i) * K + kn + (tid & 7) * 8);
      }
      __builtin_amdgcn_sched_barrier(0);
#pragma unroll
      for (int ks = 0; ks < 2; ++ks) {
        bf16x8 b[4];
#pragma unroll
        for (int i = 0; i < 4; ++i) b[i] = *(const bf16x8*)(Bs + (wn * 64 + i * 16 + l16) * 80 + ks * 32 + quad * 8);
#pragma unroll
        for (int i = 0; i < MI; ++i) {
          const bf16x8 a = *(const bf16x8*)(As + (wm * (BM / 2) + i * 16 + l16) * 80 + ks * 32 + quad * 8);
#pragma unroll
          for (int j = 0; j < 4; ++j) acc[i][j] = __builtin_amdgcn_mfma_f32_16x16x32_bf16(b[j], a, acc[i][j], 0, 0, 0);
        }
      }
    }
    const int cw = col0 + wn * 64;
    if (EPI == 0) {
      const int e = sub;
#pragma unroll
      for (int mi = 0; mi < MI; ++mi) {
        const int row = row0 + wm * (BM / 2) + mi * 16 + l16;
#pragma unroll
        for (int ni = 0; ni < 4; ++ni) {
          const int col = cw + ni * 16 + quad * 4;
          const f32x4 v = acc[mi][ni];
          u32x2 o; o.x = pack2(v[0], v[1]); o.y = pack2(v[2], v[3]);
          *(u32x2*)(dst + (long)row * 3328 + col) = o;
          if (row < NCTX && cw >= 512 && cw < 1536) {
            const int b = row >> 8, t = row & 255;
            if (cw < 1024) *(f32x4*)(p.out + OUT_NAK + ((long)((b * 2 + e) * 256 + t)) * 512 + col - 512) = v;
            else *(f32x4*)(p.out + OUT_NAV + ((long)((b * 2 + e) * 256 + t)) * 512 + col - 1024) = v;
          }
        }
      }
    } else if (EPI == 1) {
      const int o = sub;
      float inv[4];
#pragma unroll
      for (int j = 0; j < 4; ++j) inv[j] = exp2f(-(float)(quad * 4 + j) * (13.287712379549449f / 16.f));
#pragma unroll
      for (int mi = 0; mi < MI; ++mi) {
        const int row = row0 + wm * (BM / 2) + mi * 16 + l16;
        f32x4 v0 = acc[mi][0], v1 = acc[mi][1], v2 = acc[mi][2], v3 = acc[mi][3];
        if (row >= NCTX && cw < 2048) {
          const int tp = (row - NCTX) & 4095;
#pragma unroll
          for (int j = 0; j < 4; ++j) {
            const float a0 = (float)(tp >> 6) * inv[j], a1 = (float)(tp & 63) * inv[j];
            const float c0 = __cosf(a0), s0 = __sinf(a0), c1 = __cosf(a1), s1 = __sinf(a1);
            const float n0 = v0[j] * c0 - v1[j] * s0, n1 = v0[j] * s0 + v1[j] * c0;
            const float n2 = v2[j] * c1 - v3[j] * s1, n3 = v2[j] * s1 + v3[j] * c1;
            v0[j] = n0; v1[j] = n1; v2[j] = n2; v3[j] = n3;
          }
        }
        f32x4 vv[4] = {v0, v1, v2, v3};
#pragma unroll
        for (int ni = 0; ni < 4; ++ni) {
          const int col = cw + ni * 16 + quad * 4;
          u32x2 ob; ob.x = pack2(vv[ni][0], vv[ni][1]); ob.y = pack2(vv[ni][2], vv[ni][3]);
          *(u32x2*)(dst + (long)row * 3072 + col) = ob;
          if (row < NCTX && cw >= 1024) {
            const int b = row >> 8, t = row & 255;
            if (cw < 2048) *(f32x4*)(p.out + OUT_DK + ((long)((b * 2 + o) * 256 + t)) * 1024 + col - 1024) = vv[ni];
            else *(f32x4*)(p.out + OUT_DV + ((long)((b * 2 + o) * 256 + t)) * 1024 + col - 2048) = vv[ni];
          }
        }
      }
    } else if (EPI == 2) {
      f32x4 gt[4];
#pragma unroll
      for (int ni = 0; ni < 4; ++ni) gt[ni] = *(const f32x4*)(modv + gate_idx * 1024 + cw + ni * 16 + quad * 4);
#pragma unroll
      for (int mi = 0; mi < MI; ++mi) {
        const int row = row0 + wm * (BM / 2) + mi * 16 + l16;
#pragma unroll
        for (int ni = 0; ni < 4; ++ni) {
          f32x4* xp = (f32x4*)(X + (long)row * 1024 + cw + ni * 16 + quad * 4);
          *xp = *xp + gt[ni] * acc[mi][ni];
        }
      }
    } else {
#pragma unroll
      for (int mi = 0; mi < MI; ++mi) {
        const int row = row0 + wm * (BM / 2) + mi * 16 + l16;
#pragma unroll
        for (int ni = 0; ni < 2; ++ni) {
          const f32x4 a = acc[mi][ni], b = acc[mi][ni + 2];
          u32x2 ob;
          ob.x = pack2(a[0] * sigmoidf_(a[0]) * b[0], a[1] * sigmoidf_(a[1]) * b[1]);
          ob.y = pack2(a[2] * sigmoidf_(a[2]) * b[2], a[3] * sigmoidf_(a[3]) * b[3]);
          *(u32x2*)(dst + (long)row * 2816 + (cw >> 1) + ni * 16 + quad * 4) = ob;
        }
      }
    }
  }
}

__device__ __forceinline__ unsigned cvt_pk_bf16(float lo, float hi) { return pack2(lo, hi); }
typedef __attribute__((ext_vector_type(2))) unsigned u32pair_t;
__device__ __forceinline__ float xq_max(float v) {
  const unsigned x = __float_as_uint(v);
  const u32pair_t r = __builtin_amdgcn_permlane16_swap(x, x, false, false);
  const float m = fmaxf(__uint_as_float(r.x), __uint_as_float(r.y));
  const unsigned y = __float_as_uint(m);
  const u32pair_t q = __builtin_amdgcn_permlane32_swap(y, y, false, false);
  return fmaxf(__uint_as_float(q.x), __uint_as_float(q.y));
}
__device__ __forceinline__ float xq_sum(float v) {
  const unsigned x = __float_as_uint(v);
  const u32pair_t r = __builtin_amdgcn_permlane16_swap(x, x, false, false);
  const float m = __uint_as_float(r.x) + __uint_as_float(r.y);
  const unsigned y = __float_as_uint(m);
  const u32pair_t q = __builtin_amdgcn_permlane32_swap(y, y, false, false);
  return __uint_as_float(q.x) + __uint_as_float(q.y);
}
template <int NS, int DV, bool LOCAL>
__device__ __forceinline__ void attn_job(char* smem, const u16* qp, int qst,
                         const u16* k0, const u16* v0, int st0, int n0,
                         const u16* k1, const u16* v1, int st1, int n1,
                         const float* rpbh, int qi, int r0,
                         float lam, float outscale, const float* subln,
                         u16* op, int ost) {
  constexpr int KD = NS * 64, KST = KD + 16, KCH = KD / 8;
  u16* Ks = (u16*)smem;
  constexpr int VST = DV + 8, VCH = DV / 8;
  u16* Vs = Ks + 64 * KST;
  u16* Ps = Vs + 64 * VST;
  const int tid = otid(), lane = tid & 63, wave = tid >> 6, quad = lane >> 4, l16 = lane & 15;
  constexpr float C2 = 0.125f * 1.4426950408889634f;
  bf16x8 qf[NS][2];
#pragma unroll
  for (int s = 0; s < NS; ++s)
#pragma unroll
    for (int ks = 0; ks < 2; ++ks)
      qf[s][ks] = *(const bf16x8*)(qp + (long)(wave * 16 + l16) * qst + s * 64 + ks * 32 + quad * 8);
  float m[NS], l[NS];
  f32x4 O[NS][DV / 16];
#pragma unroll
  for (int s = 0; s < NS; ++s) {
    m[s] = -1e30f; l[s] = 0.f;
#pragma unroll
    for (int n = 0; n < DV / 16; ++n) O[s][n] = (f32x4){0.f, 0.f, 0.f, 0.f};
  }
  const int jq = wave * 16 + l16;
  int c0 = jq - 8; c0 = c0 < 0 ? 0 : (c0 > 48 ? 48 : c0);
  const int nt0 = n0 >> 6, ntot = nt0 + (n1 >> 6);
  constexpr int KPT = (64 * KCH) / 256;
  constexpr int VPT = (64 * VCH) / 256;
  u32x4 kreg[KPT];
  u32x4 vreg[VPT];
  auto load_tile = [&](int t) {
    const u16 *kp, *vp; int st;
    if (t < nt0) { kp = k0 + (long)t * 64 * st0; vp = v0 + (long)t * 64 * st0; st = st0; }
    else { kp = k1 + (long)(t - nt0) * 64 * st1; vp = v1 + (long)(t - nt0) * 64 * st1; st = st1; }
#pragma unroll
    for (int i = 0; i < KPT; ++i) {
      const int c = tid + 256 * i;
      kreg[i] = *(const u32x4*)(kp + (long)(c / KCH) * st + (c % KCH) * 8);
    }
#pragma unroll
    for (int i = 0; i < VPT; ++i) {
      const int c = tid + 256 * i;
      vreg[i] = *(const u32x4*)(vp + (long)(c / VCH) * st + (c % VCH) * 8);
    }
  };
  load_tile(0);
  for (int t = 0; t < ntot; ++t) {
    __syncthreads();
#pragma unroll
    for (int i = 0; i < KPT; ++i) {
      const int c = tid + 256 * i;
      *(u32x4*)(Ks + (c / KCH) * KST + (c % KCH) * 8) = kreg[i];
    }
#pragma unroll
    for (int i = 0; i < VPT; ++i) {
      const int c = tid + 256 * i;
      *(u32x4*)(Vs + (c / VCH) * VST + (c % VCH) * 8) = vreg[i];
    }
    __syncthreads();
    if (t + 1 < ntot) load_tile(t + 1);
    __builtin_amdgcn_sched_barrier(0);
#pragma unroll
    for (int s = 0; s < NS; ++s) {
      f32x4 sc[4];
#pragma unroll
      for (int n = 0; n < 4; ++n) {
        sc[n] = (f32x4){0.f, 0.f, 0.f, 0.f};
#pragma unroll
        for (int ks = 0; ks < 2; ++ks) {
          const bf16x8 kf = *(const bf16x8*)(Ks + (n * 16 + l16) * KST + s * 64 + ks * 32 + quad * 8);
          sc[n] = __builtin_amdgcn_mfma_f32_16x16x32_bf16(kf, qf[s][ks], sc[n], 0, 0, 0);
        }
      }
      float mx = -1e30f;
#pragma unroll
      for (int n = 0; n < 4; ++n)
#pragma unroll
        for (int j = 0; j < 4; ++j) {
          float v = sc[n][j] * C2;
          if (LOCAL) {
            if (t >= nt0) {
              const int kr = r0 + (t - nt0), kc = n * 16 + quad * 4 + j;
              const bool ok = (kc >= c0) && (kc < c0 + 16);
              const float bias = rpbh[ok ? ((kr - qi + 7) * 31 + (kc - jq + 15)) : 0];
              v = ok ? v + bias * 1.4426950408889634f : -1e30f;
            }
          }
          sc[n][j] = v;
          mx = fmaxf(mx, v);
        }
      mx = xq_max(mx);
      const float mn = fmaxf(m[s], mx);
      if (__builtin_amdgcn_ballot_w64(mn > m[s]) != 0ull) {
        const float corr = __builtin_amdgcn_exp2f(m[s] - mn);
        l[s] *= corr;
#pragma unroll
        for (int n = 0; n < DV / 16; ++n) O[s][n] *= corr;
        m[s] = mn;
      }
      float rs = 0.f;
#pragma unroll
      for (int n = 0; n < 4; ++n) {
        const float p0 = __builtin_amdgcn_exp2f(sc[n][0] - mn), p1 = __builtin_amdgcn_exp2f(sc[n][1] - mn);
        const float p2 = __builtin_amdgcn_exp2f(sc[n][2] - mn), p3 = __builtin_amdgcn_exp2f(sc[n][3] - mn);
        rs += (p0 + p1) + (p2 + p3);
        u32x2 pk; pk.x = cvt_pk_bf16(p0, p1); pk.y = cvt_pk_bf16(p2, p3);
        *(u32x2*)(Ps + ((wave * NS + s) * 16 + l16) * 80 + n * 16 + quad * 4) = pk;
      }
      l[s] += rs;
    }
    __builtin_amdgcn_wave_barrier();
    {
      bf16x8 pf[NS][2];
#pragma unroll
      for (int s = 0; s < NS; ++s)
#pragma unroll
        for (int ks = 0; ks < 2; ++ks)
          pf[s][ks] = *(const bf16x8*)(Ps + ((wave * NS + s) * 16 + l16) * 80 + ks * 32 + quad * 8);
#pragma unroll
      for (int ks = 0; ks < 2; ++ks)
#pragma unroll
        for (int n = 0; n < DV / 16; ++n) {
          const u16* va = Vs + (ks * 32 + quad * 8 + (l16 >> 2)) * VST + n * 16 + (l16 & 3) * 4;
          typedef __attribute__((ext_vector_type(4))) short s16x4_t;
          const s16x4_t v0 = __builtin_amdgcn_ds_read_tr16_b64_v4i16((__attribute__((address_space(3))) s16x4_t*)va);
          const s16x4_t v1 = __builtin_amdgcn_ds_read_tr16_b64_v4i16((__attribute__((address_space(3))) s16x4_t*)(va + 4 * VST));
          const bf16x8 vf = __builtin_shufflevector(v0, v1, 0, 1, 2, 3, 4, 5, 6, 7);
#pragma unroll
          for (int s = 0; s < NS; ++s) O[s][n] = __builtin_amdgcn_mfma_f32_16x16x32_bf16(vf, pf[s][ks], O[s][n], 0, 0, 0);
        }
    }
  }
  u16* orow = op + (long)(wave * 16 + l16) * ost + quad * 4;
  if (NS == 1) {
    const float il = 1.f / xq_sum(l[0]);
#pragma unroll
    for (int n = 0; n < DV / 16; ++n) {
      u32x2 o; o.x = cvt_pk_bf16(O[0][n][0] * il, O[0][n][1] * il); o.y = cvt_pk_bf16(O[0][n][2] * il, O[0][n][3] * il);
      *(u32x2*)(orow + n * 16) = o;
    }
  } else {
    const float i0 = 1.f / xq_sum(l[0]), i1 = lam / xq_sum(l[NS - 1]);
    float ss = 0.f;
#pragma unroll
    for (int n = 0; n < DV / 16; ++n) {
      O[0][n] = O[0][n] * i0 - O[NS - 1][n] * i1;
      ss += O[0][n][0] * O[0][n][0] + O[0][n][1] * O[0][n][1] + O[0][n][2] * O[0][n][2] + O[0][n][3] * O[0][n][3];
    }
    ss = xq_sum(ss);
    const float ri = rsqrtf(ss * (1.f / (float)DV) + 1e-6f) * outscale;
#pragma unroll
    for (int n = 0; n < DV / 16; ++n) {
      const f32x4 g = *(const f32x4*)(subln + n * 16 + quad * 4);
      u32x2 o; o.x = cvt_pk_bf16(O[0][n][0] * ri * g[0], O[0][n][1] * ri * g[1]); o.y = cvt_pk_bf16(O[0][n][2] * ri * g[2], O[0][n][3] * ri * g[3]);
      *(u32x2*)(orow + n * 16) = o;
    }
  }
}

__device__ __forceinline__ float* yl_ptr(const P& p, int tok, int d, int col) {
  const int slab = tok >> 8;
  return p.out + OUT_DK + (long)(slab >> 5) * 16777216L + ((long)(((slab & 31) * 2 + 1) * 256 + (tok & 255))) * 1024 + d * 512 + col;
}
__device__ __forceinline__ float* tb_ptr(const P& p, int unit, int d, int isB) {
  return (float*)(p.ws + WS_TB) + ((long)((unit * 2 + d) * 2 + isB)) * 4096;
}
__device__ __forceinline__ float ushift(const u16* proj, const float* mu, int tok, int seq0, int slen, int c) {
  const u16* pp = proj + (long)tok * 3328 + 1536 + c;
  const bool hp = tok > seq0, hn = tok < seq0 + slen - 1;
  const float cur = bf2f(pp[0]);
  const float pv = bf2f(pp[hp ? -3328 : 0]);
  const float nv = bf2f(pp[hn ? 3328 : 0]);
  const float prev = hp ? pv : 0.f;
  const float next = hn ? nv : 0.f;
  return cur + mu[c] * (prev - cur) + mu[1792 + c] * (next - cur);
}

__device__ __forceinline__ void rwkv_scan_unit(const P& p, char* smem, int e, int unit) {
  const int gch = unit >> 3, h = unit & 7;
  int seq0, slen;
  if (gch < 64) { seq0 = (gch >> 1) * 256; slen = 256; } else { seq0 = NCTX + ((gch - 64) >> 5) * 4096; slen = 4096; }
  const int t0 = gch * 128;
  float* sc = (float*)smem;
  const u16* proj = (const u16*)(p.ws + WS_BIG);
  const float* mu = p.in[17] + e * 2 * 1792;
  const float* w0 = p.in[18] + e * 1024;
  const float* w2 = p.in[19] + (long)e * 2 * 64 * 512;
  const float* a0 = p.in[20] + e * 1024;
  const float* a2 = p.in[21] + (long)e * 2 * 64 * 512;
  const float* kkw = p.in[22] + e * 512;
  const float* kaw = p.in[23] + e * 512;
  const float* bonus = p.in[24] + e * 1024;
  float* rkb = (float*)(p.ws + WS_RKB);
  float* qt = (float*)(p.ws + WS_QT);
  const int tid = otid(), lane = tid & 63, wave = tid >> 6;
  const int sd = wave >> 1; const bool isB = (wave & 1) != 0;
  const int pd = tid >> 7, th = (tid >> 6) & 1;
  float S[64];
#pragma unroll
  for (int j = 0; j < 64; ++j) S[j] = (!isB && j == lane) ? 1.f : 0.f;
  const int hc = h * 64 + lane;
  const float kkwj = kkw[hc], kawj = kaw[hc], bonj = bonus[pd * 512 + hc], w0j = w0[pd * 512 + hc], a0j = a0[pd * 512 + hc];

  u16* raw = (u16*)(smem + 49152);
  u32x4 rg[3];
  auto load_raw = [&](int lo) {
#pragma unroll
    for (int i = 0; i < 3; ++i) {
      const int c = tid + 256 * i;
      u32x4 v = (u32x4){0u, 0u, 0u, 0u};
      if (c < 720) {
        const int row = c / 40, cc = c % 40, vec = cc >> 3, ch = cc & 7;
        const int tok = lo + row;
        const int voff = (vec < 3) ? (vec * 512 + h * 64) : (1536 + (vec - 3) * 64);
        const int tokc = tok < seq0 ? seq0 : (tok > seq0 + slen - 1 ? seq0 + slen - 1 : tok);
        const u32x4 ld = *(const u32x4*)(proj + (long)tokc * 3328 + 1536 + voff + ch * 8);
        const bool inb = (tok >= seq0) && (tok < seq0 + slen);
        v.x = inb ? ld.x : 0u; v.y = inb ? ld.y : 0u; v.z = inb ? ld.z : 0u; v.w = inb ? ld.w : 0u;
      }
      rg[i] = v;
    }
  };
  auto store_raw = [&]() {
#pragma unroll
    for (int i = 0; i < 3; ++i) {
      const int c = tid + 256 * i;
      if (c < 720) {
        const int row = c / 40, cc = c % 40;
        *(u32x4*)(raw + row * 320 + cc * 8) = rg[i];
      }
    }
  };
  auto shift_dir = [&](int d) {
    float mu0v[5], mu1v[5];
#pragma unroll
    for (int v = 0; v < 5; ++v) {
      const int c = (v < 3) ? (v * 512 + h * 64 + lane) : (1536 + (v - 3) * 64 + lane);
      mu0v[v] = mu[c]; mu1v[v] = mu[1792 + c];
    }
#pragma unroll
    for (int vec = 0; vec < 5; ++vec)
#pragma unroll
      for (int k = 0; k < 4; ++k) {
        const int pslot = wave + 4 * k;
        const int row = (d == 0) ? pslot + 1 : 16 - pslot;
        const u16* rp = raw + row * 320 + vec * 64 + lane;
        const float cur = bf2f(rp[0]), prev = bf2f(rp[-320]), next = bf2f(rp[320]);
        float val = cur + mu0v[vec] * (prev - cur) + mu1v[vec] * (next - cur);
        if (vec == 3) { const float ex = __expf(2.f * val); val = 1.f - 2.f * __builtin_amdgcn_rcpf(ex + 1.f); }
        if (vec >= 3) ((u16*)(sc + (d * 6 + 5) * 1024))[(vec - 3) * 1024 + pslot * 64 + lane] = f2bf(val);
        else sc[((d * 6 + vec) * 16 + pslot) * 64 + lane] = val;
      }
  };
  for (int sub = 0; sub < 8; ++sub) {
    load_raw(t0 + sub * 16 - 1);
    __syncthreads();
    store_raw();
    load_raw(t0 + 127 - sub * 16 - 16);
    __syncthreads();
    shift_dir(0);
    __syncthreads();
    store_raw();
    __syncthreads();
    shift_dir(1);
    __syncthreads();
    {
      const int t2 = otid(), quad = (t2 >> 4) & 3, l16 = t2 & 15, w2i = t2 >> 6, sd2 = w2i >> 1, mat = w2i & 1;
      const u16* at = (const u16*)(sc + (sd2 * 6 + 5) * 1024) + mat * 1024;
      const u16* wt = (const u16*)(p.ws + WS_WT) + ((long)((e * 2 + sd2) * 2 + mat) * 512 + h * 64) * 64;
      bf16x8 af[2];
#pragma unroll
      for (int ks = 0; ks < 2; ++ks) af[ks] = *(const bf16x8*)(at + l16 * 64 + ks * 32 + quad * 8);
#pragma unroll
      for (int nt = 0; nt < 4; ++nt) {
        f32x4 dacc = (f32x4){0.f, 0.f, 0.f, 0.f};
#pragma unroll
        for (int ks = 0; ks < 2; ++ks) {
          const bf16x8 bfr = *(const bf16x8*)(wt + (nt * 16 + l16) * 64 + ks * 32 + quad * 8);
          dacc = __builtin_amdgcn_mfma_f32_16x16x32_bf16(af[ks], bfr, dacc, 0, 0, 0);
        }
#pragma unroll
        for (int j = 0; j < 4; ++j) sc[((sd2 * 6 + 3 + mat) * 16 + quad * 4 + j) * 64 + nt * 16 + l16] = dacc[j];
      }
    }
    __syncthreads();
    {
      float* scw = sc + pd * 6 * 1024;
#pragma unroll
      for (int tk = 0; tk < 8; ++tk) {
        const int pslot = th * 8 + tk;
        const int tok = (pd == 0) ? (t0 + sub * 16 + pslot) : (t0 + 127 - sub * 16 - pslot);
        const float kv = scw[(1 * 16 + pslot) * 64 + lane];
        const float rv = scw[(0 * 16 + pslot) * 64 + lane];
        float kkv = kv * kkwj;
        const float nrm = wave_sum(kkv * kkv);
        kkv *= rsqrtf(fmaxf(nrm, 1e-12f));
        const float xw = -(w0j + scw[(3 * 16 + pslot) * 64 + lane]);
        const float sp = fmaxf(xw, 0.f) + __logf(1.f + __expf(-fabsf(xw)));
        const float decay = __expf(-__expf(-sp - 0.5f));
        const float a = sigmoidf_(a0j + scw[(4 * 16 + pslot) * 64 + lane]);
        const float kt = kv * (1.f + (a - 1.f) * kawj);
        const float bsum = wave_sum(rv * kt * bonj);
        scw[(5 * 16 + pslot) * 64 + lane] = kkv;
        scw[(3 * 16 + pslot) * 64 + lane] = decay;
        scw[(4 * 16 + pslot) * 64 + lane] = kkv * a;
        scw[(1 * 16 + pslot) * 64 + lane] = kt;
        if (lane == 0) rkb[tok * 16 + pd * 8 + h] = bsum;
      }
    }
    __syncthreads();
    if (isB || gch >= 64 || ((gch & 1) == (sd == 0 ? 1 : 0))) {
      const float* base = sc + sd * 6 * 1024;
      for (int ps = 0; ps < 16; ++ps) {
        const f32x4* kk4 = (const f32x4*)(base + (5 * 16 + ps) * 64);
        const f32x4* w4 = (const f32x4*)(base + (3 * 16 + ps) * 64);
        const f32x4* ka4 = (const f32x4*)(base + (4 * 16 + ps) * 64);
        const f32x4* kt4 = (const f32x4*)(base + (1 * 16 + ps) * 64);
        const f32x4* r4 = (const f32x4*)(base + (0 * 16 + ps) * 64);
        f32x4 kk[16];
#pragma unroll
        for (int q = 0; q < 16; ++q) kk[q] = kk4[q];
        f32x4 bw[2][2], bka[2][2], bkt[2][2], br[2][2];
#pragma unroll
        for (int q = 0; q < 2; ++q) { bw[0][q] = w4[q]; bka[0][q] = ka4[q]; br[0][q] = r4[q]; bkt[0][q] = kt4[q]; }
        const float vv = isB ? base[(2 * 16 + ps) * 64 + lane] : 0.f;
        __builtin_amdgcn_sched_barrier(0);
        float s0 = 0.f, s1 = 0.f;
#pragma unroll
        for (int q = 0; q < 16; ++q) {
          s0 += S[q * 4 + 0] * kk[q].x; s1 += S[q * 4 + 1] * kk[q].y; s0 += S[q * 4 + 2] * kk[q].z; s1 += S[q * 4 + 3] * kk[q].w;
        }
        const float nskk = -(s0 + s1);
        float y0 = 0.f, y1 = 0.f;
#pragma unroll
        for (int qq = 0; qq < 8; ++qq) {
          const int cb = qq & 1, nbf = cb ^ 1;
          if (qq < 7) {
#pragma unroll
            for (int q = 0; q < 2; ++q) {
              bw[nbf][q] = w4[(qq + 1) * 2 + q]; bka[nbf][q] = ka4[(qq + 1) * 2 + q];
              br[nbf][q] = r4[(qq + 1) * 2 + q]; bkt[nbf][q] = kt4[(qq + 1) * 2 + q];
            }
          }
          __builtin_amdgcn_sched_barrier(0);
#pragma unroll
          for (int q = 0; q < 2; ++q) {
            const int j = (qq * 2 + q) * 4;
            const f32x4 w = bw[cb][q], ka = bka[cb][q], kt = bkt[cb][q], r = br[cb][q];
            S[j + 0] = fmaf(vv, kt.x, fmaf(nskk, ka.x, S[j + 0] * w.x));
            S[j + 1] = fmaf(vv, kt.y, fmaf(nskk, ka.y, S[j + 1] * w.y));
            S[j + 2] = fmaf(vv, kt.z, fmaf(nskk, ka.z, S[j + 2] * w.z));
            S[j + 3] = fmaf(vv, kt.w, fmaf(nskk, ka.w, S[j + 3] * w.w));
            y0 += S[j + 0] * r.x; y1 += S[j + 1] * r.y; y0 += S[j + 2] * r.z; y1 += S[j + 3] * r.w;
          }
        }
        const int tok = (sd == 0) ? (t0 + sub * 16 + ps) : (t0 + 127 - sub * 16 - ps);
        const float y = y0 + y1;
        if (isB) *yl_ptr(p, tok, sd, hc) = y;
        else qt[((long)tok * 2 + sd) * 512 + hc] = y;
      }
    }
  }
  float4* tp = (float4*)(tb_ptr(p, unit, sd, isB ? 1 : 0) + lane * 64);
#pragma unroll
  for (int q = 0; q < 16; ++q) tp[q] = make_float4(S[q * 4], S[q * 4 + 1], S[q * 4 + 2], S[q * 4 + 3]);
}

__device__ __forceinline__ void rwkv_e3_job(const P& p, char* smem, int e, int job) {
  float* Ss = (float*)smem;
  const int tid = otid(), r = tid >> 4, cgp = tid & 15;
  __syncthreads();
  if (job < 2048) {
    const int chain = job >> 2, rg = job & 3, row = rg * 16 + r;
    const int seq = chain >> 4, h = (chain >> 1) & 7, d = chain & 1;
    const int first = seq * 2 + (d == 0 ? 0 : 1), second = seq * 2 + (d == 0 ? 1 : 0);
    const float* Bf = tb_ptr(p, first * 8 + h, d, 1);
    const float* Ts = tb_ptr(p, second * 8 + h, d, 0);
    const float* Bs = tb_ptr(p, second * 8 + h, d, 1);
    *(float4*)(Ss + r * 64 + cgp * 4) = *(const float4*)(Bf + row * 64 + cgp * 4);
    __syncthreads();
    float4 acc = *(const float4*)(Bs + row * 64 + cgp * 4);
#pragma unroll 8
    for (int i = 0; i < 64; ++i) {
      const float s = Ss[r * 64 + i];
      const float4 t = *(const float4*)(Ts + i * 64 + cgp * 4);
      acc.x += s * t.x; acc.y += s * t.y; acc.z += s * t.z; acc.w += s * t.w;
    }
    *(float4*)(p.out + OUT_ST + ((long)(((seq * 2 + e) * 2 + d) * 8 + h)) * 4096 + row * 64 + cgp * 4) = acc;
  } else {
    const int j2 = job - 2048;
    const int chain = j2 >> 2, rg = j2 & 3, row = rg * 16 + r;
    const int b = chain >> 4, h = (chain >> 1) & 7, d = chain & 1;
    float* Tb = (float*)smem + 1024;
    const float* s0 = p.in[5] + ((long)(((b * 2 + e) * 2 + d) * 8 + h)) * 4096;
    *(float4*)(Ss + r * 64 + cgp * 4) = *(const float4*)(s0 + row * 64 + cgp * 4);
    f32x4 tn[4], bn;
    float* Bcur;
    {
      const int gch = 64 + b * 32 + ((d == 0) ? 0 : 31);
      const float* Tc = tb_ptr(p, gch * 8 + h, d, 0);
      Bcur = tb_ptr(p, gch * 8 + h, d, 1);
#pragma unroll
      for (int q = 0; q < 4; ++q) tn[q] = *(const f32x4*)(Tc + (tid + 256 * q) * 4);
      bn = *(const f32x4*)(Bcur + row * 64 + cgp * 4);
    }
    for (int step = 0; step < 31; ++step) {
      float* Tcur = Tb + (step & 1) * 4096;
#pragma unroll
      for (int q = 0; q < 4; ++q) *(f32x4*)(Tcur + (tid + 256 * q) * 4) = tn[q];
      f32x4 acc = bn;
      float* Bst = Bcur;
      __syncthreads();
      if (step + 1 < 31) {
        const int c = (d == 0) ? step + 1 : 30 - step;
        const int gch = 64 + b * 32 + c;
        const float* Tc = tb_ptr(p, gch * 8 + h, d, 0);
        Bcur = tb_ptr(p, gch * 8 + h, d, 1);
#pragma unroll
        for (int q = 0; q < 4; ++q) tn[q] = *(const f32x4*)(Tc + (tid + 256 * q) * 4);
        bn = *(const f32x4*)(Bcur + row * 64 + cgp * 4);
      }
#pragma unroll 16
      for (int i = 0; i < 64; ++i) {
        const float sv = Ss[r * 64 + i];
        const f32x4 t = *(const f32x4*)(Tcur + i * 64 + cgp * 4);
        acc += sv * t;
      }
      __syncthreads();
      *(f32x4*)(Ss + r * 64 + cgp * 4) = acc;
      *(f32x4*)(Bst + row * 64 + cgp * 4) = acc;
    }
  }
}

__device__ __forceinline__ void rwkv_e4_unit(const P& p, char* smem, int e, int unit) {
  const int gch = unit >> 3, h = unit & 7;
  int seq0, slen, cidx, nch;
  if (gch < 64) { seq0 = (gch >> 1) * 256; slen = 256; cidx = gch & 1; nch = 2; }
  else { seq0 = NCTX + ((gch - 64) >> 5) * 4096; slen = 4096; cidx = (gch - 64) & 31; nch = 32; }
  const int tid = otid(), lane = tid & 63, wave = tid >> 6;
  float* qbuf = (float*)smem + wave * 1024;
  float* dout = qbuf;
  u16* G2T = (u16*)(smem + 16384);
  u16* SGw = (u16*)(smem + 34816) + wave * 16 * 144;
  const u16* proj = (const u16*)(p.ws + WS_BIG);
  const float* mu = p.in[17] + e * 2 * 1792;
  const float* g2 = p.in[25] + (long)e * 128 * 512;
  const float* rkb = (const float*)(p.ws + WS_RKB);
  const float* qt = (const float*)(p.ws + WS_QT);
  u16* mix = (u16*)(p.ws + WS_MIX);
  const int hc = h * 64 + lane;
  const int quad = lane >> 4, l16 = lane & 15;
  __syncthreads();
#pragma unroll 8
  for (int idx = tid; idx < 8192; idx += 256) G2T[(idx & 63) * 144 + (idx >> 6)] = f2bf(g2[(long)(idx >> 6) * 512 + h * 64 + (idx & 63)]);
  __syncthreads();
  const float lnw = p.in[26][e * 512 + hc], lnb = p.in[27][e * 512 + hc];
  const int cg0 = 1536 + 1664 + lane, cg1 = 1536 + 1728 + lane, cv = 1536 + 1024 + hc;
  const float m0g0 = mu[1664 + lane], m1g0 = mu[1792 + 1664 + lane];
  const float m0g1 = mu[1728 + lane], m1g1 = mu[1792 + 1728 + lane];
  const float m0v = mu[1024 + hc], m1v = mu[1792 + 1024 + hc];
  for (int hf = 0; hf < 2; ++hf) {
    const int tw0 = gch * 128 + wave * 32 + hf * 16;
    float yv[16];
#pragma unroll
    for (int tk = 0; tk < 16; ++tk) yv[tk] = *yl_ptr(p, tw0 + tk, 0, hc) + *yl_ptr(p, tw0 + tk, 1, hc);
    for (int d = 0; d < 2; ++d) {
      const int oi = (d == 0) ? cidx : nch - 1 - cidx;
      const float* Sp = nullptr;
      if (oi == 0) {
        if (gch >= 64) Sp = p.in[5] + ((long)(((((gch - 64) >> 5) * 2 + e) * 2 + d) * 8 + h)) * 4096;
      } else {
        const int gp = (d == 0) ? gch - 1 : gch + 1;
        Sp = tb_ptr(p, gp * 8 + h, d, 1);
      }
      if (Sp != nullptr) {
        float S[64];
#pragma unroll
        for (int q = 0; q < 16; ++q) {
          const f32x4 v = *(const f32x4*)(Sp + lane * 64 + q * 4);
          S[q * 4] = v[0]; S[q * 4 + 1] = v[1]; S[q * 4 + 2] = v[2]; S[q * 4 + 3] = v[3];
        }
        f32x4 qv[4];
#pragma unroll
        for (int i = 0; i < 4; ++i) {
          const int idx = lane + 64 * i, r = idx >> 4, c4 = idx & 15;
          qv[i] = *(const f32x4*)(qt + ((long)(tw0 + r) * 2 + d) * 512 + h * 64 + c4 * 4);
        }
        __builtin_amdgcn_wave_barrier();
#pragma unroll
        for (int i = 0; i < 4; ++i) *(f32x4*)(qbuf + (lane + 64 * i) * 4) = qv[i];
        __builtin_amdgcn_wave_barrier();
#pragma unroll
        for (int r = 0; r < 16; ++r) {
          float y0 = 0.f, y1 = 0.f;
#pragma unroll
          for (int q = 0; q < 16; ++q) {
            const f32x4 v = *(const f32x4*)(qbuf + r * 64 + q * 4);
            y0 += S[q * 4] * v[0]; y1 += S[q * 4 + 1] * v[1]; y0 += S[q * 4 + 2] * v[2]; y1 += S[q * 4 + 3] * v[3];
          }
          yv[r] += y0 + y1;
        }
        __builtin_amdgcn_wave_barrier();
      }
    }
    float rkl = 0.f;
    if (lane < 16) rkl = rkb[(tw0 + lane) * 16 + h] + rkb[(tw0 + lane) * 16 + 8 + h];
    auto ldrow = [&](int r, float& a, float& b, float& c) {
      const bool ok = (r >= seq0) && (r < seq0 + slen);
      const u16* rp = proj + (long)(ok ? r : tw0) * 3328;
      const float x = bf2f(rp[cg0]), y = bf2f(rp[cg1]), z = bf2f(rp[cv]);
      a = ok ? x : 0.f; b = ok ? y : 0.f; c = ok ? z : 0.f;
    };
    float pg0, pg1, pvv, cg0v, cg1v, cvv, ng0, ng1, nvv;
    ldrow(tw0 - 1, pg0, pg1, pvv);
    ldrow(tw0, cg0v, cg1v, cvv);
    ldrow(tw0 + 1, ng0, ng1, nvv);
    float vshv[16];
#pragma unroll
    for (int tk = 0; tk < 16; ++tk) {
      float fg0, fg1, fvv;
      ldrow(tw0 + tk + 2, fg0, fg1, fvv);
      const float gv0 = sigmoidf_(cg0v + m0g0 * (pg0 - cg0v) + m1g0 * (ng0 - cg0v));
      const float gv1 = sigmoidf_(cg1v + m0g1 * (pg1 - cg1v) + m1g1 * (ng1 - cg1v));
      vshv[tk] = cvv + m0v * (pvv - cvv) + m1v * (nvv - cvv);
      pg0 = cg0v; pg1 = cg1v; pvv = cvv; cg0v = ng0; cg1v = ng1; cvv = nvv; ng0 = fg0; ng1 = fg1; nvv = fvv;
      SGw[tk * 144 + lane] = f2bf(gv0);
      SGw[tk * 144 + 64 + lane] = f2bf(gv1);
    }
    __builtin_amdgcn_wave_barrier();
    {
      bf16x8 af[4];
#pragma unroll
      for (int ks = 0; ks < 4; ++ks) af[ks] = *(const bf16x8*)(SGw + l16 * 144 + ks * 32 + quad * 8);
#pragma unroll
      for (int nt = 0; nt < 4; ++nt) {
        f32x4 dacc = (f32x4){0.f, 0.f, 0.f, 0.f};
#pragma unroll
        for (int ks = 0; ks < 4; ++ks) {
          const bf16x8 bfr = *(const bf16x8*)(G2T + (nt * 16 + l16) * 144 + ks * 32 + quad * 8);
          dacc = __builtin_amdgcn_mfma_f32_16x16x32_bf16(af[ks], bfr, dacc, 0, 0, 0);
        }
#pragma unroll
        for (int j = 0; j < 4; ++j) dout[(quad * 4 + j) * 64 + nt * 16 + l16] = dacc[j];
      }
    }
    __builtin_amdgcn_wave_barrier();
#pragma unroll
    for (int tk = 0; tk < 16; ++tk) {
      const int tok = tw0 + tk;
      const float rk = __int_as_float(__builtin_amdgcn_readlane(__float_as_int(rkl), tk));
      const float gate = dout[tk * 64 + lane];
      const float y = yv[tk];
      const float mean = wave_sum(y) * (1.f / 64.f);
      const float dv = y - mean;
      const float var = wave_sum(dv * dv) * (1.f / 64.f);
      const float yn = dv * rsqrtf(var + 64e-5f) * lnw + lnb;
      mix[(long)tok * 1024 + 512 + hc] = f2bf((yn + rk * vshv[tk]) * gate);
    }
    __builtin_amdgcn_wave_barrier();
  }
}

#define XB_TMO      128
#define XB_XCNT(j)  (256  + 64 * (j))
#define XB_XSUB(j)  (1280 + 64 * (j))
#define XB_XGEN(j)  (2304 + 64 * (j))
#define XB_TOP      3328
#define XB_TOPGEN   3392
#define XCD_BAR_WORDS 3456
#define XB_SPIN_CAP (1u << 22)
#define LAS __attribute__((address_space(3)))
__device__ __forceinline__ unsigned xb_ld(unsigned* p)              { return __hip_atomic_load(p, __ATOMIC_RELAXED, __HIP_MEMORY_SCOPE_AGENT); }
__device__ __forceinline__ unsigned xb_add(unsigned* p, unsigned v) { return __hip_atomic_fetch_add(p, v, __ATOMIC_RELAXED, __HIP_MEMORY_SCOPE_AGENT); }
__device__ __forceinline__ unsigned xb_xcc_id() { return (unsigned)__builtin_amdgcn_s_getreg((3 << 11) | 20) & 0xFu; }
#define XB_SPIN(cond, bar) do { unsigned _sp = 0; while (cond) { __builtin_amdgcn_s_sleep(1); \
    if ((++_sp & 255u) == 0u) { if (xb_ld(&(bar)[XB_TMO])) break; if (_sp > XB_SPIN_CAP) { atomicAdd(&(bar)[XB_TMO], 1u); break; } } } } while (0)
struct XcdBarrier { unsigned* bar; unsigned x; volatile LAS unsigned* st; };
__device__ __forceinline__ XcdBarrier xcd_barrier_post(unsigned* bar, volatile LAS unsigned* st) {
  XcdBarrier b; b.bar = bar; b.x = xb_xcc_id(); b.st = st;
  if (threadIdx.x == 0) (void)xb_add(&bar[XB_XCNT(b.x)], 1u);
  return b;
}
__device__ __forceinline__ void xcd_barrier_complete(unsigned* bar, unsigned x, unsigned& nloc, unsigned& nx) {
  const unsigned G = gridDim.x * gridDim.y * gridDim.z;
  unsigned sum, cnt, mine, sp = 0u;
  for (;;) {
    sum = 0u; cnt = 0u; mine = 0u;
#pragma unroll
    for (unsigned j = 0; j < 16; ++j) { const unsigned c = xb_ld(&bar[XB_XCNT(j)]); sum += c; cnt += (c > 0u) ? 1u : 0u; mine = (j == x) ? c : mine; }
    if (sum == G) break;
    __builtin_amdgcn_s_sleep(1);
    if ((++sp & 255u) == 0u) { if (xb_ld(&bar[XB_TMO])) break; if (sp > XB_SPIN_CAP) { atomicAdd(&bar[XB_TMO], 1u); break; } }
  }
  nloc = mine > 0u ? mine : 1u; nx = cnt > 0u ? cnt : 1u;
}
__device__ __forceinline__ void xcd_barrier(const XcdBarrier& b0) {
  XcdBarrier b; b.bar = b0.bar; b.st = b0.st; b.x = (unsigned)__builtin_amdgcn_readfirstlane((int)xb_xcc_id());
  asm volatile("s_waitcnt vmcnt(0)" ::: "memory");
  __syncthreads();
  if (threadIdx.x == 0) {
    unsigned* bar = b.bar;
    __builtin_amdgcn_s_waitcnt(0);
    unsigned nloc = b.st[0], nx = b.st[1];
    if (nloc == 0u) { xcd_barrier_complete(bar, b.x, nloc, nx); b.st[0] = nloc; b.st[1] = nx; }
    const unsigned old = xb_add(&bar[XB_XSUB(b.x)], 1u);
    const unsigned gen = old / nloc;
    if (old + 1u == (gen + 1u) * nloc) {
      __builtin_amdgcn_fence(__ATOMIC_RELEASE, "agent");
      asm volatile("s_waitcnt vmcnt(0)" ::: "memory");
      const unsigned og = xb_add(&bar[XB_TOP], 1u);
      const unsigned tg = og / nx;
      if (og + 1u == (tg + 1u) * nx) xb_add(&bar[XB_TOPGEN], 1u);
      else XB_SPIN(xb_ld(&bar[XB_TOPGEN]) == tg, bar);
      __builtin_amdgcn_fence(__ATOMIC_ACQUIRE, "agent");
      xb_add(&bar[XB_XGEN(b.x)], 1u);
      asm volatile("s_waitcnt vmcnt(0)" ::: "memory");
    } else {
      XB_SPIN(xb_ld(&bar[XB_XGEN(b.x)]) == gen, bar);
      __builtin_amdgcn_fence(__ATOMIC_ACQUIRE, "agent");
      asm volatile("s_waitcnt vmcnt(0)" ::: "memory");
    }
  }
  __syncthreads();
}

__device__ __forceinline__ void norm_job(const P& p, int job, const float* gvec, const float* modl, int shift_idx) {
  const int t = otid();
  const int row = job * 4 + (t >> 6), lane = t & 63;
  const int grp = row < NCTX ? 0 : 1 + ((row - NCTX) >> 12);
  const float* modv = modl + grp * 6144;
  const float* x = p.out + (long)row * 1024;
  u16* H = (u16*)(p.ws + WS_MIX) + (long)row * 1024;
  float4 v[4];
  float ss = 0.f;
#pragma unroll
  for (int i = 0; i < 4; ++i) {
    v[i] = *(const float4*)(x + (i * 64 + lane) * 4);
    ss += v[i].x * v[i].x + v[i].y * v[i].y + v[i].z * v[i].z + v[i].w * v[i].w;
  }
  ss = wave_sum(ss);
  const float r = rsqrtf(ss * (1.f / 1024.f) + 1e-6f);
#pragma unroll
  for (int i = 0; i < 4; ++i) {
    const int k = (i * 64 + lane) * 4;
    const float4 g = *(const float4*)(gvec + k);
    const float4 sc = *(const float4*)(modv + (shift_idx + 1) * 1024 + k);
    const float4 sh = *(const float4*)(modv + shift_idx * 1024 + k);
    u32x2 o;
    o.x = pack2(v[i].x * r * g.x * (1.f + sc.x) + sh.x, v[i].y * r * g.y * (1.f + sc.y) + sh.y);
    o.y = pack2(v[i].z * r * g.z * (1.f + sc.z) + sh.z, v[i].w * r * g.w * (1.f + sc.w) + sh.w);
    *(u32x2*)(H + k) = o;
  }
}

__device__ __forceinline__ void final_job(const P& p, int job) {
  const int t = otid();
  const int row = job * 4 + (t >> 6), lane = t & 63;
  float* x = p.out + (long)row * 1024;
  float4 v[4];
  float ss = 0.f;
#pragma unroll
  for (int i = 0; i < 4; ++i) {
    v[i] = *(const float4*)(x + (i * 64 + lane) * 4);
    ss += v[i].x * v[i].x + v[i].y * v[i].y + v[i].z * v[i].z + v[i].w * v[i].w;
  }
  ss = wave_sum(ss);
  const float r = rsqrtf(ss * (1.f / 1024.f) + 1e-6f);
#pragma unroll
  for (int i = 0; i < 4; ++i) {
    const float4 g = *(const float4*)(p.in[13] + (i * 64 + lane) * 4);
    float4 o;
    o.x = v[i].x * r * g.x; o.y = v[i].y * r * g.y; o.z = v[i].z * r * g.z; o.w = v[i].w * r * g.w;
    *(float4*)(x + (i * 64 + lane) * 4) = o;
  }
}

#ifndef PHMASK
#define PHMASK 0xffff
#endif
#define PHON(k) (((PHMASK) >> (k)) & 1)
#ifndef DUPMASK
#define DUPMASK 0
#endif
#define NREP(k) ((((DUPMASK) >> (k)) & 1) ? 2 : 1)
__global__ void __launch_bounds__(256, 2) fwd_megakernel(P p) {
  cg::grid_group grid = cg::this_grid();
  __shared__ __attribute__((aligned(16))) char smem[SMEM_BYTES];
  __shared__ uint4 xb_words;
  if (threadIdx.x == 0) xb_words = make_uint4(0u, 0u, 0u, 0u);
  __syncthreads();
  XcdBarrier xb = xcd_barrier_post((unsigned*)(p.ws + WS_BAR), (volatile LAS unsigned*)&xb_words);
  const int nb = gridDim.x, bid0 = blockIdx.x;
  int bid = bid0;
  asm volatile("" : "+s"(bid));
  float* mod = (float*)(p.ws + WS_MOD);
  u16* big = (u16*)(p.ws + WS_BIG);
  u16* mix = (u16*)(p.ws + WS_MIX);

  for (int rep = 0; rep < NREP(0); ++rep)
  for (int job = bid; job < 384 + N_CONV_JOBS + 3072 + 4096 + 128; job += nb) {
    if (!PHON(0)) break;
    if (job >= 384 + N_CONV_JOBS + 3072 + 4096) loracvt_job(p, job - (384 + N_CONV_JOBS + 3072 + 4096));
    else if (job < 384) adaln_job(p, smem, job);
    else if (job < 384 + N_CONV_JOBS) conv_job(p, smem, job - 384);
    else if (job < 384 + N_CONV_JOBS + 3072) cachecvt_job(p, job - 384 - N_CONV_JOBS);
    else xcopy_job(p, job - 384 - N_CONV_JOBS - 3072);
  }
  if (p.ws == nullptr) grid.sync();
  xcd_barrier(xb);

  for (int l = 0; l < 4; ++l) {
    int bid = bid0;
    asm volatile("" : "+s"(bid));
    const float* modl = mod + l * 3 * 6144;
    const int sub = l >> 1;
    const bool even = (l & 1) == 0;
    for (int lj = bid >> 3; lj < 512; lj += (nb >> 3)) norm_job(p, (bid & 7) * 512 + lj, p.in[11] + l * 1024, modl, 0);
    xcd_barrier(xb);
    if (even) {
      if (PHON(1)) gemm_phase<0, 0, 256>(p, smem, mix, 1024, (const u16*)(p.ws + WS_WIN) + (long)sub * 3328 * 1024, 3328,
                                    nullptr, modl, 0, 0, sub, big);
    } else {
      if (PHON(7)) gemm_phase<0, 1, 128>(p, smem, mix, 1024, (const u16*)(p.ws + WS_WQKV) + (long)sub * 3072 * 1024, 3072,
                                    nullptr, modl, 0, 0, sub, big);
    }
    xcd_barrier(xb);
    if (even) {
      const int e = sub;
      for (int rep = 0; rep < NREP(2); ++rep)
      for (int job = bid; job < 3072; job += nb) {
        if (job < 1024) { if (PHON(2)) rwkv_scan_unit(p, smem, e, job); }
        else if (!PHON(3)) {}
        else if (job < 2048) {
          const int j = job - 1024;
          const int b = j >> 9, h = (j >> 6) & 7, qi = j & 63;
          int r0 = qi - 4; r0 = r0 < 0 ? 0 : (r0 > 56 ? 56 : r0);
          const long tq = NCTX + b * 4096 + qi * 64, tk = NCTX + b * 4096 + r0 * 64;
          attn_job<1, 64, true>(smem, big + tq * 3328 + h * 64, 3328,
                                (const u16*)(p.ws + WS_CNK) + (long)(b * 2 + e) * 512 * 512 + h * 64,
                                (const u16*)(p.ws + WS_CNV) + (long)(b * 2 + e) * 512 * 512 + h * 64, 512, 512,
                                big + tk * 3328 + 512 + h * 64, big + tk * 3328 + 1024 + h * 64, 3328, 512,
                                p.in[16] + (long)(e * 8 + h) * 15 * 31, qi, r0, 0.f, 0.f, nullptr,
                                mix + tq * 1024 + h * 64, 1024);
        } else {
          const int j = job - 2048;
          const int b = j >> 5, h = (j >> 2) & 7, qb = j & 3;
          const long tq = b * 256 + qb * 64, tk = b * 256;
          attn_job<1, 64, false>(smem, big + tq * 3328 + h * 64, 3328,
                                 big + tk * 3328 + 512 + h * 64, big + tk * 3328 + 1024 + h * 64, 3328, 256,
                                 nullptr, nullptr, 0, 0, nullptr, 0, 0, 0.f, 0.f, nullptr,
                                 mix + tq * 1024 + h * 64, 1024);
        }
      }
      xcd_barrier(xb);
      for (int ph = 0; ph < 2; ++ph) {
        if (ph == 0) {
          if (PHON(4)) for (int job = bid; job < 2176; job += nb) rwkv_e3_job(p, smem, e, job < 128 ? job + 2048 : job - 128);
        }
        const bool spare = nb > 256;
        const int first = (ph == 0) ? (spare ? bid - 128 : bid) : bid;
        const int step = (ph == 0 && spare) ? nb - 128 : nb;
        if (PHON(5) && first >= 0)
          for (int u = first; u < 512; u += step) rwkv_e4_unit(p, smem, e, (ph == 0 ? 0 : 512) + u);
        if (ph == 0) xcd_barrier(xb);
      }
    } else {
      const int o = sub;
      const float lam_init = 0.8f - 0.6f * __expf(-0.3f * (float)l);
      float d0 = 0.f, d1 = 0.f;
      for (int i = 0; i < 64; ++i) {
        d0 += p.in[30][o * 128 + i] * p.in[31][o * 128 + i];
        d1 += p.in[30][o * 128 + 64 + i] * p.in[31][o * 128 + 64 + i];
      }
      const float lam = __expf(d0) - __expf(d1) + lam_init;
      for (int rep = 0; rep < NREP(8); ++rep)
      if (PHON(8)) for (int job = bid; job < 2048; job += nb) {
        long tq, tk; int h, n0, n1; const u16 *k0, *v0; int st0;
        if (job < 1024) {
          const int x = job & 7, lj = job >> 3;
          const int pair = x + 8 * (lj >> 6), qb = lj & 63;
          const int b = pair >> 3; h = pair & 7;
          tq = NCTX + b * 4096 + qb * 64; tk = NCTX + b * 4096;
          k0 = (const u16*)(p.ws + WS_CDK) + (long)(b * 2 + o) * 512 * 1024 + h * 128;
          v0 = (const u16*)(p.ws + WS_CDV) + (long)(b * 2 + o) * 512 * 1024 + h * 128;
          st0 = 1024; n0 = 512; n1 = 4096;
        } else {
          const int j = job - 1024;
          const int b = j >> 5, qb = j & 3; h = (j >> 2) & 7;
          tq = b * 256 + qb * 64; tk = b * 256;
          k0 = big + tk * 3072 + 1024 + h * 128; v0 = big + tk * 3072 + 2048 + h * 128;
          st0 = 3072; n0 = 256; n1 = 0;
        }
        attn_job<2, 128, false>(smem, big + tq * 3072 + h * 128, 3072, k0, v0, st0, n0,
                                big + tk * 3072 + 1024 + h * 128, big + tk * 3072 + 2048 + h * 128, 3072, n1,
                                nullptr, 0, 0, lam, 1.f - lam_init, p.in[32] + o * 128,
                                mix + tq * 1024 + h * 128, 1024);
      }
    }
    xcd_barrier(xb);
    for (int g = 0; g < 2; ++g) {
      if (g == 1) {
        for (int lj = bid >> 3; lj < 512; lj += (nb >> 3)) norm_job(p, (bid & 7) * 512 + lj, p.in[12] + l * 1024, modl, 3);
        xcd_barrier(xb);
        for (int rep = 0; rep < NREP(9); ++rep)
        if (PHON(9)) gemm_phase<0, 3, 256>(p, smem, mix, 1024, (const u16*)(p.ws + WS_W13) + (long)l * 5632 * 1024, 5632,
                                      nullptr, modl, 3, 0, 0, big);
        xcd_barrier(xb);
      }
      const u16* A2 = g == 0 ? mix : big;
      const int K2 = g == 0 ? 1024 : 2816;
      const u16* B2 = g == 0 ? (even ? (const u16*)(p.ws + WS_WOE) + (long)sub * 1024 * 1024 : (const u16*)(p.ws + WS_WOD) + (long)sub * 1024 * 1024)
                             : (const u16*)(p.ws + WS_W2) + (long)l * 1024 * 2816;
      if (PHON(6)) gemm_phase<0, 2, 256>(p, smem, A2, K2, B2, 1024, nullptr, modl, 0, g == 0 ? 2 : 5, 0, nullptr);
      xcd_barrier(xb);
    }
  }
  if (PHON(10)) for (int lj = bid >> 3; lj < 512; lj += (nb >> 3)) final_job(p, (bid & 7) * 512 + lj);
}

extern "C" void kernel_launch(void* const* d_in, const int* in_sizes, int n_in, void* d_out, int out_size,
                              void* d_ws, size_t ws_size, hipStream_t stream) {
  static int grid_blocks = 0;
  if (!grid_blocks) {
    int dev = 0, cus = 0, per_cu = 0;
    (void)hipGetDevice(&dev);
    (void)hipDeviceGetAttribute(&cus, hipDeviceAttributeMultiprocessorCount, dev);
    (void)hipOccupancyMaxActiveBlocksPerMultiprocessor(&per_cu, fwd_megakernel, 256, 0);
    (void)per_cu;
    grid_blocks = cus * 2;
  }
  if (ws_size < (size_t)WS_TOTAL) { fprintf(stderr, "workspace too small: %zu < %ld\n", ws_size, (long)WS_END); return; }
  P p{};
  for (int i = 0; i < 36; ++i) p.in[i] = (const float*)d_in[i];
  p.out = (float*)d_out;
  p.ws = (char*)d_ws;
  (void)hipMemsetAsync((char*)d_ws + WS_BAR, 0, XCD_BAR_WORDS * 4, stream);
  void* args[] = {&p};
  hipError_t e = hipLaunchCooperativeKernel((void*)fwd_megakernel, dim3(grid_blocks), dim3(256), args, 0, stream);
  if (e != hipSuccess) fprintf(stderr, "cooperative launch failed: %s (grid %d)\n", hipGetErrorString(e), grid_blocks);
}
```

```cpp
#include <hip/hip_runtime.h>
#include <hip/hip_cooperative_groups.h>
#include <cstdio>
namespace cg = cooperative_groups;

typedef unsigned short u16;
typedef __attribute__((ext_vector_type(8))) short bf16x8;
typedef __attribute__((ext_vector_type(4))) float f32x4;
typedef __attribute__((ext_vector_type(4))) unsigned u32x4;
typedef __attribute__((ext_vector_type(2))) unsigned u32x2;

#define NTOK 16384
#define NCTX 8192
#define OUT_NAK 16777216L
#define OUT_NAV 25165824L
#define OUT_ST  33554432L
#define OUT_DK  37748736L
#define OUT_DV  54525952L
#define WS_WIN   0L
#define WS_WOE   13631488L
#define WS_WQKV  17825792L
#define WS_WOD   30408704L
#define WS_W13   34603008L
#define WS_W2    80740352L
#define WS_CNK   103809024L
#define WS_CNV   105906176L
#define WS_CDK   108003328L
#define WS_CDV   112197632L
#define WS_MOD   116391936L
#define WS_ROWSS 116686848L
#define WS_RKB   117735424L
#define WS_MIX   118784000L
#define WS_BIG   152338432L
#define WS_TB    261390336L
#define WS_QT    328499200L
#define WS_END   395608064L
#define WS_BAR   395624448L
#define WS_WT    395640832L
#define WS_TOTAL 396165120L

struct P {
  const float* in[36];
  float* out;
  char* ws;
};

#define SMEM_BYTES 61440

typedef __attribute__((ext_vector_type(2))) float f32x2_t;
typedef __attribute__((ext_vector_type(2))) __bf16 bf16x2_t;
__device__ __forceinline__ u16 f2bf(float f) { return __builtin_bit_cast(u16, (__bf16)f); }
__device__ __forceinline__ float bf2f(u16 h) { return __uint_as_float(((unsigned)h) << 16); }
__device__ __forceinline__ unsigned pack2(float a, float b) {
  const f32x2_t v = {a, b};
  return __builtin_bit_cast(unsigned, __builtin_convertvector(v, bf16x2_t));
}
template <int CTRL>
__device__ __forceinline__ float dpp_mov(float v) {
  return __int_as_float(__builtin_amdgcn_update_dpp(0, __float_as_int(v), CTRL, 0xf, 0xf, false));
}
__device__ __forceinline__ float g16_sum(float v) {
  v += dpp_mov<0xB1>(v);
  v += dpp_mov<0x4E>(v);
  v += dpp_mov<0x124>(v);
  v += dpp_mov<0x128>(v);
  return v;
}
__device__ __forceinline__ float g16_max(float v) {
  v = fmaxf(v, dpp_mov<0xB1>(v));
  v = fmaxf(v, dpp_mov<0x4E>(v));
  v = fmaxf(v, dpp_mov<0x124>(v));
  v = fmaxf(v, dpp_mov<0x128>(v));
  return v;
}
__device__ __forceinline__ float wave_sum(float v) {
  v = g16_sum(v);
  const float r0 = __int_as_float(__builtin_amdgcn_readlane(__float_as_int(v), 0));
  const float r1 = __int_as_float(__builtin_amdgcn_readlane(__float_as_int(v), 16));
  const float r2 = __int_as_float(__builtin_amdgcn_readlane(__float_as_int(v), 32));
  const float r3 = __int_as_float(__builtin_amdgcn_readlane(__float_as_int(v), 48));
  return (r0 + r1) + (r2 + r3);
}
__device__ __forceinline__ int otid() { int t = threadIdx.x; asm volatile("" : "+v"(t)); return t; }
__device__ __forceinline__ float sigmoidf_(float x) { return __builtin_amdgcn_rcpf(1.f + __expf(-x)); }

struct ConvT { const float* src; u16* dst; int K, N, mode, kt, nt; };
__device__ __forceinline__ ConvT conv_params(const P& p, int job) {
  ConvT c;
  if (job < 1664) {
    int e = job / 832, r = job % 832;
    c.src = p.in[14] + (long)e * 1024 * 3328; c.K = 1024; c.N = 3328; c.dst = (u16*)(p.ws + WS_WIN) + (long)e * 3328 * 1024; c.mode = 0; c.kt = r / 52; c.nt = r % 52;
    return c;
  }
  job -= 1664;
  if (job < 512) {
    int e = job / 256, r = job % 256;
    c.src = p.in[15] + (long)e * 1024 * 1024; c.K = 1024; c.N = 1024; c.dst = (u16*)(p.ws + WS_WOE) + (long)e * 1024 * 1024; c.mode = 0; c.kt = r / 16; c.nt = r % 16;
    return c;
  }
  job -= 512;
  if (job < 1536) {
    int e = job / 768, r = job % 768;
    c.src = p.in[28] + (long)e * 1024 * 3072; c.K = 1024; c.N = 3072; c.dst = (u16*)(p.ws + WS_WQKV) + (long)e * 3072 * 1024; c.mode = 0; c.kt = r / 48; c.nt = r % 48;
    return c;
  }
  job -= 1536;
  if (job < 512) {
    int e = job / 256, r = job % 256;
    c.src = p.in[29] + (long)e * 1024 * 1024; c.K = 1024; c.N = 1024; c.dst = (u16*)(p.ws + WS_WOD) + (long)e * 1024 * 1024; c.mode = 0; c.kt = r / 16; c.nt = r % 16;
    return c;
  }
  job -= 512;
  if (job < 2816) {
    int l = job / 704, r = job % 704;
    c.src = p.in[33] + (long)l * 1024 * 2816; c.K = 1024; c.N = 2816; c.dst = (u16*)(p.ws + WS_W13) + (long)l * 5632 * 1024; c.mode = 1; c.kt = r / 44; c.nt = r % 44;
    return c;
  }
  job -= 2816;
  if (job < 2816) {
    int l = job / 704, r = job % 704;
    c.src = p.in[34] + (long)l * 1024 * 2816; c.K = 1024; c.N = 2816; c.dst = (u16*)(p.ws + WS_W13) + (long)l * 5632 * 1024; c.mode = 2; c.kt = r / 44; c.nt = r % 44;
    return c;
  }
  job -= 2816;
  {
    int l = job / 704, r = job % 704;
    c.src = p.in[35] + (long)l * 2816 * 1024; c.K = 2816; c.N = 1024; c.dst = (u16*)(p.ws + WS_W2) + (long)l * 1024 * 2816; c.mode = 0; c.kt = r / 16; c.nt = r % 16;
  }
  return c;
}
__device__ __forceinline__ void conv_job(const P& p, char* smem, int job2) {
  const int tid = otid();
  float* tile = (float*)smem;
  ConvT c[2];
  c[0] = conv_params(p, 2 * job2);
  c[1] = conv_params(p, 2 * job2 + 1);
  float v[2][16];
#pragma unroll
  for (int t = 0; t < 2; ++t)
#pragma unroll
    for (int i = 0; i < 16; ++i) {
      const int kl = (tid >> 6) + 4 * i, nl = tid & 63;
      v[t][i] = c[t].src[(long)(c[t].kt * 64 + kl) * c[t].N + c[t].nt * 64 + nl];
    }
  __syncthreads();
#pragma unroll
  for (int t = 0; t < 2; ++t)
#pragma unroll
    for (int i = 0; i < 16; ++i) {
      const int kl = (tid >> 6) + 4 * i, nl = tid & 63;
      tile[t * 4160 + kl * 65 + nl] = v[t][i];
    }
  __syncthreads();
#pragma unroll
  for (int t = 0; t < 2; ++t)
#pragma unroll
    for (int i = 0; i < 2; ++i) {
      const int task = tid + 256 * i;
      const int kg = task & 7, nl = task >> 3;
      const int n = c[t].nt * 64 + nl;
      int nd = n;
      if (c[t].mode == 1) nd = (n >> 5) * 64 + (n & 31);
      else if (c[t].mode == 2) nd = (n >> 5) * 64 + 32 + (n & 31);
      const float* tt = tile + t * 4160;
      u32x4 o;
      o.x = pack2(tt[(kg * 8 + 0) * 65 + nl], tt[(kg * 8 + 1) * 65 + nl]);
      o.y = pack2(tt[(kg * 8 + 2) * 65 + nl], tt[(kg * 8 + 3) * 65 + nl]);
      o.z = pack2(tt[(kg * 8 + 4) * 65 + nl], tt[(kg * 8 + 5) * 65 + nl]);
      o.w = pack2(tt[(kg * 8 + 6) * 65 + nl], tt[(kg * 8 + 7) * 65 + nl]);
      *(u32x4*)(c[t].dst + (long)nd * c[t].K + c[t].kt * 64 + kg * 8) = o;
    }
}
#define N_CONV_JOBS 6336

__device__ __forceinline__ void adaln_job(const P& p, char* smem, int job) {
  const int l = job / 96, cgp = job % 96;
  const int tid = otid();
  float* sil = (float*)smem;
  float* red = sil + 3072;
  __syncthreads();
  for (int i = tid; i < 3072; i += 256) {
    int v = i >> 10, k = i & 1023;
    float c = (v == 0) ? p.in[8][k] : p.in[2][(v - 1) * 1024 + k];
    sil[i] = c * sigmoidf_(c);
  }
  __syncthreads();
  const int kq = tid >> 6, cl = tid & 63;
  const float* w = p.in[9] + (long)l * 1024 * 6144 + cgp * 64 + cl;
  float a0 = 0.f, a1 = 0.f, a2 = 0.f;
#pragma unroll 16
  for (int k = kq * 256; k < kq * 256 + 256; ++k) {
    float wv = w[(long)k * 6144];
    a0 += sil[k] * wv; a1 += sil[1024 + k] * wv; a2 += sil[2048 + k] * wv;
  }
  red[(kq * 3 + 0) * 64 + cl] = a0; red[(kq * 3 + 1) * 64 + cl] = a1; red[(kq * 3 + 2) * 64 + cl] = a2;
  __syncthreads();
  if (tid < 192) {
    int v = tid >> 6;
    float s = red[(0 * 3 + v) * 64 + cl] + red[(1 * 3 + v) * 64 + cl] + red[(2 * 3 + v) * 64 + cl] + red[(3 * 3 + v) * 64 + cl];
    s += p.in[10][l * 6144 + cgp * 64 + cl];
    ((float*)(p.ws + WS_MOD))[(l * 3 + v) * 6144 + cgp * 64 + cl] = s;
  }
}

__device__ __forceinline__ void cachecvt_job(const P& p, int job) {
  const float* src; u16* dst; int j;
  if (job < 512) { src = p.in[3]; dst = (u16*)(p.ws + WS_CNK); j = job; }
  else if (job < 1024) { src = p.in[4]; dst = (u16*)(p.ws + WS_CNV); j = job - 512; }
  else if (job < 2048) { src = p.in[6]; dst = (u16*)(p.ws + WS_CDK); j = job - 1024; }
  else { src = p.in[7]; dst = (u16*)(p.ws + WS_CDV); j = job - 2048; }
  long off = (long)j * 2048 + otid() * 8;
  float4 a = *(const float4*)(src + off), b = *(const float4*)(src + off + 4);
  uint4 v; v.x = pack2(a.x, a.y); v.y = pack2(a.z, a.w); v.z = pack2(b.x, b.y); v.w = pack2(b.z, b.w);
  *(uint4*)(dst + off) = v;
}


__device__ __forceinline__ void loracvt_job(const P& p, int job) {
  u16* dst = (u16*)(p.ws + WS_WT);
#pragma unroll
  for (int i = 0; i < 8; ++i) {
    const int g = job * 2048 + i * 256 + otid();
    const int k = g & 63, n = (g >> 6) & 511, mat = (g >> 15) & 1, ed = g >> 16;
    const float* src = mat ? p.in[21] : p.in[19];
    dst[g] = f2bf(src[((long)ed * 64 + k) * 512 + n]);
  }
}

__device__ __forceinline__ void xcopy_job(const P& p, int job) {
  const int row = job * 4 + (otid() >> 6), lane = otid() & 63;
  const float* src = (row < NCTX) ? p.in[0] + (long)row * 1024 : p.in[1] + (long)(row - NCTX) * 1024;
  float* dst = p.out + (long)row * 1024;
  float ss = 0.f;
#pragma unroll
  for (int i = 0; i < 4; ++i) {
    float4 v = *(const float4*)(src + (i * 64 + lane) * 4);
    ss += v.x * v.x + v.y * v.y + v.z * v.z + v.w * v.w;
    *(float4*)(dst + (i * 64 + lane) * 4) = v;
  }
}

template <int AM, int EPI, int BM>
__device__ __forceinline__ void gemm_phase(const P& p, char* smem, const void* Aptr, int K, const u16* Bt, int N,
                           const float* gvec, const float* modl, int shift_idx, int gate_idx, int sub, u16* dst) {
  const int tid = otid(), lane = tid & 63, wave = tid >> 6, wm = wave >> 1, wn = wave & 1;
  const int quad = lane >> 4, l16 = lane & 15;
  u16* As = (u16*)smem;
  u16* Bs = As + BM * 80;
  constexpr int MI = BM / 32;
  const int NT = N >> 7, ntiles = (16384 / BM) * NT, ntk = K >> 6;
  float* X = p.out;
  const float* rowss = (const float*)(p.ws + WS_ROWSS);
  const int MPX = (16384 / BM) / 8, LB = gridDim.x >> 3, xcd = blockIdx.x & 7;
  (void)ntiles;
  for (int lt = blockIdx.x >> 3; lt < MPX * NT; lt += LB) {
    const int mt = xcd * MPX + lt % MPX, nt = lt / MPX;
    const int row0 = mt * BM, col0 = nt * 128;
    const int grp = row0 < NCTX ? 0 : 1 + ((row0 - NCTX) >> 12);
    const float* modv = modl + grp * 6144;
    f32x4 acc[MI][4];
#pragma unroll
    for (int i = 0; i < MI; ++i)
#pragma unroll
      for (int j = 0; j < 4; ++j) acc[i][j] = (f32x4){0.f, 0.f, 0.f, 0.f};
    f32x4 ar[8]; u32x4 ab[MI]; u32x4 bb[4]; float rinv[8];
    if (AM == 1) {
#pragma unroll
      for (int i = 0; i < 8; ++i) {
        const float4* rp = (const float4*)(rowss + (long)(row0 + (tid >> 4) + 16 * i) * 16);
        float4 s0 = rp[0], s1 = rp[1], s2 = rp[2], s3 = rp[3];
        float s = (s0.x + s0.y + s0.z + s0.w) + (s1.x + s1.y + s1.z + s1.w) + (s2.x + s2.y + s2.z + s2.w) + (s3.x + s3.y + s3.z + s3.w);
        rinv[i] = rsqrtf(s * (1.f / 1024.f) + 1e-6f);
      }
    }
    if (AM == 1) {
#pragma unroll
      for (int i = 0; i < 8; ++i)
        ar[i] = *(const f32x4*)((const float*)Aptr + (long)(row0 + (tid >> 4) + 16 * i) * 1024 + (tid & 15) * 4);
    } else {
#pragma unroll
      for (int i = 0; i < MI; ++i)
        ab[i] = *(const u32x4*)((const u16*)Aptr + (long)(row0 + (tid >> 3) + 32 * i) * K + (tid & 7) * 8);
    }
#pragma unroll
    for (int i = 0; i < 4; ++i)
      bb[i] = *(const u32x4*)(Bt + (long)(col0 + (tid >> 3) + 32 * i) * K + (tid & 7) * 8);

    for (int kt = 0; kt < ntk; ++kt) {
      __syncthreads();
      if (AM == 1) {
        const int k = kt * 64 + (tid & 15) * 4;
        float4 g = *(const float4*)(gvec + k);
        float4 sc = *(const float4*)(modv + (shift_idx + 1) * 1024 + k);
        float4 sh = *(const float4*)(modv + shift_idx * 1024 + k);
        g.x *= (1.f + sc.x); g.y *= (1.f + sc.y); g.z *= (1.f + sc.z); g.w *= (1.f + sc.w);
#pragma unroll
        for (int i = 0; i < 8; ++i) {
          float r = rinv[i];
          u32x2 v;
          v.x = pack2(ar[i].x * r * g.x + sh.x, ar[i].y * r * g.y + sh.y);
          v.y = pack2(ar[i].z * r * g.z + sh.z, ar[i].w * r * g.w + sh.w);
          *(u32x2*)(As + ((tid >> 4) + 16 * i) * 80 + (tid & 15) * 4) = v;
        }
      } else {
#pragma unroll
        for (int i = 0; i < MI; ++i) *(u32x4*)(As + ((tid >> 3) + 32 * i) * 80 + (tid & 7) * 8) = ab[i];
      }
#pragma unroll
      for (int i = 0; i < 4; ++i) *(u32x4*)(Bs + ((tid >> 3) + 32 * i) * 80 + (tid & 7) * 8) = bb[i];
      __syncthreads();
      if (kt + 1 < ntk) {
        const int kn = (kt + 1) * 64;
        if (AM == 1) {
#pragma unroll
          for (int i = 0; i < 8; ++i)
            ar[i] = *(const f32x4*)((const float*)Aptr + (long)(row0 + (tid >> 4) + 16 * i) * 1024 + kn + (tid & 15) * 4);
        } else {
#pragma unroll
          for (int i = 0; i < MI; ++i)
            ab[i] = *(const u32x4*)((const u16*)Aptr + (long)(row0 + (tid >> 3) + 32 * i) * K + kn + (tid & 7) * 8);
        }
#pragma unroll
        for (int i = 0; i < 4; ++i)
          bb[i] = *(const u32x4*)(Bt + (long)(col0 + (tid >> 3) + 32 * i) * K + kn + (tid & 7) * 8);
      }
      __builtin_amdgcn_sched_barrier(0);
#pragma unroll
      for (int ks = 0; ks < 2; ++ks) {
        bf16x8 b[4];
#pragma unroll
        for (int i = 0; i < 4; ++i) b[i] = *(const bf16x8*)(Bs + (wn * 64 + i * 16 + l16) * 80 + ks * 32 + quad * 8);
#pragma unroll
        for (int i = 0; i < MI; ++i) {
          const bf16x8 a = *(const bf16x8*)(As + (wm * (BM / 2) + i * 16 + l16) * 80 + ks * 32 + quad * 8);
#pragma unroll
          for (int j = 0; j < 4; ++j) acc[i][j] = __builtin_amdgcn_mfma_f32_16x16x32_bf16(b[j], a, acc[i][j], 0, 0, 0);
        }
      }
    }
    const int cw = col0 + wn * 64;
    if (EPI == 0) {
      const int e = sub;
#pragma unroll
      for (int mi = 0; mi < MI; ++mi) {
        const int row = row0 + wm * (BM / 2) + mi * 16 + l16;
#pragma unroll
        for (int ni = 0; ni < 4; ++ni) {
          const int col = cw + ni * 16 + quad * 4;
          const f32x4 v = acc[mi][ni];
          u32x2 o; o.x = pack2(v[0], v[1]); o.y = pack2(v[2], v[3]);
          *(u32x2*)(dst + (long)row * 3328 + col) = o;
          if (row < NCTX && cw >= 512 && cw < 1536) {
            const int b = row >> 8, t = row & 255;
            if (cw < 1024) *(f32x4*)(p.out + OUT_NAK + ((long)((b * 2 + e) * 256 + t)) * 512 + col - 512) = v;
            else *(f32x4*)(p.out + OUT_NAV + ((long)((b * 2 + e) * 256 + t)) * 512 + col - 1024) = v;
          }
        }
      }
    } else if (EPI == 1) {
      const int o = sub;
      float inv[4];
#pragma unroll
      for (int j = 0; j < 4; ++j) inv[j] = exp2f(-(float)(quad * 4 + j) * (13.287712379549449f / 16.f));
#pragma unroll
      for (int mi = 0; mi < MI; ++mi) {
        const int row = row0 + wm * (BM / 2) + mi * 16 + l16;
        f32x4 v0 = acc[mi][0], v1 = acc[mi][1], v2 = acc[mi][2], v3 = acc[mi][3];
        if (row >= NCTX && cw < 2048) {
          const int tp = (row - NCTX) & 4095;
#pragma unroll
          for (int j = 0; j < 4; ++j) {
            const float a0 = (float)(tp >> 6) * inv[j], a1 = (float)(tp & 63) * inv[j];
            const float c0 = __cosf(a0), s0 = __sinf(a0), c1 = __cosf(a1), s1 = __sinf(a1);
            const float n0 = v0[j] * c0 - v1[j] * s0, n1 = v0[j] * s0 + v1[j] * c0;
            const float n2 = v2[j] * c1 - v3[j] * s1, n3 = v2[j] * s1 + v3[j] * c1;
            v0[j] = n0; v1[j] = n1; v2[j] = n2; v3[j] = n3;
          }
        }
        f32x4 vv[4] = {v0, v1, v2, v3};
#pragma unroll
        for (int ni = 0; ni < 4; ++ni) {
          const int col = cw + ni * 16 + quad * 4;
          u32x2 ob; ob.x = pack2(vv[ni][0], vv[ni][1]); ob.y = pack2(vv[ni][2], vv[ni][3]);
          *(u32x2*)(dst + (long)row * 3072 + col) = ob;
          if (row < NCTX && cw >= 1024) {
            const int b = row >> 8, t = row & 255;
            if (cw < 2048) *(f32x4*)(p.out + OUT_DK + ((long)((b * 2 + o) * 256 + t)) * 1024 + col - 1024) = vv[ni];
            else *(f32x4*)(p.out + OUT_DV + ((long)((b * 2 + o) * 256 + t)) * 1024 + col - 2048) = vv[ni];
          }
        }
      }
    } else if (EPI == 2) {
      f32x4 gt[4];
#pragma unroll
      for (int ni = 0; ni < 4; ++ni) gt[ni] = *(const f32x4*)(modv + gate_idx * 1024 + cw + ni * 16 + quad * 4);
#pragma unroll
      for (int mi = 0; mi < MI; ++mi) {
        const int row = row0 + wm * (BM / 2) + mi * 16 + l16;
#pragma unroll
        for (int ni = 0; ni < 4; ++ni) {
          f32x4* xp = (f32x4*)(X + (long)row * 1024 + cw + ni * 16 + quad * 4);
          *xp = *xp + gt[ni] * acc[mi][ni];
        }
      }
    } else {
#pragma unroll
      for (int mi = 0; mi < MI; ++mi) {
        const int row = row0 + wm * (BM / 2) + mi * 16 + l16;
#pragma unroll
        for (int ni = 0; ni < 2; ++ni) {
          const f32x4 a = acc[mi][ni], b = acc[mi][ni + 2];
          u32x2 ob;
          ob.x = pack2(a[0] * sigmoidf_(a[0]) * b[0], a[1] * sigmoidf_(a[1]) * b[1]);
          ob.y = pack2(a[2] * sigmoidf_(a[2]) * b[2], a[3] * sigmoidf_(a[3]) * b[3]);
          *(u32x2*)(dst + (long)row * 2816 + (cw >> 1) + ni * 16 + quad * 4) = ob;
        }
      }
    }
  }
}

__device__ __forceinline__ unsigned cvt_pk_bf16(float lo, float hi) { return pack2(lo, hi); }
typedef __attribute__((ext_vector_type(2))) unsigned u32pair_t;
__device__ __forceinline__ float xq_max(float v) {
  const unsigned x = __float_as_uint(v);
  const u32pair_t r = __builtin_amdgcn_permlane16_swap(x, x, false, false);
  const float m = fmaxf(__uint_as_float(r.x), __uint_as_float(r.y));
  const unsigned y = __float_as_uint(m);
  const u32pair_t q = __builtin_amdgcn_permlane32_swap(y, y, false, false);
  return fmaxf(__uint_as_float(q.x), __uint_as_float(q.y));
}
__device__ __forceinline__ float xq_sum(float v) {
  const unsigned x = __float_as_uint(v);
  const u32pair_t r = __builtin_amdgcn_permlane16_swap(x, x, false, false);
  const float m = __uint_as_float(r.x) + __uint_as_float(r.y);
  const unsigned y = __float_as_uint(m);
  const u32pair_t q = __builtin_amdgcn_permlane32_swap(y, y, false, false);
  return __uint_as_float(q.x) + __uint_as_float(q.y);
}
template <int NS, int DV, bool LOCAL>
__device__ __forceinline__ void attn_job(char* smem, const u16* qp, int qst,
                         const u16* k0, const u16* v0, int st0, int n0,
                         const u16* k1, const u16* v1, int st1, int n1,
                         const float* rpbh, int qi, int r0,
                         float lam, float outscale, const float* subln,
                         u16* op, int ost) {
  constexpr int KD = NS * 64, KST = KD + 16, KCH = KD / 8;
  u16* Ks = (u16*)smem;
  constexpr int VST = DV + 8, VCH = DV / 8;
  u16* Vs = Ks + 64 * KST;
  u16* Ps = Vs + 64 * VST;
  const int tid = otid(), lane = tid & 63, wave = tid >> 6, quad = lane >> 4, l16 = lane & 15;
  constexpr float C2 = 0.125f * 1.4426950408889634f;
  bf16x8 qf[NS][2];
#pragma unroll
  for (int s = 0; s < NS; ++s)
#pragma unroll
    for (int ks = 0; ks < 2; ++ks)
      qf[s][ks] = *(const bf16x8*)(qp + (long)(wave * 16 + l16) * qst + s * 64 + ks * 32 + quad * 8);
  float m[NS], l[NS];
  f32x4 O[NS][DV / 16];
#pragma unroll
  for (int s = 0; s < NS; ++s) {
    m[s] = -1e30f; l[s] = 0.f;
#pragma unroll
    for (int n = 0; n < DV / 16; ++n) O[s][n] = (f32x4){0.f, 0.f, 0.f, 0.f};
  }
  const int jq = wave * 16 + l16;
  int c0 = jq - 8; c0 = c0 < 0 ? 0 : (c0 > 48 ? 48 : c0);
  const int nt0 = n0 >> 6, ntot = nt0 + (n1 >> 6);
  constexpr int KPT = (64 * KCH) / 256;
  constexpr int VPT = (64 * VCH) / 256;
  u32x4 kreg[KPT];
  u32x4 vreg[VPT];
  auto load_tile = [&](int t) {
    const u16 *kp, *vp; int st;
    if (t < nt0) { kp = k0 + (long)t * 64 * st0; vp = v0 + (long)t * 64 * st0; st = st0; }
    else { kp = k1 + (long)(t - nt0) * 64 * st1; vp = v1 + (long)(t - nt0) * 64 * st1; st = st1; }
#pragma unroll
    for (int i = 0; i < KPT; ++i) {
      const int c = tid + 256 * i;
      kreg[i] = *(const u32x4*)(kp + (long)(c / KCH) * st + (c % KCH) * 8);
    }
#pragma unroll
    for (int i = 0; i < VPT; ++i) {
      const int c = tid + 256 * i;
      vreg[i] = *(const u32x4*)(vp + (long)(c / VCH) * st + (c % VCH) * 8);
    }
  };
  load_tile(0);
  for (int t = 0; t < ntot; ++t) {
    __syncthreads();
#pragma unroll
    for (int i = 0; i < KPT; ++i) {
      const int c = tid + 256 * i;
      *(u32x4*)(Ks + (c / KCH) * KST + (c % KCH) * 8) = kreg[i];
    }
#pragma unroll
    for (int i = 0; i < VPT; ++i) {
      const int c = tid + 256 * i;
      *(u32x4*)(Vs + (c / VCH) * VST + (c % VCH) * 8) = vreg[i];
    }
    __syncthreads();
    if (t + 1 < ntot) load_tile(t + 1);
    __builtin_amdgcn_sched_barrier(0);
#pragma unroll
    for (int s = 0; s < NS; ++s) {
      f32x4 sc[4];
#pragma unroll
      for (int n = 0; n < 4; ++n) {
        sc[n] = (f32x4){0.f, 0.f, 0.f, 0.f};
#pragma unroll
        for (int ks = 0; ks < 2; ++ks) {
          const bf16x8 kf = *(const bf16x8*)(Ks + (n * 16 + l16) * KST + s * 64 + ks * 32 + quad * 8);
          sc[n] = __builtin_amdgcn_mfma_f32_16x16x32_bf16(kf, qf[s][ks], sc[n], 0, 0, 0);
        }
      }
      float mx = -1e30f;
#pragma unroll
      for (int n = 0; n < 4; ++n)
#pragma unroll
        for (int j = 0; j < 4; ++j) {
          float v = sc[n][j] * C2;
          if (LOCAL) {
            if (t >= nt0) {
              const int kr = r0 + (t - nt0), kc = n * 16 + quad * 4 + j;
              const bool ok = (kc >= c0) && (kc < c0 + 16);
              const float bias = rpbh[ok ? ((kr - qi + 7) * 31 + (kc - jq + 15)) : 0];
              v = ok ? v + bias * 1.4426950408889634f : -1e30f;
            }
          }
          sc[n][j] = v;
          mx = fmaxf(mx, v);
        }
      mx = xq_max(mx);
      const float mn = fmaxf(m[s], mx);
      if (__builtin_amdgcn_ballot_w64(mn > m[s]) != 0ull) {
        const float corr = __builtin_amdgcn_exp2f(m[s] - mn);
        l[s] *= corr;
#pragma unroll
        for (int n = 0; n < DV / 16; ++n) O[s][n] *= corr;
        m[s] = mn;
      }
      float rs = 0.f;
#pragma unroll
      for (int n = 0; n < 4; ++n) {
        const float p0 = __builtin_amdgcn_exp2f(sc[n][0] - mn), p1 = __builtin_amdgcn_exp2f(sc[n][1] - mn);
        const float p2 = __builtin_amdgcn_exp2f(sc[n][2] - mn), p3 = __builtin_amdgcn_exp2f(sc[n][3] - mn);
        rs += (p0 + p1) + (p2 + p3);
        u32x2 pk; pk.x = cvt_pk_bf16(p0, p1); pk.y = cvt_pk_bf16(p2, p3);
        *(u32x2*)(Ps + ((wave * NS + s) * 16 + l16) * 80 + n * 16 + quad * 4) = pk;
      }
      l[s] += rs;
    }
    __builtin_amdgcn_wave_barrier();
    {
      bf16x8 pf[NS][2];
#pragma unroll
      for (int s = 0; s < NS; ++s)
#pragma unroll
        for (int ks = 0; ks < 2; ++ks)
          pf[s][ks] = *(const bf16x8*)(Ps + ((wave * NS + s) * 16 + l16) * 80 + ks * 32 + quad * 8);
#pragma unroll
      for (int ks = 0; ks < 2; ++ks)
#pragma unroll
        for (int n = 0; n < DV / 16; ++n) {
          const u16* va = Vs + (ks * 32 + quad * 8 + (l16 >> 2)) * VST + n * 16 + (l16 & 3) * 4;
          typedef __attribute__((ext_vector_type(4))) short s16x4_t;
          const s16x4_t v0 = __builtin_amdgcn_ds_read_tr16_b64_v4i16((__attribute__((address_space(3))) s16x4_t*)va);
          const s16x4_t v1 = __builtin_amdgcn_ds_read_tr16_b64_v4i16((__attribute__((address_space(3))) s16x4_t*)(va + 4 * VST));
          const bf16x8 vf = __builtin_shufflevector(v0, v1, 0, 1, 2, 3, 4, 5, 6, 7);
#pragma unroll
          for (int s = 0; s < NS; ++s) O[s][n] = __builtin_amdgcn_mfma_f32_16x16x32_bf16(vf, pf[s][ks], O[s][n], 0, 0, 0);
        }
    }
  }
  u16* orow = op + (long)(wave * 16 + l16) * ost + quad * 4;
  if (NS == 1) {
    const float il = 1.f / xq_sum(l[0]);
#pragma unroll
    for (int n = 0; n < DV / 16; ++n) {
      u32x2 o; o.x = cvt_pk_bf16(O[0][n][0] * il, O[0][n][1] * il); o.y = cvt_pk_bf16(O[0][n][2] * il, O[0][n][3] * il);
      *(u32x2*)(orow + n * 16) = o;
    }
  } else {
    const float i0 = 1.f / xq_sum(l[0]), i1 = lam / xq_sum(l[NS - 1]);
    float ss = 0.f;
#pragma unroll
    for (int n = 0; n < DV / 16; ++n) {
      O[0][n] = O[0][n] * i0 - O[NS - 1][n] * i1;
      ss += O[0][n][0] * O[0][n][0] + O[0][n][1] * O[0][n][1] + O[0][n][2] * O[0][n][2] + O[0][n][3] * O[0][n][3];
    }
    ss = xq_sum(ss);
    const float ri = rsqrtf(ss * (1.f / (float)DV) + 1e-6f) * outscale;
#pragma unroll
    for (int n = 0; n < DV / 16; ++n) {
      const f32x4 g = *(const f32x4*)(subln + n * 16 + quad * 4);
      u32x2 o; o.x = cvt_pk_bf16(O[0][n][0] * ri * g[0], O[0][n][1] * ri * g[1]); o.y = cvt_pk_bf16(O[0][n][2] * ri * g[2], O[0][n][3] * ri * g[3]);
      *(u32x2*)(orow + n * 16) = o;
    }
  }
}

__device__ __forceinline__ float* yl_ptr(const P& p, int tok, int d, int col) {
  const int slab = tok >> 8;
  return p.out + OUT_DK + (long)(slab >> 5) * 16777216L + ((long)(((slab & 31) * 2 + 1) * 256 + (tok & 255))) * 1024 + d * 512 + col;
}
__device__ __forceinline__ float* tb_ptr(const P& p, int unit, int d, int isB) {
  return (float*)(p.ws + WS_TB) + ((long)((unit * 2 + d) * 2 + isB)) * 4096;
}
__device__ __forceinline__ float ushift(const u16* proj, const float* mu, int tok, int seq0, int slen, int c) {
  const u16* pp = proj + (long)tok * 3328 + 1536 + c;
  const bool hp = tok > seq0, hn = tok < seq0 + slen - 1;
  const float cur = bf2f(pp[0]);
  const float pv = bf2f(pp[hp ? -3328 : 0]);
  const float nv = bf2f(pp[hn ? 3328 : 0]);
  const float prev = hp ? pv : 0.f;
  const float next = hn ? nv : 0.f;
  return cur + mu[c] * (prev - cur) + mu[1792 + c] * (next - cur);
}

__device__ __forceinline__ void rwkv_scan_unit(const P& p, char* smem, int e, int unit) {
  const int gch = unit >> 3, h = unit & 7;
  int seq0, slen;
  if (gch < 64) { seq0 = (gch >> 1) * 256; slen = 256; } else { seq0 = NCTX + ((gch - 64) >> 5) * 4096; slen = 4096; }
  const int t0 = gch * 128;
  float* sc = (float*)smem;
  const u16* proj = (const u16*)(p.ws + WS_BIG);
  const float* mu = p.in[17] + e * 2 * 1792;
  const float* w0 = p.in[18] + e * 1024;
  const float* w2 = p.in[19] + (long)e * 2 * 64 * 512;
  const float* a0 = p.in[20] + e * 1024;
  const float* a2 = p.in[21] + (long)e * 2 * 64 * 512;
  const float* kkw = p.in[22] + e * 512;
  const float* kaw = p.in[23] + e * 512;
  const float* bonus = p.in[24] + e * 1024;
  float* rkb = (float*)(p.ws + WS_RKB);
  float* qt = (float*)(p.ws + WS_QT);
  const int tid = otid(), lane = tid & 63, wave = tid >> 6;
  const int sd = wave >> 1; const bool isB = (wave & 1) != 0;
  const int pd = tid >> 7, th = (tid >> 6) & 1;
  float S[64];
#pragma unroll
  for (int j = 0; j < 64; ++j) S[j] = (!isB && j == lane) ? 1.f : 0.f;
  const int hc = h * 64 + lane;
  const float kkwj = kkw[hc], kawj = kaw[hc], bonj = bonus[pd * 512 + hc], w0j = w0[pd * 512 + hc], a0j = a0[pd * 512 + hc];

  u16* raw = (u16*)(smem + 49152);
  u32x4 rg[3];
  auto load_raw = [&](int lo) {
#pragma unroll
    for (int i = 0; i < 3; ++i) {
      const int c = tid + 256 * i;
      u32x4 v = (u32x4){0u, 0u, 0u, 0u};
      if (c < 720) {
        const int row = c / 40, cc = c % 40, vec = cc >> 3, ch = cc & 7;
        const int tok = lo + row;
        const int voff = (vec < 3) ? (vec * 512 + h * 64) : (1536 + (vec - 3) * 64);
        const int tokc = tok < seq0 ? seq0 : (tok > seq0 + slen - 1 ? seq0 + slen - 1 : tok);
        const u32x4 ld = *(const u32x4*)(proj + (long)tokc * 3328 + 1536 + voff + ch * 8);
        const bool inb = (tok >= seq0) && (tok < seq0 + slen);
        v.x = inb ? ld.x : 0u; v.y = inb ? ld.y : 0u; v.z = inb ? ld.z : 0u; v.w = inb ? ld.w : 0u;
      }
      rg[i] = v;
    }
  };
  auto store_raw = [&]() {
#pragma unroll
    for (int i = 0; i < 3; ++i) {
      const int c = tid + 256 * i;
      if (c < 720) {
        const int row = c / 40, cc = c % 40;
        *(u32x4*)(raw + row * 320 + cc * 8) = rg[i];
      }
    }
  };
  auto shift_dir = [&](int d) {
    float mu0v[5], mu1v[5];
#pragma unroll
    for (int v = 0; v < 5; ++v) {
      const int c = (v < 3) ? (v * 512 + h * 64 + lane) : (1536 + (v - 3) * 64 + lane);
      mu0v[v] = mu[c]; mu1v[v] = mu[1792 + c];
    }
#pragma unroll
    for (int vec = 0; vec < 5; ++vec)
#pragma unroll
      for (int k = 0; k < 4; ++k) {
        const int pslot = wave + 4 * k;
        const int row = (d == 0) ? pslot + 1 : 16 - pslot;
        const u16* rp = raw + row * 320 + vec * 64 + lane;
        const float cur = bf2f(rp[0]), prev = bf2f(rp[-320]), next = bf2f(rp[320]);
        float val = cur + mu0v[vec] * (prev - cur) + mu1v[vec] * (next - cur);
        if (vec == 3) { const float ex = __expf(2.f * val); val = 1.f - 2.f * __builtin_amdgcn_rcpf(ex + 1.f); }
        if (vec >= 3) ((u16*)(sc + (d * 6 + 5) * 1024))[(vec - 3) * 1024 + pslot * 64 + lane] = f2bf(val);
        else sc[((d * 6 + vec) * 16 + pslot) * 64 + lane] = val;
      }
  };
  for (int sub = 0; sub < 8; ++sub) {
    load_raw(t0 + sub * 16 - 1);
    __syncthreads();
    store_raw();
    load_raw(t0 + 127 - sub * 16 - 16);
    __syncthreads();
    shift_dir(0);
    __syncthreads();
    store_raw();
    __syncthreads();
    shift_dir(1);
    __syncthreads();
    {
      const int t2 = otid(), quad = (t2 >> 4) & 3, l16 = t2 & 15, w2i = t2 >> 6, sd2 = w2i >> 1, mat = w2i & 1;
      const u16* at = (const u16*)(sc + (sd2 * 6 + 5) * 1024) + mat * 1024;
      const u16* wt = (const u16*)(p.ws + WS_WT) + ((long)((e * 2 + sd2) * 2 + mat) * 512 + h * 64) * 64;
      bf16x8 af[2];
#pragma unroll
      for (int ks = 0; ks < 2; ++ks) af[ks] = *(const bf16x8*)(at + l16 * 64 + ks * 32 + quad * 8);
#pragma unroll
      for (int nt = 0; nt < 4; ++nt) {
        f32x4 dacc = (f32x4){0.f, 0.f, 0.f, 0.f};
#pragma unroll
        for (int ks = 0; ks < 2; ++ks) {
          const bf16x8 bfr = *(const bf16x8*)(wt + (nt * 16 + l16) * 64 + ks * 32 + quad * 8);
          dacc = __builtin_amdgcn_mfma_f32_16x16x32_bf16(af[ks], bfr, dacc, 0, 0, 0);
        }
#pragma unroll
        for (int j = 0; j < 4; ++j) sc[((sd2 * 6 + 3 + mat) * 16 + quad * 4 + j) * 64 + nt * 16 + l16] = dacc[j];
      }
    }
    __syncthreads();
    {
      float* scw = sc + pd * 6 * 1024;
#pragma unroll
      for (int tk = 0; tk < 8; ++tk) {
        const int pslot = th * 8 + tk;
        const int tok = (pd == 0) ? (t0 + sub * 16 + pslot) : (t0 + 127 - sub * 16 - pslot);
        const float kv = scw[(1 * 16 + pslot) * 64 + lane];
        const float rv = scw[(0 * 16 + pslot) * 64 + lane];
        float kkv = kv * kkwj;
        const float nrm = wave_sum(kkv * kkv);
        kkv *= rsqrtf(fmaxf(nrm, 1e-12f));
        const float xw = -(w0j + scw[(3 * 16 + pslot) * 64 + lane]);
        const float sp = fmaxf(xw, 0.f) + __logf(1.f + __expf(-fabsf(xw)));
        const float decay = __expf(-__expf(-sp - 0.5f));
        const float a = sigmoidf_(a0j + scw[(4 * 16 + pslot) * 64 + lane]);
        const float kt = kv * (1.f + (a - 1.f) * kawj);
        const float bsum = wave_sum(rv * kt * bonj);
        scw[(5 * 16 + pslot) * 64 + lane] = kkv;
        scw[(3 * 16 + pslot) * 64 + lane] = decay;
        scw[(4 * 16 + pslot) * 64 + lane] = kkv * a;
        scw[(1 * 16 + pslot) * 64 + lane] = kt;
        if (lane == 0) rkb[tok * 16 + pd * 8 + h] = bsum;
      }
    }
    __syncthreads();
    if (isB || gch >= 64 || ((gch & 1) == (sd == 0 ? 1 : 0))) {
      const float* base = sc + sd * 6 * 1024;
      for (int ps = 0; ps < 16; ++ps) {
        const f32x4* kk4 = (const f32x4*)(base + (5 * 16 + ps) * 64);
        const f32x4* w4 = (const f32x4*)(base + (3 * 16 + ps) * 64);
        const f32x4* ka4 = (const f32x4*)(base + (4 * 16 + ps) * 64);
        const f32x4* kt4 = (const f32x4*)(base + (1 * 16 + ps) * 64);
        const f32x4* r4 = (const f32x4*)(base + (0 * 16 + ps) * 64);
        f32x4 kk[16];
#pragma unroll
        for (int q = 0; q < 16; ++q) kk[q] = kk4[q];
        f32x4 bw[2][2], bka[2][2], bkt[2][2], br[2][2];
#pragma unroll
        for (int q = 0; q < 2; ++q) { bw[0][q] = w4[q]; bka[0][q] = ka4[q]; br[0][q] = r4[q]; bkt[0][q] = kt4[q]; }
        const float vv = isB ? base[(2 * 16 + ps) * 64 + lane] : 0.f;
        __builtin_amdgcn_sched_barrier(0);
        float s0 = 0.f, s1 = 0.f;
#pragma unroll
        for (int q = 0; q < 16; ++q) {
          s0 += S[q * 4 + 0] * kk[q].x; s1 += S[q * 4 + 1] * kk[q].y; s0 += S[q * 4 + 2] * kk[q].z; s1 += S[q * 4 + 3] * kk[q].w;
        }
        const float nskk = -(s0 + s1);
        float y0 = 0.f, y1 = 0.f;
#pragma unroll
        for (int qq = 0; qq < 8; ++qq) {
          const int cb = qq & 1, nbf = cb ^ 1;
          if (qq < 7) {
#pragma unroll
            for (int q = 0; q < 2; ++q) {
              bw[nbf][q] = w4[(qq + 1) * 2 + q]; bka[nbf][q] = ka4[(qq + 1) * 2 + q];
              br[nbf][q] = r4[(qq + 1) * 2 + q]; bkt[nbf][q] = kt4[(qq + 1) * 2 + q];
            }
          }
          __builtin_amdgcn_sched_barrier(0);
#pragma unroll
          for (int q = 0; q < 2; ++q) {
            const int j = (qq * 2 + q) * 4;
            const f32x4 w = bw[cb][q], ka = bka[cb][q], kt = bkt[cb][q], r = br[cb][q];
            S[j + 0] = fmaf(vv, kt.x, fmaf(nskk, ka.x, S[j + 0] * w.x));
            S[j + 1] = fmaf(vv, kt.y, fmaf(nskk, ka.y, S[j + 1] * w.y));
            S[j + 2] = fmaf(vv, kt.z, fmaf(nskk, ka.z, S[j + 2] * w.z));
            S[j + 3] = fmaf(vv, kt.w, fmaf(nskk, ka.w, S[j + 3] * w.w));
            y0 += S[j + 0] * r.x; y1 += S[j + 1] * r.y; y0 += S[j + 2] * r.z; y1 += S[j + 3] * r.w;
          }
        }
        const int tok = (sd == 0) ? (t0 + sub * 16 + ps) : (t0 + 127 - sub * 16 - ps);
        const float y = y0 + y1;
        if (isB) *yl_ptr(p, tok, sd, hc) = y;
        else qt[((long)tok * 2 + sd) * 512 + hc] = y;
      }
    }
  }
  float4* tp = (float4*)(tb_ptr(p, unit, sd, isB ? 1 : 0) + lane * 64);
#pragma unroll
  for (int q = 0; q < 16; ++q) tp[q] = make_float4(S[q * 4], S[q * 4 + 1], S[q * 4 + 2], S[q * 4 + 3]);
}

__device__ __forceinline__ void rwkv_e3_job(const P& p, char* smem, int e, int job) {
  float* Ss = (float*)smem;
  const int tid = otid(), r = tid >> 4, cgp = tid & 15;
  __syncthreads();
  if (job < 2048) {
    const int chain = job >> 2, rg = job & 3, row = rg * 16 + r;
    const int seq = chain >> 4, h = (chain >> 1) & 7, d = chain & 1;
    const int first = seq * 2 + (d == 0 ? 0 : 1), second = seq * 2 + (d == 0 ? 1 : 0);
    const float* Bf = tb_ptr(p, first * 8 + h, d, 1);
    const float* Ts = tb_ptr(p, second * 8 + h, d, 0);
    const float* Bs = tb_ptr(p, second * 8 + h, d, 1);
    *(float4*)(Ss + r * 64 + cgp * 4) = *(const float4*)(Bf + row * 64 + cgp * 4);
    __syncthreads();
    float4 acc = *(const float4*)(Bs + row * 64 + cgp * 4);
#pragma unroll 8
    for (int i = 0; i < 64; ++i) {
      const float s = Ss[r * 64 + i];
      const float4 t = *(const float4*)(Ts + i * 64 + cgp * 4);
      acc.x += s * t.x; acc.y += s * t.y; acc.z += s * t.z; acc.w += s * t.w;
    }
    *(float4*)(p.out + OUT_ST + ((long)(((seq * 2 + e) * 2 + d) * 8 + h)) * 4096 + row * 64 + cgp * 4) = acc;
  } else {
    const int j2 = job - 2048;
    const int chain = j2 >> 2, rg = j2 & 3, row = rg * 16 + r;
    const int b = chain >> 4, h = (chain >> 1) & 7, d = chain & 1;
    float* Tb = (float*)smem + 1024;
    const float* s0 = p.in[5] + ((long)(((b * 2 + e) * 2 + d) * 8 + h)) * 4096;
    *(float4*)(Ss + r * 64 + cgp * 4) = *(const float4*)(s0 + row * 64 + cgp * 4);
    f32x4 tn[4], bn;
    float* Bcur;
    {
      const int gch = 64 + b * 32 + ((d == 0) ? 0 : 31);
      const float* Tc = tb_ptr(p, gch * 8 + h, d, 0);
      Bcur = tb_ptr(p, gch * 8 + h, d, 1);
#pragma unroll
      for (int q = 0; q < 4; ++q) tn[q] = *(const f32x4*)(Tc + (tid + 256 * q) * 4);
      bn = *(const f32x4*)(Bcur + row * 64 + cgp * 4);
    }
    for (int step = 0; step < 31; ++step) {
      float* Tcur = Tb + (step & 1) * 4096;
#pragma unroll
      for (int q = 0; q < 4; ++q) *(f32x4*)(Tcur + (tid + 256 * q) * 4) = tn[q];
      f32x4 acc = bn;
      float* Bst = Bcur;
      __syncthreads();
      if (step + 1 < 31) {
        const int c = (d == 0) ? step + 1 : 30 - step;
        const int gch = 64 + b * 32 + c;
        const float* Tc = tb_ptr(p, gch * 8 + h, d, 0);
        Bcur = tb_ptr(p, gch * 8 + h, d, 1);
#pragma unroll
        for (int q = 0; q < 4; ++q) tn[q] = *(const f32x4*)(Tc + (tid + 256 * q) * 4);
        bn = *(const f32x4*)(Bcur + row * 64 + cgp * 4);
      }
#pragma unroll 16
      for (int i = 0; i < 64; ++i) {
        const float sv = Ss[r * 64 + i];
        const f32x4 t = *(const f32x4*)(Tcur + i * 64 + cgp * 4);
        acc += sv * t;
      }
      __syncthreads();
      *(f32x4*)(Ss + r * 64 + cgp * 4) = acc;
      *(f32x4*)(Bst + row * 64 + cgp * 4) = acc;
    }
  }
}

__device__ __forceinline__ void rwkv_e4_unit(const P& p, char* smem, int e, int unit) {
  const int gch = unit >> 3, h = unit & 7;
  int seq0, slen, cidx, nch;
  if (gch < 64) { seq0 = (gch >> 1) * 256; slen = 256; cidx = gch & 1; nch = 2; }
  else { seq0 = NCTX + ((gch - 64) >> 5) * 4096; slen = 4096; cidx = (gch - 64) & 31; nch = 32; }
  const int tid = otid(), lane = tid & 63, wave = tid >> 6;
  float* qbuf = (float*)smem + wave * 1024;
  float* dout = qbuf;
  u16* G2T = (u16*)(smem + 16384);
  u16* SGw = (u16*)(smem + 34816) + wave * 16 * 144;
  const u16* proj = (const u16*)(p.ws + WS_BIG);
  const float* mu = p.in[17] + e * 2 * 1792;
  const float* g2 = p.in[25] + (long)e * 128 * 512;
  const float* rkb = (const float*)(p.ws + WS_RKB);
  const float* qt = (const float*)(p.ws + WS_QT);
  u16* mix = (u16*)(p.ws + WS_MIX);
  const int hc = h * 64 + lane;
  const int quad = lane >> 4, l16 = lane & 15;
  __syncthreads();
#pragma unroll 8
  for (int idx = tid; idx < 8192; idx += 256) G2T[(idx & 63) * 144 + (idx >> 6)] = f2bf(g2[(long)(idx >> 6) * 512 + h * 64 + (idx & 63)]);
  __syncthreads();
  const float lnw = p.in[26][e * 512 + hc], lnb = p.in[27][e * 512 + hc];
  const int cg0 = 1536 + 1664 + lane, cg1 = 1536 + 1728 + lane, cv = 1536 + 1024 + hc;
  const float m0g0 = mu[1664 + lane], m1g0 = mu[1792 + 1664 + lane];
  const float m0g1 = mu[1728 + lane], m1g1 = mu[1792 + 1728 + lane];
  const float m0v = mu[1024 + hc], m1v = mu[1792 + 1024 + hc];
  for (int hf = 0; hf < 2; ++hf) {
    const int tw0 = gch * 128 + wave * 32 + hf * 16;
    float yv[16];
#pragma unroll
    for (int tk = 0; tk < 16; ++tk) yv[tk] = *yl_ptr(p, tw0 + tk, 0, hc) + *yl_ptr(p, tw0 + tk, 1, hc);
    for (int d = 0; d < 2; ++d) {
      const int oi = (d == 0) ? cidx : nch - 1 - cidx;
      const float* Sp = nullptr;
      if (oi == 0) {
        if (gch >= 64) Sp = p.in[5] + ((long)(((((gch - 64) >> 5) * 2 + e) * 2 + d) * 8 + h)) * 4096;
      } else {
        const int gp = (d == 0) ? gch - 1 : gch + 1;
        Sp = tb_ptr(p, gp * 8 + h, d, 1);
      }
      if (Sp != nullptr) {
        float S[64];
#pragma unroll
        for (int q = 0; q < 16; ++q) {
          const f32x4 v = *(const f32x4*)(Sp + lane * 64 + q * 4);
          S[q * 4] = v[0]; S[q * 4 + 1] = v[1]; S[q * 4 + 2] = v[2]; S[q * 4 + 3] = v[3];
        }
        f32x4 qv[4];
#pragma unroll
        for (int i = 0; i < 4; ++i) {
          const int idx = lane + 64 * i, r = idx >> 4, c4 = idx & 15;
          qv[i] = *(const f32x4*)(qt + ((long)(tw0 + r) * 2 + d) * 512 + h * 64 + c4 * 4);
        }
        __builtin_amdgcn_wave_barrier();
#pragma unroll
        for (int i = 0; i < 4; ++i) *(f32x4*)(qbuf + (lane + 64 * i) * 4) = qv[i];
        __builtin_amdgcn_wave_barrier();
#pragma unroll
        for (int r = 0; r < 16; ++r) {
          float y0 = 0.f, y1 = 0.f;
#pragma unroll
          for (int q = 0; q < 16; ++q) {
            const f32x4 v = *(const f32x4*)(qbuf + r * 64 + q * 4);
            y0 += S[q * 4] * v[0]; y1 += S[q * 4 + 1] * v[1]; y0 += S[q * 4 + 2] * v[2]; y1 += S[q * 4 + 3] * v[3];
          }
          yv[r] += y0 + y1;
        }
        __builtin_amdgcn_wave_barrier();
      }
    }
    float rkl = 0.f;
    if (lane < 16) rkl = rkb[(tw0 + lane) * 16 + h] + rkb[(tw0 + lane) * 16 + 8 + h];
    auto ldrow = [&](int r, float& a, float& b, float& c) {
      const bool ok = (r >= seq0) && (r < seq0 + slen);
      const u16* rp = proj + (long)(ok ? r : tw0) * 3328;
      const float x = bf2f(rp[cg0]), y = bf2f(rp[cg1]), z = bf2f(rp[cv]);
      a = ok ? x : 0.f; b = ok ? y : 0.f; c = ok ? z : 0.f;
    };
    float pg0, pg1, pvv, cg0v, cg1v, cvv, ng0, ng1, nvv;
    ldrow(tw0 - 1, pg0, pg1, pvv);
    ldrow(tw0, cg0v, cg1v, cvv);
    ldrow(tw0 + 1, ng0, ng1, nvv);
    float vshv[16];
#pragma unroll
    for (int tk = 0; tk < 16; ++tk) {
      float fg0, fg1, fvv;
      ldrow(tw0 + tk + 2, fg0, fg1, fvv);
      const float gv0 = sigmoidf_(cg0v + m0g0 * (pg0 - cg0v) + m1g0 * (ng0 - cg0v));
      const float gv1 = sigmoidf_(cg1v + m0g1 * (pg1 - cg1v) + m1g1 * (ng1 - cg1v));
      vshv[tk] = cvv + m0v * (pvv - cvv) + m1v * (nvv - cvv);
      pg0 = cg0v; pg1 = cg1v; pvv = cvv; cg0v = ng0; cg1v = ng1; cvv = nvv; ng0 = fg0; ng1 = fg1; nvv = fvv;
      SGw[tk * 144 + lane] = f2bf(gv0);
      SGw[tk * 144 + 64 + lane] = f2bf(gv1);
    }
    __builtin_amdgcn_wave_barrier();
    {
      bf16x8 af[4];
#pragma unroll
      for (int ks = 0; ks < 4; ++ks) af[ks] = *(const bf16x8*)(SGw + l16 * 144 + ks * 32 + quad * 8);
#pragma unroll
      for (int nt = 0; nt < 4; ++nt) {
        f32x4 dacc = (f32x4){0.f, 0.f, 0.f, 0.f};
#pragma unroll
        for (int ks = 0; ks < 4; ++ks) {
          const bf16x8 bfr = *(const bf16x8*)(G2T + (nt * 16 + l16) * 144 + ks * 32 + quad * 8);
          dacc = __builtin_amdgcn_mfma_f32_16x16x32_bf16(af[ks], bfr, dacc, 0, 0, 0);
        }
#pragma unroll
        for (int j = 0; j < 4; ++j) dout[(quad * 4 + j) * 64 + nt * 16 + l16] = dacc[j];
      }
    }
    __builtin_amdgcn_wave_barrier();
#pragma unroll
    for (int tk = 0; tk < 16; ++tk) {
      const int tok = tw0 + tk;
      const float rk = __int_as_float(__builtin_amdgcn_readlane(__float_as_int(rkl), tk));
      const float gate = dout[tk * 64 + lane];
      const float y = yv[tk];
      const float mean = wave_sum(y) * (1.f / 64.f);
      const float dv = y - mean;
      const float var = wave_sum(dv * dv) * (1.f / 64.f);
      const float yn = dv * rsqrtf(var + 64e-5f) * lnw + lnb;
      mix[(long)tok * 1024 + 512 + hc] = f2bf((yn + rk * vshv[tk]) * gate);
    }
    __builtin_amdgcn_wave_barrier();
  }
}

#define XB_TMO      128
#define XB_XCNT(j)  (256  + 64 * (j))
#define XB_XSUB(j)  (1280 + 64 * (j))
#define XB_XGEN(j)  (2304 + 64 * (j))
#define XB_TOP      3328
#define XB_TOPGEN   3392
#define XCD_BAR_WORDS 3456
#define XB_SPIN_CAP (1u << 22)
#define LAS __attribute__((address_space(3)))
__device__ __forceinline__ unsigned xb_ld(unsigned* p)              { return __hip_atomic_load(p, __ATOMIC_RELAXED, __HIP_MEMORY_SCOPE_AGENT); }
__device__ __forceinline__ unsigned xb_add(unsigned* p, unsigned v) { return __hip_atomic_fetch_add(p, v, __ATOMIC_RELAXED, __HIP_MEMORY_SCOPE_AGENT); }
__device__ __forceinline__ unsigned xb_xcc_id() { return (unsigned)__builtin_amdgcn_s_getreg((3 << 11) | 20) & 0xFu; }
#define XB_SPIN(cond, bar) do { unsigned _sp = 0; while (cond) { __builtin_amdgcn_s_sleep(1); \
    if ((++_sp & 255u) == 0u) { if (xb_ld(&(bar)[XB_TMO])) break; if (_sp > XB_SPIN_CAP) { atomicAdd(&(bar)[XB_TMO], 1u); break; } } } } while (0)
struct XcdBarrier { unsigned* bar; unsigned x; volatile LAS unsigned* st; };
__device__ __forceinline__ XcdBarrier xcd_barrier_post(unsigned* bar, volatile LAS unsigned* st) {
  XcdBarrier b; b.bar = bar; b.x = xb_xcc_id(); b.st = st;
  if (threadIdx.x == 0) (void)xb_add(&bar[XB_XCNT(b.x)], 1u);
  return b;
}
__device__ __forceinline__ void xcd_barrier_complete(unsigned* bar, unsigned x, unsigned& nloc, unsigned& nx) {
  const unsigned G = gridDim.x * gridDim.y * gridDim.z;
  unsigned sum, cnt, mine, sp = 0u;
  for (;;) {
    sum = 0u; cnt = 0u; mine = 0u;
#pragma unroll
    for (unsigned j = 0; j < 16; ++j) { const unsigned c = xb_ld(&bar[XB_XCNT(j)]); sum += c; cnt += (c > 0u) ? 1u : 0u; mine = (j == x) ? c : mine; }
    if (sum == G) break;
    __builtin_amdgcn_s_sleep(1);
    if ((++sp & 255u) == 0u) { if (xb_ld(&bar[XB_TMO])) break; if (sp > XB_SPIN_CAP) { atomicAdd(&bar[XB_TMO], 1u); break; } }
  }
  nloc = mine > 0u ? mine : 1u; nx = cnt > 0u ? cnt : 1u;
}
__device__ __forceinline__ void xcd_barrier(const XcdBarrier& b0) {
  XcdBarrier b; b.bar = b0.bar; b.st = b0.st; b.x = (unsigned)__builtin_amdgcn_readfirstlane((int)xb_xcc_id());
  asm volatile("s_waitcnt vmcnt(0)" ::: "memory");
  __syncthreads();
  if (threadIdx.x == 0) {
    unsigned* bar = b.bar;
    __builtin_amdgcn_s_waitcnt(0);
    unsigned nloc = b.st[0], nx = b.st[1];
    if (nloc == 0u) { xcd_barrier_complete(bar, b.x, nloc, nx); b.st[0] = nloc; b.st[1] = nx; }
    const unsigned old = xb_add(&bar[XB_XSUB(b.x)], 1u);
    const unsigned gen = old / nloc;
    if (old + 1u == (gen + 1u) * nloc) {
      __builtin_amdgcn_fence(__ATOMIC_RELEASE, "agent");
      asm volatile("s_waitcnt vmcnt(0)" ::: "memory");
      const unsigned og = xb_add(&bar[XB_TOP], 1u);
      const unsigned tg = og / nx;
      if (og + 1u == (tg + 1u) * nx) xb_add(&bar[XB_TOPGEN], 1u);
      else XB_SPIN(xb_ld(&bar[XB_TOPGEN]) == tg, bar);
      __builtin_amdgcn_fence(__ATOMIC_ACQUIRE, "agent");
      xb_add(&bar[XB_XGEN(b.x)], 1u);
      asm volatile("s_waitcnt vmcnt(0)" ::: "memory");
    } else {
      XB_SPIN(xb_ld(&bar[XB_XGEN(b.x)]) == gen, bar);
      __builtin_amdgcn_fence(__ATOMIC_ACQUIRE, "agent");
      asm volatile("s_waitcnt vmcnt(0)" ::: "memory");
    }
  }
  __syncthreads();
}

__device__ __forceinline__ void norm_job(const P& p, int job, const float* gvec, const float* modl, int shift_idx) {
  const int t = otid();
  const int row = job * 4 + (t >> 6), lane = t & 63;
  const int grp = row < NCTX ? 0 : 1 + ((row - NCTX) >> 12);
  const float* modv = modl + grp * 6144;
  const float* x = p.out + (long)row * 1024;
  u16* H = (u16*)(p.ws + WS_MIX) + (long)row * 1024;
  float4 v[4];
  float ss = 0.f;
#pragma unroll
  for (int i = 0; i < 4; ++i) {
    v[i] = *(const float4*)(x + (i * 64 + lane) * 4);
    ss += v[i].x * v[i].x + v[i].y * v[i].y + v[i].z * v[i].z + v[i].w * v[i].w;
  }
  ss = wave_sum(ss);
  const float r = rsqrtf(ss * (1.f / 1024.f) + 1e-6f);
#pragma unroll
  for (int i = 0; i < 4; ++i) {
    const int k = (i * 64 + lane) * 4;
    const float4 g = *(const float4*)(gvec + k);
    const float4 sc = *(const float4*)(modv + (shift_idx + 1) * 1024 + k);
    const float4 sh = *(const float4*)(modv + shift_idx * 1024 + k);
    u32x2 o;
    o.x = pack2(v[i].x * r * g.x * (1.f + sc.x) + sh.x, v[i].y * r * g.y * (1.f + sc.y) + sh.y);
    o.y = pack2(v[i].z * r * g.z * (1.f + sc.z) + sh.z, v[i].w * r * g.w * (1.f + sc.w) + sh.w);
    *(u32x2*)(H + k) = o;
  }
}

__device__ __forceinline__ void final_job(const P& p, int job) {
  const int t = otid();
  const int row = job * 4 + (t >> 6), lane = t & 63;
  float* x = p.out + (long)row * 1024;
  float4 v[4];
  float ss = 0.f;
#pragma unroll
  for (int i = 0; i < 4; ++i) {
    v[i] = *(const float4*)(x + (i * 64 + lane) * 4);
    ss += v[i].x * v[i].x + v[i].y * v[i].y + v[i].z * v[i].z + v[i].w * v[i].w;
  }
  ss = wave_sum(ss);
  const float r = rsqrtf(ss * (1.f / 1024.f) + 1e-6f);
#pragma unroll
  for (int i = 0; i < 4; ++i) {
    const float4 g = *(const float4*)(p.in[13] + (i * 64 + lane) * 4);
    float4 o;
    o.x = v[i].x * r * g.x; o.y = v[i].y * r * g.y; o.z = v[i].z * r * g.z; o.w = v[i].w * r * g.w;
    *(float4*)(x + (i * 64 + lane) * 4) = o;
  }
}

#ifndef PHMASK
#define PHMASK 0xffff
#endif
#define PHON(k) (((PHMASK) >> (k)) & 1)
#ifndef DUPMASK
#define DUPMASK 0
#endif
#define NREP(k) ((((DUPMASK) >> (k)) & 1) ? 2 : 1)
__global__ void __launch_bounds__(256, 2) fwd_megakernel(P p) {
  cg::grid_group grid = cg::this_grid();
  __shared__ __attribute__((aligned(16))) char smem[SMEM_BYTES];
  __shared__ uint4 xb_words;
  if (threadIdx.x == 0) xb_words = make_uint4(0u, 0u, 0u, 0u);
  __syncthreads();
  XcdBarrier xb = xcd_barrier_post((unsigned*)(p.ws + WS_BAR), (volatile LAS unsigned*)&xb_words);
  const int nb = gridDim.x, bid0 = blockIdx.x;
  int bid = bid0;
  asm volatile("" : "+s"(bid));
  float* mod = (float*)(p.ws + WS_MOD);
  u16* big = (u16*)(p.ws + WS_BIG);
  u16* mix = (u16*)(p.ws + WS_MIX);

  for (int rep = 0; rep < NREP(0); ++rep)
  for (int job = bid; job < 384 + N_CONV_JOBS + 3072 + 4096 + 128; job += nb) {
    if (!PHON(0)) break;
    if (job >= 384 + N_CONV_JOBS + 3072 + 4096) loracvt_job(p, job - (384 + N_CONV_JOBS + 3072 + 4096));
    else if (job < 384) adaln_job(p, smem, job);
    else if (job < 384 + N_CONV_JOBS) conv_job(p, smem, job - 384);
    else if (job < 384 + N_CONV_JOBS + 3072) cachecvt_job(p, job - 384 - N_CONV_JOBS);
    else xcopy_job(p, job - 384 - N_CONV_JOBS - 3072);
  }
  if (p.ws == nullptr) grid.sync();
  xcd_barrier(xb);

  for (int l = 0; l < 4; ++l) {
    int bid = bid0;
    asm volatile("" : "+s"(bid));
    const float* modl = mod + l * 3 * 6144;
    const int sub = l >> 1;
    const bool even = (l & 1) == 0;
    for (int lj = bid >> 3; lj < 512; lj += (nb >> 3)) norm_job(p, (bid & 7) * 512 + lj, p.in[11] + l * 1024, modl, 0);
    xcd_barrier(xb);
    if (even) {
      if (PHON(1)) gemm_phase<0, 0, 256>(p, smem, mix, 1024, (const u16*)(p.ws + WS_WIN) + (long)sub * 3328 * 1024, 3328,
                                    nullptr, modl, 0, 0, sub, big);
    } else {
      if (PHON(7)) gemm_phase<0, 1, 128>(p, smem, mix, 1024, (const u16*)(p.ws + WS_WQKV) + (long)sub * 3072 * 1024, 3072,
                                    nullptr, modl, 0, 0, sub, big);
    }
    xcd_barrier(xb);
    if (even) {
      const int e = sub;
      for (int rep = 0; rep < NREP(2); ++rep)
      for (int job = bid; job < 3072; job += nb) {
        if (job < 1024) { if (PHON(2)) rwkv_scan_unit(p, smem, e, job); }
        else if (!PHON(3)) {}
        else if (job < 2048) {
          const int j = job - 1024;
          const int b = j >> 9, h = (j >> 6) & 7, qi = j & 63;
          int r0 = qi - 4; r0 = r0 < 0 ? 0 : (r0 > 56 ? 56 : r0);
          const long tq = NCTX + b * 4096 + qi * 64, tk = NCTX + b * 4096 + r0 * 64;
          attn_job<1, 64, true>(smem, big + tq * 3328 + h * 64, 3328,
                                (const u16*)(p.ws + WS_CNK) + (long)(b * 2 + e) * 512 * 512 + h * 64,
                                (const u16*)(p.ws + WS_CNV) + (long)(b * 2 + e) * 512 * 512 + h * 64, 512, 512,
                                big + tk * 3328 + 512 + h * 64, big + tk * 3328 + 1024 + h * 64, 3328, 512,
                                p.in[16] + (long)(e * 8 + h) * 15 * 31, qi, r0, 0.f, 0.f, nullptr,
                                mix + tq * 1024 + h * 64, 1024);
        } else {
          const int j = job - 2048;
          const int b = j >> 5, h = (j >> 2) & 7, qb = j & 3;
          const long tq = b * 256 + qb * 64, tk = b * 256;
          attn_job<1, 64, false>(smem, big + tq * 3328 + h * 64, 3328,
                                 big + tk * 3328 + 512 + h * 64, big + tk * 3328 + 1024 + h * 64, 3328, 256,
                                 nullptr, nullptr, 0, 0, nullptr, 0, 0, 0.f, 0.f, nullptr,
                                 mix + tq * 1024 + h * 64, 1024);
        }
      }
      xcd_barrier(xb);
      for (int ph = 0; ph < 2; ++ph) {
        if (ph == 0 && PHON(4)) {
          if (nb > 256) {
            if (bid < 128) rwkv_e3_job(p, smem, e, bid + 2048);
            else for (int job = bid - 128; job < 2048; job += nb - 128) rwkv_e3_job(p, smem, e, job);
          } else {
            for (int job = bid; job < 2176; job += nb) rwkv_e3_job(p, smem, e, job < 128 ? job + 2048 : job - 128);
          }
        }
        if (PHON(5))
          for (int u = bid; u < 512; u += nb) rwkv_e4_unit(p, smem, e, (ph == 0 ? 0 : 512) + u);
        if (ph == 0) xcd_barrier(xb);
      }
    } else {
      const int o = sub;
      const float lam_init = 0.8f - 0.6f * __expf(-0.3f * (float)l);
      float d0 = 0.f, d1 = 0.f;
      for (int i = 0; i < 64; ++i) {
        d0 += p.in[30][o * 128 + i] * p.in[31][o * 128 + i];
        d1 += p.in[30][o * 128 + 64 + i] * p.in[31][o * 128 + 64 + i];
      }
      const float lam = __expf(d0) - __expf(d1) + lam_init;
      for (int rep = 0; rep < NREP(8); ++rep)
      if (PHON(8)) for (int job = bid; job < 2048; job += nb) {
        long tq, tk; int h, n0, n1; const u16 *k0, *v0; int st0;
        if (job < 1024) {
          const int x = job & 7, lj = job >> 3;
          const int pair = x + 8 * (lj >> 6), qb = lj & 63;
          const int b = pair >> 3; h = pair & 7;
          tq = NCTX + b * 4096 + qb * 64; tk = NCTX + b * 4096;
          k0 = (const u16*)(p.ws + WS_CDK) + (long)(b * 2 + o) * 512 * 1024 + h * 128;
          v0 = (const u16*)(p.ws + WS_CDV) + (long)(b * 2 + o) * 512 * 1024 + h * 128;
          st0 = 1024; n0 = 512; n1 = 4096;
        } else {
          const int j = job - 1024;
          const int b = j >> 5, qb = j & 3; h = (j >> 2) & 7;
          tq = b * 256 + qb * 64; tk = b * 256;
          k0 = big + tk * 3072 + 1024 + h * 128; v0 = big + tk * 3072 + 2048 + h * 128;
          st0 = 3072; n0 = 256; n1 = 0;
        }
        attn_job<2, 128, false>(smem, big + tq * 3072 + h * 128, 3072, k0, v0, st0, n0,
                                big + tk * 3072 + 1024 + h * 128, big + tk * 3072 + 2048 + h * 128, 3072, n1,
                                nullptr, 0, 0, lam, 1.f - lam_init, p.in[32] + o * 128,
                                mix + tq * 1024 + h * 128, 1024);
      }
    }
    xcd_barrier(xb);
    for (int g = 0; g < 2; ++g) {
      if (g == 1) {
        for (int lj = bid >> 3; lj < 512; lj += (nb >> 3)) norm_job(p, (bid & 7) * 512 + lj, p.in[12] + l * 1024, modl, 3);
        xcd_barrier(xb);
        for (int rep = 0; rep < NREP(9); ++rep)
        if (PHON(9)) gemm_phase<0, 3, 256>(p, smem, mix, 1024, (const u16*)(p.ws + WS_W13) + (long)l * 5632 * 1024, 5632,
                                      nullptr, modl, 3, 0, 0, big);
        xcd_barrier(xb);
      }
      const u16* A2 = g == 0 ? mix : big;
      const int K2 = g == 0 ? 1024 : 2816;
      const u16* B2 = g == 0 ? (even ? (const u16*)(p.ws + WS_WOE) + (long)sub * 1024 * 1024 : (const u16*)(p.ws + WS_WOD) + (long)sub * 1024 * 1024)
                             : (const u16*)(p.ws + WS_W2) + (long)l * 1024 * 2816;
      if (PHON(6)) gemm_phase<0, 2, 256>(p, smem, A2, K2, B2, 1024, nullptr, modl, 0, g == 0 ? 2 : 5, 0, nullptr);
      xcd_barrier(xb);
    }
  }
  if (PHON(10)) for (int lj = bid >> 3; lj < 512; lj += (nb >> 3)) final_job(p, (bid & 7) * 512 + lj);
}

extern "C" void kernel_launch(void* const* d_in, const int* in_sizes, int n_in, void* d_out, int out_size,
                              void* d_ws, size_t ws_size, hipStream_t stream) {
  static int grid_blocks = 0;
  if (!grid_blocks) {
    int dev = 0, cus = 0, per_cu = 0;
    (void)hipGetDevice(&dev);
    (void)hipDeviceGetAttribute(&cus, hipDeviceAttributeMultiprocessorCount, dev);
    (void)hipOccupancyMaxActiveBlocksPerMultiprocessor(&per_cu, fwd_megakernel, 256, 0);
    (void)per_cu;
    grid_blocks = cus * 2;
  }
  if (ws_size < (size_t)WS_TOTAL) { fprintf(stderr, "workspace too small: %zu < %ld\n", ws_size, (long)WS_END); return; }
  P p{};
  for (int i = 0; i < 36; ++i) p.in[i] = (const float*)d_in[i];
  p.out = (float*)d_out;
  p.ws = (char*)d_ws;
  (void)hipMemsetAsync((char*)d_ws + WS_BAR, 0, XCD_BAR_WORDS * 4, stream);
  void* args[] = {&p};
  hipError_t e = hipLaunchCooperativeKernel((void*)fwd_megakernel, dim3(grid_blocks), dim3(256), args, 0, stream);
  if (e != hipSuccess) fprintf(stderr, "cooperative launch failed: %s (grid %d)\n", hipGetErrorString(e), grid_blocks);
}
```

```cpp
#include <hip/hip_runtime.h>
#include <hip/hip_cooperative_groups.h>
#include <cstdio>
namespace cg = cooperative_groups;

typedef unsigned short u16;
typedef __attribute__((ext_vector_type(8))) short bf16x8;
typedef __attribute__((ext_vector_type(4))) float f32x4;
typedef __attribute__((ext_vector_type(4))) unsigned u32x4;
typedef __attribute__((ext_vector_type(2))) unsigned u32x2;

#define NTOK 16384
#define NCTX 8192
#define OUT_NAK 16777216L
#define OUT_NAV 25165824L
#define OUT_ST  33554432L
#define OUT_DK  37748736L
#define OUT_DV  54525952L
#define WS_WIN   0L
#define WS_WOE   13631488L
#define WS_WQKV  17825792L
#define WS_WOD   30408704L
#define WS_W13   34603008L
#define WS_W2    80740352L
#define WS_CNK   103809024L
#define WS_CNV   105906176L
#define WS_CDK   108003328L
#define WS_CDV   112197632L
#define WS_MOD   116391936L
#define WS_ROWSS 116686848L
#define WS_RKB   117735424L
#define WS_MIX   118784000L
#define WS_BIG   152338432L
#define WS_TB    261390336L
#define WS_QT    328499200L
#define WS_END   395608064L
#define WS_BAR   395624448L
#define WS_WT    395640832L
#define WS_TOTAL 396165120L

struct P {
  const float* in[36];
  float* out;
  char* ws;
};

#define SMEM_BYTES 61440

typedef __attribute__((ext_vector_type(2))) float f32x2_t;
typedef __attribute__((ext_vector_type(2))) __bf16 bf16x2_t;
__device__ __forceinline__ u16 f2bf(float f) { return __builtin_bit_cast(u16, (__bf16)f); }
__device__ __forceinline__ float bf2f(u16 h) { return __uint_as_float(((unsigned)h) << 16); }
__device__ __forceinline__ unsigned pack2(float a, float b) {
  const f32x2_t v = {a, b};
  return __builtin_bit_cast(unsigned, __builtin_convertvector(v, bf16x2_t));
}
template <int CTRL>
__device__ __forceinline__ float dpp_mov(float v) {
  return __int_as_float(__builtin_amdgcn_update_dpp(0, __float_as_int(v), CTRL, 0xf, 0xf, false));
}
__device__ __forceinline__ float g16_sum(float v) {
  v += dpp_mov<0xB1>(v);
  v += dpp_mov<0x4E>(v);
  v += dpp_mov<0x124>(v);
  v += dpp_mov<0x128>(v);
  return v;
}
__device__ __forceinline__ float g16_max(float v) {
  v = fmaxf(v, dpp_mov<0xB1>(v));
  v = fmaxf(v, dpp_mov<0x4E>(v));
  v = fmaxf(v, dpp_mov<0x124>(v));
  v = fmaxf(v, dpp_mov<0x128>(v));
  return v;
}
__device__ __forceinline__ float wave_sum(float v) {
  v = g16_sum(v);
  const float r0 = __int_as_float(__builtin_amdgcn_readlane(__float_as_int(v), 0));
  const float r1 = __int_as_float(__builtin_amdgcn_readlane(__float_as_int(v), 16));
  const float r2 = __int_as_float(__builtin_amdgcn_readlane(__float_as_int(v), 32));
  const float r3 = __int_as_float(__builtin_amdgcn_readlane(__float_as_int(v), 48));
  return (r0 + r1) + (r2 + r3);
}
__device__ __forceinline__ int otid() { int t = threadIdx.x; asm volatile("" : "+v"(t)); return t; }
__device__ __forceinline__ float sigmoidf_(float x) { return __builtin_amdgcn_rcpf(1.f + __expf(-x)); }

struct ConvT { const float* src; u16* dst; int K, N, mode, kt, nt; };
__device__ __forceinline__ ConvT conv_params(const P& p, int job) {
  ConvT c;
  if (job < 1664) {
    int e = job / 832, r = job % 832;
    c.src = p.in[14] + (long)e * 1024 * 3328; c.K = 1024; c.N = 3328; c.dst = (u16*)(p.ws + WS_WIN) + (long)e * 3328 * 1024; c.mode = 0; c.kt = r / 52; c.nt = r % 52;
    return c;
  }
  job -= 1664;
  if (job < 512) {
    int e = job / 256, r = job % 256;
    c.src = p.in[15] + (long)e * 1024 * 1024; c.K = 1024; c.N = 1024; c.dst = (u16*)(p.ws + WS_WOE) + (long)e * 1024 * 1024; c.mode = 0; c.kt = r / 16; c.nt = r % 16;
    return c;
  }
  job -= 512;
  if (job < 1536) {
    int e = job / 768, r = job % 768;
    c.src = p.in[28] + (long)e * 1024 * 3072; c.K = 1024; c.N = 3072; c.dst = (u16*)(p.ws + WS_WQKV) + (long)e * 3072 * 1024; c.mode = 0; c.kt = r / 48; c.nt = r % 48;
    return c;
  }
  job -= 1536;
  if (job < 512) {
    int e = job / 256, r = job % 256;
    c.src = p.in[29] + (long)e * 1024 * 1024; c.K = 1024; c.N = 1024; c.dst = (u16*)(p.ws + WS_WOD) + (long)e * 1024 * 1024; c.mode = 0; c.kt = r / 16; c.nt = r % 16;
    return c;
  }
  job -= 512;
  if (job < 2816) {
    int l = job / 704, r = job % 704;
    c.src = p.in[33] + (long)l * 1024 * 2816; c.K = 1024; c.N = 2816; c.dst = (u16*)(p.ws + WS_W13) + (long)l * 5632 * 1024; c.mode = 1; c.kt = r / 44; c.nt = r % 44;
    return c;
  }
  job -= 2816;
  if (job < 2816) {
    int l = job / 704, r = job % 704;
    c.src = p.in[34] + (long)l * 1024 * 2816; c.K = 1024; c.N = 2816; c.dst = (u16*)(p.ws + WS_W13) + (long)l * 5632 * 1024; c.mode = 2; c.kt = r / 44; c.nt = r % 44;
    return c;
  }
  job -= 2816;
  {
    int l = job / 704, r = job % 704;
    c.src = p.in[35] + (long)l * 2816 * 1024; c.K = 2816; c.N = 1024; c.dst = (u16*)(p.ws + WS_W2) + (long)l * 1024 * 2816; c.mode = 0; c.kt = r / 16; c.nt = r % 16;
  }
  return c;
}
__device__ __forceinline__ void conv_job(const P& p, char* smem, int job2) {
  const int tid = otid();
  float* tile = (float*)smem;
  ConvT c[2];
  c[0] = conv_params(p, 2 * job2);
  c[1] = conv_params(p, 2 * job2 + 1);
  float v[2][16];
#pragma unroll
  for (int t = 0; t < 2; ++t)
#pragma unroll
    for (int i = 0; i < 16; ++i) {
      const int kl = (tid >> 6) + 4 * i, nl = tid & 63;
      v[t][i] = c[t].src[(long)(c[t].kt * 64 + kl) * c[t].N + c[t].nt * 64 + nl];
    }
  __syncthreads();
#pragma unroll
  for (int t = 0; t < 2; ++t)
#pragma unroll
    for (int i = 0; i < 16; ++i) {
      const int kl = (tid >> 6) + 4 * i, nl = tid & 63;
      tile[t * 4160 + kl * 65 + nl] = v[t][i];
    }
  __syncthreads();
#pragma unroll
  for (int t = 0; t < 2; ++t)
#pragma unroll
    for (int i = 0; i < 2; ++i) {
      const int task = tid + 256 * i;
      const int kg = task & 7, nl = task >> 3;
      const int n = c[t].nt * 64 + nl;
      int nd = n;
      if (c[t].mode == 1) nd = (n >> 5) * 64 + (n & 31);
      else if (c[t].mode == 2) nd = (n >> 5) * 64 + 32 + (n & 31);
      const float* tt = tile + t * 4160;
      u32x4 o;
      o.x = pack2(tt[(kg * 8 + 0) * 65 + nl], tt[(kg * 8 + 1) * 65 + nl]);
      o.y = pack2(tt[(kg * 8 + 2) * 65 + nl], tt[(kg * 8 + 3) * 65 + nl]);
      o.z = pack2(tt[(kg * 8 + 4) * 65 + nl], tt[(kg * 8 + 5) * 65 + nl]);
      o.w = pack2(tt[(kg * 8 + 6) * 65 + nl], tt[(kg * 8 + 7) * 65 + nl]);
      *(u32x4*)(c[t].dst + (long)nd * c[t].K + c[t].kt * 64 + kg * 8) = o;
    }
}
#define N_CONV_JOBS 6336

__device__ __forceinline__ void adaln_job(const P& p, char* smem, int job) {
  const int l = job / 96, cgp = job % 96;
  const int tid = otid();
  float* sil = (float*)smem;
  float* red = sil + 3072;
  __syncthreads();
  for (int i = tid; i < 3072; i += 256) {
    int v = i >> 10, k = i & 1023;
    float c = (v == 0) ? p.in[8][k] : p.in[2][(v - 1) * 1024 + k];
    sil[i] = c * sigmoidf_(c);
  }
  __syncthreads();
  const int kq = tid >> 6, cl = tid & 63;
  const float* w = p.in[9] + (long)l * 1024 * 6144 + cgp * 64 + cl;
  float a0 = 0.f, a1 = 0.f, a2 = 0.f;
#pragma unroll 16
  for (int k = kq * 256; k < kq * 256 + 256; ++k) {
    float wv = w[(long)k * 6144];
    a0 += sil[k] * wv; a1 += sil[1024 + k] * wv; a2 += sil[2048 + k] * wv;
  }
  red[(kq * 3 + 0) * 64 + cl] = a0; red[(kq * 3 + 1) * 64 + cl] = a1; red[(kq * 3 + 2) * 64 + cl] = a2;
  __syncthreads();
  if (tid < 192) {
    int v = tid >> 6;
    float s = red[(0 * 3 + v) * 64 + cl] + red[(1 * 3 + v) * 64 + cl] + red[(2 * 3 + v) * 64 + cl] + red[(3 * 3 + v) * 64 + cl];
    s += p.in[10][l * 6144 + cgp * 64 + cl];
    ((float*)(p.ws + WS_MOD))[(l * 3 + v) * 6144 + cgp * 64 + cl] = s;
  }
}

__device__ __forceinline__ void cachecvt_job(const P& p, int job) {
  const float* src; u16* dst; int j;
  if (job < 512) { src = p.in[3]; dst = (u16*)(p.ws + WS_CNK); j = job; }
  else if (job < 1024) { src = p.in[4]; dst = (u16*)(p.ws + WS_CNV); j = job - 512; }
  else if (job < 2048) { src = p.in[6]; dst = (u16*)(p.ws + WS_CDK); j = job - 1024; }
  else { src = p.in[7]; dst = (u16*)(p.ws + WS_CDV); j = job - 2048; }
  long off = (long)j * 2048 + otid() * 8;
  float4 a = *(const float4*)(src + off), b = *(const float4*)(src + off + 4);
  uint4 v; v.x = pack2(a.x, a.y); v.y = pack2(a.z, a.w); v.z = pack2(b.x, b.y); v.w = pack2(b.z, b.w);
  *(uint4*)(dst + off) = v;
}


__device__ __forceinline__ void loracvt_job(const P& p, int job) {
  u16* dst = (u16*)(p.ws + WS_WT);
#pragma unroll
  for (int i = 0; i < 8; ++i) {
    const int g = job * 2048 + i * 256 + otid();
    const int k = g & 63, n = (g >> 6) & 511, mat = (g >> 15) & 1, ed = g >> 16;
    const float* src = mat ? p.in[21] : p.in[19];
    dst[g] = f2bf(src[((long)ed * 64 + k) * 512 + n]);
  }
}

__device__ __forceinline__ void xcopy_job(const P& p, int job) {
  const int row = job * 4 + (otid() >> 6), lane = otid() & 63;
  const float* src = (row < NCTX) ? p.in[0] + (long)row * 1024 : p.in[1] + (long)(row - NCTX) * 1024;
  float* dst = p.out + (long)row * 1024;
  float ss = 0.f;
#pragma unroll
  for (int i = 0; i < 4; ++i) {
    float4 v = *(const float4*)(src + (i * 64 + lane) * 4);
    ss += v.x * v.x + v.y * v.y + v.z * v.z + v.w * v.w;
    *(float4*)(dst + (i * 64 + lane) * 4) = v;
  }
}

template <int AM, int EPI, int BM>
__device__ __forceinline__ void gemm_phase(const P& p, char* smem, const void* Aptr, int K, const u16* Bt, int N,
                           const float* gvec, const float* modl, int shift_idx, int gate_idx, int sub, u16* dst) {
  const int tid = otid(), lane = tid & 63, wave = tid >> 6, wm = wave >> 1, wn = wave & 1;
  const int quad = lane >> 4, l16 = lane & 15;
  u16* As = (u16*)smem;
  u16* Bs = As + BM * 80;
  constexpr int MI = BM / 32;
  const int NT = N >> 7, ntiles = (16384 / BM) * NT, ntk = K >> 6;
  float* X = p.out;
  const float* rowss = (const float*)(p.ws + WS_ROWSS);
  const int MPX = (16384 / BM) / 8, LB = gridDim.x >> 3, xcd = blockIdx.x & 7;
  (void)ntiles;
  for (int lt = blockIdx.x >> 3; lt < MPX * NT; lt += LB) {
    const int mt = xcd * MPX + lt % MPX, nt = lt / MPX;
    const int row0 = mt * BM, col0 = nt * 128;
    const int grp = row0 < NCTX ? 0 : 1 + ((row0 - NCTX) >> 12);
    const float* modv = modl + grp * 6144;
    f32x4 acc[MI][4];
#pragma unroll
    for (int i = 0; i < MI; ++i)
#pragma unroll
      for (int j = 0; j < 4; ++j) acc[i][j] = (f32x4){0.f, 0.f, 0.f, 0.f};
    f32x4 ar[8]; u32x4 ab[MI]; u32x4 bb[4]; float rinv[8];
    if (AM == 1) {
#pragma unroll
      for (int i = 0; i < 8; ++i) {
        const float4* rp = (const float4*)(rowss + (long)(row0 + (tid >> 4) + 16 * i) * 16);
        float4 s0 = rp[0], s1 = rp[1], s2 = rp[2], s3 = rp[3];
        float s = (s0.x + s0.y + s0.z + s0.w) + (s1.x + s1.y + s1.z + s1.w) + (s2.x + s2.y + s2.z + s2.w) + (s3.x + s3.y + s3.z + s3.w);
        rinv[i] = rsqrtf(s * (1.f / 1024.f) + 1e-6f);
      }
    }
    if (AM == 1) {
#pragma unroll
      for (int i = 0; i < 8; ++i)
        ar[i] = *(const f32x4*)((const float*)Aptr + (long)(row0 + (tid >> 4) + 16 * i) * 1024 + (tid & 15) * 4);
    } else {
#pragma unroll
      for (int i = 0; i < MI; ++i)
        ab[i] = *(const u32x4*)((const u16*)Aptr + (long)(row0 + (tid >> 3) + 32 * i) * K + (tid & 7) * 8);
    }
#pragma unroll
    for (int i = 0; i < 4; ++i)
      bb[i] = *(const u32x4*)(Bt + (long)(col0 + (tid >> 3) + 32 * i) * K + (tid & 7) * 8);

    for (int kt = 0; kt < ntk; ++kt) {
      __syncthreads();
      if (AM == 1) {
        const int k = kt * 64 + (tid & 15) * 4;
        float4 g = *(const float4*)(gvec + k);
        float4 sc = *(const float4*)(modv + (shift_idx + 1) * 1024 + k);
        float4 sh = *(const float4*)(modv + shift_idx * 1024 + k);
        g.x *= (1.f + sc.x); g.y *= (1.f + sc.y); g.z *= (1.f + sc.z); g.w *= (1.f + sc.w);
#pragma unroll
        for (int i = 0; i < 8; ++i) {
          float r = rinv[i];
          u32x2 v;
          v.x = pack2(ar[i].x * r * g.x + sh.x, ar[i].y * r * g.y + sh.y);
          v.y = pack2(ar[i].z * r * g.z + sh.z, ar[i].w * r * g.w + sh.w);
          *(u32x2*)(As + ((tid >> 4) + 16 * i) * 80 + (tid & 15) * 4) = v;
        }
      } else {
#pragma unroll
        for (int i = 0; i < MI; ++i) *(u32x4*)(As + ((tid >> 3) + 32 * i) * 80 + (tid & 7) * 8) = ab[i];
      }
#pragma unroll
      for (int i = 0; i < 4; ++i) *(u32x4*)(Bs + ((tid >> 3) + 32 * i) * 80 + (tid & 7) * 8) = bb[i];
      __syncthreads();
      if (kt + 1 < ntk) {
        const int kn = (kt + 1) * 64;
        if (AM == 1) {
#pragma unroll
          for (int i = 0; i < 8; ++i)
            ar[i] = *(const f32x4*)((const float*)Aptr + (long)(row0 + (tid >> 4) + 16 * i) * 1024 + kn + (tid & 15) * 4);
        } else {
#pragma unroll
          for (int i = 0; i < MI; ++i)
            ab[i] = *(const u32x4*)((const u16*)Aptr + (long)(row0 + (tid >> 3) + 32 * i) * K + kn + (tid & 7) * 8);
        }
#pragma unroll
        for (int i = 0; i < 4; ++i)
          bb[i] = *(const u32x4*)(Bt + (long)(col0 + (tid >> 3) + 32 * i) * K + kn + (tid & 7) * 8);
      }
      __builtin_amdgcn_sched_barrier(0);
#pragma unroll
      for (int ks = 0; ks < 2; ++ks) {
        bf16x8 b[4];
#pragma unroll
        for (int i = 0; i < 4; ++i) b[i] = *(const bf16x8*)(Bs + (wn * 64 + i * 16 + l16) * 80 + ks * 32 + quad * 8);
        bf16x8 af[3];
        af[0] = *(const bf16x8*)(As + (wm * (BM / 2) + 0 * 16 + l16) * 80 + ks * 32 + quad * 8);
        af[1] = *(const bf16x8*)(As + (wm * (BM / 2) + 1 * 16 + l16) * 80 + ks * 32 + quad * 8);
#pragma unroll
        for (int i = 0; i < MI; ++i) {
          if (i + 2 < MI) af[(i + 2) % 3] = *(const bf16x8*)(As + (wm * (BM / 2) + (i + 2) * 16 + l16) * 80 + ks * 32 + quad * 8);
#pragma unroll
          for (int j = 0; j < 4; ++j) acc[i][j] = __builtin_amdgcn_mfma_f32_16x16x32_bf16(b[j], af[i % 3], acc[i][j], 0, 0, 0);
        }
      }
    }
    const int cw = col0 + wn * 64;
    if (EPI == 0) {
      const int e = sub;
#pragma unroll
      for (int mi = 0; mi < MI; ++mi) {
        const int row = row0 + wm * (BM / 2) + mi * 16 + l16;
#pragma unroll
        for (int ni = 0; ni < 4; ++ni) {
          const int col = cw + ni * 16 + quad * 4;
          const f32x4 v = acc[mi][ni];
          u32x2 o; o.x = pack2(v[0], v[1]); o.y = pack2(v[2], v[3]);
          *(u32x2*)(dst + (long)row * 3328 + col) = o;
          if (row < NCTX && cw >= 512 && cw < 1536) {
            const int b = row >> 8, t = row & 255;
            if (cw < 1024) *(f32x4*)(p.out + OUT_NAK + ((long)((b * 2 + e) * 256 + t)) * 512 + col - 512) = v;
            else *(f32x4*)(p.out + OUT_NAV + ((long)((b * 2 + e) * 256 + t)) * 512 + col - 1024) = v;
          }
        }
      }
    } else if (EPI == 1) {
      const int o = sub;
      float inv[4];
#pragma unroll
      for (int j = 0; j < 4; ++j) inv[j] = exp2f(-(float)(quad * 4 + j) * (13.287712379549449f / 16.f));
#pragma unroll
      for (int mi = 0; mi < MI; ++mi) {
        const int row = row0 + wm * (BM / 2) + mi * 16 + l16;
        f32x4 v0 = acc[mi][0], v1 = acc[mi][1], v2 = acc[mi][2], v3 = acc[mi][3];
        if (row >= NCTX && cw < 2048) {
          const int tp = (row - NCTX) & 4095;
#pragma unroll
          for (int j = 0; j < 4; ++j) {
            const float a0 = (float)(tp >> 6) * inv[j], a1 = (float)(tp & 63) * inv[j];
            const float c0 = __cosf(a0), s0 = __sinf(a0), c1 = __cosf(a1), s1 = __sinf(a1);
            const float n0 = v0[j] * c0 - v1[j] * s0, n1 = v0[j] * s0 + v1[j] * c0;
            const float n2 = v2[j] * c1 - v3[j] * s1, n3 = v2[j] * s1 + v3[j] * c1;
            v0[j] = n0; v1[j] = n1; v2[j] = n2; v3[j] = n3;
          }
        }
        f32x4 vv[4] = {v0, v1, v2, v3};
#pragma unroll
        for (int ni = 0; ni < 4; ++ni) {
          const int col = cw + ni * 16 + quad * 4;
          u32x2 ob; ob.x = pack2(vv[ni][0], vv[ni][1]); ob.y = pack2(vv[ni][2], vv[ni][3]);
          *(u32x2*)(dst + (long)row * 3072 + col) = ob;
          if (row < NCTX && cw >= 1024) {
            const int b = row >> 8, t = row & 255;
            if (cw < 2048) *(f32x4*)(p.out + OUT_DK + ((long)((b * 2 + o) * 256 + t)) * 1024 + col - 1024) = vv[ni];
            else *(f32x4*)(p.out + OUT_DV + ((long)((b * 2 + o) * 256 + t)) * 1024 + col - 2048) = vv[ni];
          }
        }
      }
    } else if (EPI == 2) {
      f32x4 gt[4];
#pragma unroll
      for (int ni = 0; ni < 4; ++ni) gt[ni] = *(const f32x4*)(modv + gate_idx * 1024 + cw + ni * 16 + quad * 4);
#pragma unroll
      for (int mi = 0; mi < MI; ++mi) {
        const int row = row0 + wm * (BM / 2) + mi * 16 + l16;
#pragma unroll
        for (int ni = 0; ni < 4; ++ni) {
          f32x4* xp = (f32x4*)(X + (long)row * 1024 + cw + ni * 16 + quad * 4);
          *xp = *xp + gt[ni] * acc[mi][ni];
        }
      }
    } else {
#pragma unroll
      for (int mi = 0; mi < MI; ++mi) {
        const int row = row0 + wm * (BM / 2) + mi * 16 + l16;
#pragma unroll
        for (int ni = 0; ni < 2; ++ni) {
          const f32x4 a = acc[mi][ni], b = acc[mi][ni + 2];
          u32x2 ob;
          ob.x = pack2(a[0] * sigmoidf_(a[0]) * b[0], a[1] * sigmoidf_(a[1]) * b[1]);
          ob.y = pack2(a[2] * sigmoidf_(a[2]) * b[2], a[3] * sigmoidf_(a[3]) * b[3]);
          *(u32x2*)(dst + (long)row * 2816 + (cw >> 1) + ni * 16 + quad * 4) = ob;
        }
      }
    }
  }
}

__device__ __forceinline__ unsigned cvt_pk_bf16(float lo, float hi) { return pack2(lo, hi); }
typedef __attribute__((ext_vector_type(2))) unsigned u32pair_t;
__device__ __forceinline__ float xq_max(float v) {
  const unsigned x = __float_as_uint(v);
  const u32pair_t r = __builtin_amdgcn_permlane16_swap(x, x, false, false);
  const float m = fmaxf(__uint_as_float(r.x), __uint_as_float(r.y));
  const unsigned y = __float_as_uint(m);
  const u32pair_t q = __builtin_amdgcn_permlane32_swap(y, y, false, false);
  return fmaxf(__uint_as_float(q.x), __uint_as_float(q.y));
}
__device__ __forceinline__ float xq_sum(float v) {
  const unsigned x = __float_as_uint(v);
  const u32pair_t r = __builtin_amdgcn_permlane16_swap(x, x, false, false);
  const float m = __uint_as_float(r.x) + __uint_as_float(r.y);
  const unsigned y = __float_as_uint(m);
  const u32pair_t q = __builtin_amdgcn_permlane32_swap(y, y, false, false);
  return __uint_as_float(q.x) + __uint_as_float(q.y);
}
template <int NS, int DV, bool LOCAL>
__device__ __forceinline__ void attn_job(char* smem, const u16* qp, int qst,
                         const u16* k0, const u16* v0, int st0, int n0,
                         const u16* k1, const u16* v1, int st1, int n1,
                         const float* rpbh, int qi, int r0,
                         float lam, float outscale, const float* subln,
                         u16* op, int ost) {
  constexpr int KD = NS * 64, KST = KD + 16, KCH = KD / 8;
  u16* Ks = (u16*)smem;
  constexpr int VST = DV + 8, VCH = DV / 8;
  u16* Vs = Ks + 64 * KST;
  u16* Ps = Vs + 64 * VST;
  const int tid = otid(), lane = tid & 63, wave = tid >> 6, quad = lane >> 4, l16 = lane & 15;
  constexpr float C2 = 0.125f * 1.4426950408889634f;
  bf16x8 qf[NS][2];
#pragma unroll
  for (int s = 0; s < NS; ++s)
#pragma unroll
    for (int ks = 0; ks < 2; ++ks)
      qf[s][ks] = *(const bf16x8*)(qp + (long)(wave * 16 + l16) * qst + s * 64 + ks * 32 + quad * 8);
  float m[NS], l[NS];
  f32x4 O[NS][DV / 16];
#pragma unroll
  for (int s = 0; s < NS; ++s) {
    m[s] = -1e30f; l[s] = 0.f;
#pragma unroll
    for (int n = 0; n < DV / 16; ++n) O[s][n] = (f32x4){0.f, 0.f, 0.f, 0.f};
  }
  const int jq = wave * 16 + l16;
  int c0 = jq - 8; c0 = c0 < 0 ? 0 : (c0 > 48 ? 48 : c0);
  const int nt0 = n0 >> 6, ntot = nt0 + (n1 >> 6);
  constexpr int KPT = (64 * KCH) / 256;
  constexpr int VPT = (64 * VCH) / 256;
  u32x4 kreg[KPT];
  u32x4 vreg[VPT];
  auto load_tile = [&](int t) {
    const u16 *kp, *vp; int st;
    if (t < nt0) { kp = k0 + (long)t * 64 * st0; vp = v0 + (long)t * 64 * st0; st = st0; }
    else { kp = k1 + (long)(t - nt0) * 64 * st1; vp = v1 + (long)(t - nt0) * 64 * st1; st = st1; }
#pragma unroll
    for (int i = 0; i < KPT; ++i) {
      const int c = tid + 256 * i;
      kreg[i] = *(const u32x4*)(kp + (long)(c / KCH) * st + (c % KCH) * 8);
    }
#pragma unroll
    for (int i = 0; i < VPT; ++i) {
      const int c = tid + 256 * i;
      vreg[i] = *(const u32x4*)(vp + (long)(c / VCH) * st + (c % VCH) * 8);
    }
  };
  load_tile(0);
  for (int t = 0; t < ntot; ++t) {
    __syncthreads();
#pragma unroll
    for (int i = 0; i < KPT; ++i) {
      const int c = tid + 256 * i;
      *(u32x4*)(Ks + (c / KCH) * KST + (c % KCH) * 8) = kreg[i];
    }
#pragma unroll
    for (int i = 0; i < VPT; ++i) {
      const int c = tid + 256 * i;
      *(u32x4*)(Vs + (c / VCH) * VST + (c % VCH) * 8) = vreg[i];
    }
    __syncthreads();
    if (t + 1 < ntot) load_tile(t + 1);
    __builtin_amdgcn_sched_barrier(0);
#pragma unroll
    for (int s = 0; s < NS; ++s) {
      f32x4 sc[4];
#pragma unroll
      for (int n = 0; n < 4; ++n) {
        sc[n] = (f32x4){0.f, 0.f, 0.f, 0.f};
#pragma unroll
        for (int ks = 0; ks < 2; ++ks) {
          const bf16x8 kf = *(const bf16x8*)(Ks + (n * 16 + l16) * KST + s * 64 + ks * 32 + quad * 8);
          sc[n] = __builtin_amdgcn_mfma_f32_16x16x32_bf16(kf, qf[s][ks], sc[n], 0, 0, 0);
        }
      }
      float mx = -1e30f;
#pragma unroll
      for (int n = 0; n < 4; ++n)
#pragma unroll
        for (int j = 0; j < 4; ++j) {
          float v = sc[n][j] * C2;
          if (LOCAL) {
            if (t >= nt0) {
              const int kr = r0 + (t - nt0), kc = n * 16 + quad * 4 + j;
              const bool ok = (kc >= c0) && (kc < c0 + 16);
              const float bias = rpbh[ok ? ((kr - qi + 7) * 31 + (kc - jq + 15)) : 0];
              v = ok ? v + bias * 1.4426950408889634f : -1e30f;
            }
          }
          sc[n][j] = v;
          mx = fmaxf(mx, v);
        }
      mx = xq_max(mx);
      const float mn = fmaxf(m[s], mx);
      if (__builtin_amdgcn_ballot_w64(mn > m[s]) != 0ull) {
        const float corr = __builtin_amdgcn_exp2f(m[s] - mn);
        l[s] *= corr;
#pragma unroll
        for (int n = 0; n < DV / 16; ++n) O[s][n] *= corr;
        m[s] = mn;
      }
      float rs = 0.f;
#pragma unroll
      for (int n = 0; n < 4; ++n) {
        const float p0 = __builtin_amdgcn_exp2f(sc[n][0] - mn), p1 = __builtin_amdgcn_exp2f(sc[n][1] - mn);
        const float p2 = __builtin_amdgcn_exp2f(sc[n][2] - mn), p3 = __builtin_amdgcn_exp2f(sc[n][3] - mn);
        rs += (p0 + p1) + (p2 + p3);
        u32x2 pk; pk.x = cvt_pk_bf16(p0, p1); pk.y = cvt_pk_bf16(p2, p3);
        *(u32x2*)(Ps + ((wave * NS + s) * 16 + l16) * 80 + n * 16 + quad * 4) = pk;
      }
      l[s] += rs;
    }
    __builtin_amdgcn_wave_barrier();
    {
      bf16x8 pf[NS][2];
#pragma unroll
      for (int s = 0; s < NS; ++s)
#pragma unroll
        for (int ks = 0; ks < 2; ++ks)
          pf[s][ks] = *(const bf16x8*)(Ps + ((wave * NS + s) * 16 + l16) * 80 + ks * 32 + quad * 8);
#pragma unroll
      for (int ks = 0; ks < 2; ++ks)
#pragma unroll
        for (int n = 0; n < DV / 16; ++n) {
          const u16* va = Vs + (ks * 32 + quad * 8 + (l16 >> 2)) * VST + n * 16 + (l16 & 3) * 4;
          typedef __attribute__((ext_vector_type(4))) short s16x4_t;
          const s16x4_t v0 = __builtin_amdgcn_ds_read_tr16_b64_v4i16((__attribute__((address_space(3))) s16x4_t*)va);
          const s16x4_t v1 = __builtin_amdgcn_ds_read_tr16_b64_v4i16((__attribute__((address_space(3))) s16x4_t*)(va + 4 * VST));
          const bf16x8 vf = __builtin_shufflevector(v0, v1, 0, 1, 2, 3, 4, 5, 6, 7);
#pragma unroll
          for (int s = 0; s < NS; ++s) O[s][n] = __builtin_amdgcn_mfma_f32_16x16x32_bf16(vf, pf[s][ks], O[s][n], 0, 0, 0);
        }
    }
  }
  u16* orow = op + (long)(wave * 16 + l16) * ost + quad * 4;
  if (NS == 1) {
    const float il = 1.f / xq_sum(l[0]);
#pragma unroll
    for (int n = 0; n < DV / 16; ++n) {
      u32x2 o; o.x = cvt_pk_bf16(O[0][n][0] * il, O[0][n][1] * il); o.y = cvt_pk_bf16(O[0][n][2] * il, O[0][n][3] * il);
      *(u32x2*)(orow + n * 16) = o;
    }
  } else {
    const float i0 = 1.f / xq_sum(l[0]), i1 = lam / xq_sum(l[NS - 1]);
    float ss = 0.f;
#pragma unroll
    for (int n = 0; n < DV / 16; ++n) {
      O[0][n] = O[0][n] * i0 - O[NS - 1][n] * i1;
      ss += O[0][n][0] * O[0][n][0] + O[0][n][1] * O[0][n][1] + O[0][n][2] * O[0][n][2] + O[0][n][3] * O[0][n][3];
    }
    ss = xq_sum(ss);
    const float ri = rsqrtf(ss * (1.f / (float)DV) + 1e-6f) * outscale;
#pragma unroll
    for (int n = 0; n < DV / 16; ++n) {
      const f32x4 g = *(const f32x4*)(subln + n * 16 + quad * 4);
      u32x2 o; o.x = cvt_pk_bf16(O[0][n][0] * ri * g[0], O[0][n][1] * ri * g[1]); o.y = cvt_pk_bf16(O[0][n][2] * ri * g[2], O[0][n][3] * ri * g[3]);
      *(u32x2*)(orow + n * 16) = o;
    }
  }
}

__device__ __forceinline__ float* yl_ptr(const P& p, int tok, int d, int col) {
  const int slab = tok >> 8;
  return p.out + OUT_DK + (long)(slab >> 5) * 16777216L + ((long)(((slab & 31) * 2 + 1) * 256 + (tok & 255))) * 1024 + d * 512 + col;
}
__device__ __forceinline__ float* tb_ptr(const P& p, int unit, int d, int isB) {
  return (float*)(p.ws + WS_TB) + ((long)((unit * 2 + d) * 2 + isB)) * 4096;
}
__device__ __forceinline__ float ushift(const u16* proj, const float* mu, int tok, int seq0, int slen, int c) {
  const u16* pp = proj + (long)tok * 3328 + 1536 + c;
  const bool hp = tok > seq0, hn = tok < seq0 + slen - 1;
  const float cur = bf2f(pp[0]);
  const float pv = bf2f(pp[hp ? -3328 : 0]);
  const float nv = bf2f(pp[hn ? 3328 : 0]);
  const float prev = hp ? pv : 0.f;
  const float next = hn ? nv : 0.f;
  return cur + mu[c] * (prev - cur) + mu[1792 + c] * (next - cur);
}

__device__ __forceinline__ void rwkv_scan_unit(const P& p, char* smem, int e, int unit) {
  const int gch = unit >> 3, h = unit & 7;
  int seq0, slen;
  if (gch < 64) { seq0 = (gch >> 1) * 256; slen = 256; } else { seq0 = NCTX + ((gch - 64) >> 5) * 4096; slen = 4096; }
  const int t0 = gch * 128;
  float* sc = (float*)smem;
  const u16* proj = (const u16*)(p.ws + WS_BIG);
  const float* mu = p.in[17] + e * 2 * 1792;
  const float* w0 = p.in[18] + e * 1024;
  const float* w2 = p.in[19] + (long)e * 2 * 64 * 512;
  const float* a0 = p.in[20] + e * 1024;
  const float* a2 = p.in[21] + (long)e * 2 * 64 * 512;
  const float* kkw = p.in[22] + e * 512;
  const float* kaw = p.in[23] + e * 512;
  const float* bonus = p.in[24] + e * 1024;
  float* rkb = (float*)(p.ws + WS_RKB);
  float* qt = (float*)(p.ws + WS_QT);
  const int tid = otid(), lane = tid & 63, wave = tid >> 6;
  const int sd = wave >> 1; const bool isB = (wave & 1) != 0;
  const int pd = tid >> 7, th = (tid >> 6) & 1;
  float S[64];
#pragma unroll
  for (int j = 0; j < 64; ++j) S[j] = (!isB && j == lane) ? 1.f : 0.f;
  const int hc = h * 64 + lane;
  const float kkwj = kkw[hc], kawj = kaw[hc], bonj = bonus[pd * 512 + hc], w0j = w0[pd * 512 + hc], a0j = a0[pd * 512 + hc];

  u16* raw = (u16*)(smem + 49152);
  u32x4 rg[3];
  auto load_raw = [&](int lo) {
#pragma unroll
    for (int i = 0; i < 3; ++i) {
      const int c = tid + 256 * i;
      u32x4 v = (u32x4){0u, 0u, 0u, 0u};
      if (c < 720) {
        const int row = c / 40, cc = c % 40, vec = cc >> 3, ch = cc & 7;
        const int tok = lo + row;
        const int voff = (vec < 3) ? (vec * 512 + h * 64) : (1536 + (vec - 3) * 64);
        const int tokc = tok < seq0 ? seq0 : (tok > seq0 + slen - 1 ? seq0 + slen - 1 : tok);
        const u32x4 ld = *(const u32x4*)(proj + (long)tokc * 3328 + 1536 + voff + ch * 8);
        const bool inb = (tok >= seq0) && (tok < seq0 + slen);
        v.x = inb ? ld.x : 0u; v.y = inb ? ld.y : 0u; v.z = inb ? ld.z : 0u; v.w = inb ? ld.w : 0u;
      }
      rg[i] = v;
    }
  };
  auto store_raw = [&]() {
#pragma unroll
    for (int i = 0; i < 3; ++i) {
      const int c = tid + 256 * i;
      if (c < 720) {
        const int row = c / 40, cc = c % 40;
        *(u32x4*)(raw + row * 320 + cc * 8) = rg[i];
      }
    }
  };
  auto shift_dir = [&](int d) {
    float mu0v[5], mu1v[5];
#pragma unroll
    for (int v = 0; v < 5; ++v) {
      const int c = (v < 3) ? (v * 512 + h * 64 + lane) : (1536 + (v - 3) * 64 + lane);
      mu0v[v] = mu[c]; mu1v[v] = mu[1792 + c];
    }
#pragma unroll
    for (int vec = 0; vec < 5; ++vec)
#pragma unroll
      for (int k = 0; k < 4; ++k) {
        const int pslot = wave + 4 * k;
        const int row = (d == 0) ? pslot + 1 : 16 - pslot;
        const u16* rp = raw + row * 320 + vec * 64 + lane;
        const float cur = bf2f(rp[0]), prev = bf2f(rp[-320]), next = bf2f(rp[320]);
        float val = cur + mu0v[vec] * (prev - cur) + mu1v[vec] * (next - cur);
        if (vec == 3) { const float ex = __expf(2.f * val); val = 1.f - 2.f * __builtin_amdgcn_rcpf(ex + 1.f); }
        if (vec >= 3) ((u16*)(sc + (d * 6 + 5) * 1024))[(vec - 3) * 1024 + pslot * 64 + lane] = f2bf(val);
        else sc[((d * 6 + vec) * 16 + pslot) * 64 + lane] = val;
      }
  };
  for (int sub = 0; sub < 8; ++sub) {
    load_raw(t0 + sub * 16 - 1);
    __syncthreads();
    store_raw();
    load_raw(t0 + 127 - sub * 16 - 16);
    __syncthreads();
    shift_dir(0);
    __syncthreads();
    store_raw();
    __syncthreads();
    shift_dir(1);
    __syncthreads();
    {
      const int t2 = otid(), quad = (t2 >> 4) & 3, l16 = t2 & 15, w2i = t2 >> 6, sd2 = w2i >> 1, mat = w2i & 1;
      const u16* at = (const u16*)(sc + (sd2 * 6 + 5) * 1024) + mat * 1024;
      const u16* wt = (const u16*)(p.ws + WS_WT) + ((long)((e * 2 + sd2) * 2 + mat) * 512 + h * 64) * 64;
      bf16x8 af[2];
#pragma unroll
      for (int ks = 0; ks < 2; ++ks) af[ks] = *(const bf16x8*)(at + l16 * 64 + ks * 32 + quad * 8);
#pragma unroll
      for (int nt = 0; nt < 4; ++nt) {
        f32x4 dacc = (f32x4){0.f, 0.f, 0.f, 0.f};
#pragma unroll
        for (int ks = 0; ks < 2; ++ks) {
          const bf16x8 bfr = *(const bf16x8*)(wt + (nt * 16 + l16) * 64 + ks * 32 + quad * 8);
          dacc = __builtin_amdgcn_mfma_f32_16x16x32_bf16(af[ks], bfr, dacc, 0, 0, 0);
        }
#pragma unroll
        for (int j = 0; j < 4; ++j) sc[((sd2 * 6 + 3 + mat) * 16 + quad * 4 + j) * 64 + nt * 16 + l16] = dacc[j];
      }
    }
    __syncthreads();
    {
      float* scw = sc + pd * 6 * 1024;
#pragma unroll
      for (int tk = 0; tk < 8; ++tk) {
        const int pslot = th * 8 + tk;
        const int tok = (pd == 0) ? (t0 + sub * 16 + pslot) : (t0 + 127 - sub * 16 - pslot);
        const float kv = scw[(1 * 16 + pslot) * 64 + lane];
        const float rv = scw[(0 * 16 + pslot) * 64 + lane];
        float kkv = kv * kkwj;
        const float nrm = wave_sum(kkv * kkv);
        kkv *= rsqrtf(fmaxf(nrm, 1e-12f));
        const float xw = -(w0j + scw[(3 * 16 + pslot) * 64 + lane]);
        const float sp = fmaxf(xw, 0.f) + __logf(1.f + __expf(-fabsf(xw)));
        const float decay = __expf(-__expf(-sp - 0.5f));
        const float a = sigmoidf_(a0j + scw[(4 * 16 + pslot) * 64 + lane]);
        const float kt = kv * (1.f + (a - 1.f) * kawj);
        const float bsum = wave_sum(rv * kt * bonj);
        scw[(5 * 16 + pslot) * 64 + lane] = kkv;
        scw[(3 * 16 + pslot) * 64 + lane] = decay;
        scw[(4 * 16 + pslot) * 64 + lane] = kkv * a;
        scw[(1 * 16 + pslot) * 64 + lane] = kt;
        if (lane == 0) rkb[tok * 16 + pd * 8 + h] = bsum;
      }
    }
    __syncthreads();
    if (isB || gch >= 64 || ((gch & 1) == (sd == 0 ? 1 : 0))) {
      const float* base = sc + sd * 6 * 1024;
      for (int ps = 0; ps < 16; ++ps) {
        const f32x4* kk4 = (const f32x4*)(base + (5 * 16 + ps) * 64);
        const f32x4* w4 = (const f32x4*)(base + (3 * 16 + ps) * 64);
        const f32x4* ka4 = (const f32x4*)(base + (4 * 16 + ps) * 64);
        const f32x4* kt4 = (const f32x4*)(base + (1 * 16 + ps) * 64);
        const f32x4* r4 = (const f32x4*)(base + (0 * 16 + ps) * 64);
        f32x4 kk[16];
#pragma unroll
        for (int q = 0; q < 16; ++q) kk[q] = kk4[q];
        f32x4 bw[2][2], bka[2][2], bkt[2][2], br[2][2];
#pragma unroll
        for (int q = 0; q < 2; ++q) { bw[0][q] = w4[q]; bka[0][q] = ka4[q]; br[0][q] = r4[q]; bkt[0][q] = kt4[q]; }
        const float vv = isB ? base[(2 * 16 + ps) * 64 + lane] : 0.f;
        __builtin_amdgcn_sched_barrier(0);
        float s0 = 0.f, s1 = 0.f;
#pragma unroll
        for (int q = 0; q < 16; ++q) {
          s0 += S[q * 4 + 0] * kk[q].x; s1 += S[q * 4 + 1] * kk[q].y; s0 += S[q * 4 + 2] * kk[q].z; s1 += S[q * 4 + 3] * kk[q].w;
        }
        const float nskk = -(s0 + s1);
        float y0 = 0.f, y1 = 0.f;
#pragma unroll
        for (int qq = 0; qq < 8; ++qq) {
          const int cb = qq & 1, nbf = cb ^ 1;
          if (qq < 7) {
#pragma unroll
            for (int q = 0; q < 2; ++q) {
              bw[nbf][q] = w4[(qq + 1) * 2 + q]; bka[nbf][q] = ka4[(qq + 1) * 2 + q];
              br[nbf][q] = r4[(qq + 1) * 2 + q]; bkt[nbf][q] = kt4[(qq + 1) * 2 + q];
            }
          }
          __builtin_amdgcn_sched_barrier(0);
#pragma unroll
          for (int q = 0; q < 2; ++q) {
            const int j = (qq * 2 + q) * 4;
            const f32x4 w = bw[cb][q], ka = bka[cb][q], kt = bkt[cb][q], r = br[cb][q];
            S[j + 0] = fmaf(vv, kt.x, fmaf(nskk, ka.x, S[j + 0] * w.x));
            S[j + 1] = fmaf(vv, kt.y, fmaf(nskk, ka.y, S[j + 1] * w.y));
            S[j + 2] = fmaf(vv, kt.z, fmaf(nskk, ka.z, S[j + 2] * w.z));
            S[j + 3] = fmaf(vv, kt.w, fmaf(nskk, ka.w, S[j + 3] * w.w));
            y0 += S[j + 0] * r.x; y1 += S[j + 1] * r.y; y0 += S[j + 2] * r.z; y1 += S[j + 3] * r.w;
          }
        }
        const int tok = (sd == 0) ? (t0 + sub * 16 + ps) : (t0 + 127 - sub * 16 - ps);
        const float y = y0 + y1;
        if (isB) *yl_ptr(p, tok, sd, hc) = y;
        else qt[((long)tok * 2 + sd) * 512 + hc] = y;
      }
    }
  }
  float4* tp = (float4*)(tb_ptr(p, unit, sd, isB ? 1 : 0) + lane * 64);
#pragma unroll
  for (int q = 0; q < 16; ++q) tp[q] = make_float4(S[q * 4], S[q * 4 + 1], S[q * 4 + 2], S[q * 4 + 3]);
}

__device__ __forceinline__ void rwkv_e3_job(const P& p, char* smem, int e, int job) {
  float* Ss = (float*)smem;
  const int tid = otid(), r = tid >> 4, cgp = tid & 15;
  __syncthreads();
  if (job < 2048) {
    const int chain = job >> 2, rg = job & 3, row = rg * 16 + r;
    const int seq = chain >> 4, h = (chain >> 1) & 7, d = chain & 1;
    const int first = seq * 2 + (d == 0 ? 0 : 1), second = seq * 2 + (d == 0 ? 1 : 0);
    const float* Bf = tb_ptr(p, first * 8 + h, d, 1);
    const float* Ts = tb_ptr(p, second * 8 + h, d, 0);
    const float* Bs = tb_ptr(p, second * 8 + h, d, 1);
    *(float4*)(Ss + r * 64 + cgp * 4) = *(const float4*)(Bf + row * 64 + cgp * 4);
    __syncthreads();
    float4 acc = *(const float4*)(Bs + row * 64 + cgp * 4);
#pragma unroll 8
    for (int i = 0; i < 64; ++i) {
      const float s = Ss[r * 64 + i];
      const float4 t = *(const float4*)(Ts + i * 64 + cgp * 4);
      acc.x += s * t.x; acc.y += s * t.y; acc.z += s * t.z; acc.w += s * t.w;
    }
    *(float4*)(p.out + OUT_ST + ((long)(((seq * 2 + e) * 2 + d) * 8 + h)) * 4096 + row * 64 + cgp * 4) = acc;
  } else {
    const int j2 = job - 2048;
    const int chain = j2 >> 2, rg = j2 & 3, row = rg * 16 + r;
    const int b = chain >> 4, h = (chain >> 1) & 7, d = chain & 1;
    float* Tb = (float*)smem + 1024;
    const float* s0 = p.in[5] + ((long)(((b * 2 + e) * 2 + d) * 8 + h)) * 4096;
    *(float4*)(Ss + r * 64 + cgp * 4) = *(const float4*)(s0 + row * 64 + cgp * 4);
    f32x4 tn[4], bn;
    float* Bcur;
    {
      const int gch = 64 + b * 32 + ((d == 0) ? 0 : 31);
      const float* Tc = tb_ptr(p, gch * 8 + h, d, 0);
      Bcur = tb_ptr(p, gch * 8 + h, d, 1);
#pragma unroll
      for (int q = 0; q < 4; ++q) tn[q] = *(const f32x4*)(Tc + (tid + 256 * q) * 4);
      bn = *(const f32x4*)(Bcur + row * 64 + cgp * 4);
    }
    for (int step = 0; step < 31; ++step) {
      float* Tcur = Tb + (step & 1) * 4096;
#pragma unroll
      for (int q = 0; q < 4; ++q) *(f32x4*)(Tcur + (tid + 256 * q) * 4) = tn[q];
      f32x4 acc = bn;
      float* Bst = Bcur;
      __syncthreads();
      if (step + 1 < 31) {
        const int c = (d == 0) ? step + 1 : 30 - step;
        const int gch = 64 + b * 32 + c;
        const float* Tc = tb_ptr(p, gch * 8 + h, d, 0);
        Bcur = tb_ptr(p, gch * 8 + h, d, 1);
#pragma unroll
        for (int q = 0; q < 4; ++q) tn[q] = *(const f32x4*)(Tc + (tid + 256 * q) * 4);
        bn = *(const f32x4*)(Bcur + row * 64 + cgp * 4);
      }
#pragma unroll 16
      for (int i = 0; i < 64; ++i) {
        const float sv = Ss[r * 64 + i];
        const f32x4 t = *(const f32x4*)(Tcur + i * 64 + cgp * 4);
        acc += sv * t;
      }
      __syncthreads();
      *(f32x4*)(Ss + r * 64 + cgp * 4) = acc;
      *(f32x4*)(Bst + row * 64 + cgp * 4) = acc;
    }
  }
}

__device__ __forceinline__ void rwkv_e4_unit(const P& p, char* smem, int e, int unit) {
  const int gch = unit >> 3, h = unit & 7;
  int seq0, slen, cidx, nch;
  if (gch < 64) { seq0 = (gch >> 1) * 256; slen = 256; cidx = gch & 1; nch = 2; }
  else { seq0 = NCTX + ((gch - 64) >> 5) * 4096; slen = 4096; cidx = (gch - 64) & 31; nch = 32; }
  const int tid = otid(), lane = tid & 63, wave = tid >> 6;
  float* qbuf = (float*)smem + wave * 1024;
  float* dout = qbuf;
  u16* G2T = (u16*)(smem + 16384);
  u16* SGw = (u16*)(smem + 34816) + wave * 16 * 144;
  const u16* proj = (const u16*)(p.ws + WS_BIG);
  const float* mu = p.in[17] + e * 2 * 1792;
  const float* g2 = p.in[25] + (long)e * 128 * 512;
  const float* rkb = (const float*)(p.ws + WS_RKB);
  const float* qt = (const float*)(p.ws + WS_QT);
  u16* mix = (u16*)(p.ws + WS_MIX);
  const int hc = h * 64 + lane;
  const int quad = lane >> 4, l16 = lane & 15;
  __syncthreads();
#pragma unroll 8
  for (int idx = tid; idx < 8192; idx += 256) G2T[(idx & 63) * 144 + (idx >> 6)] = f2bf(g2[(long)(idx >> 6) * 512 + h * 64 + (idx & 63)]);
  __syncthreads();
  const float lnw = p.in[26][e * 512 + hc], lnb = p.in[27][e * 512 + hc];
  const int cg0 = 1536 + 1664 + lane, cg1 = 1536 + 1728 + lane, cv = 1536 + 1024 + hc;
  const float m0g0 = mu[1664 + lane], m1g0 = mu[1792 + 1664 + lane];
  const float m0g1 = mu[1728 + lane], m1g1 = mu[1792 + 1728 + lane];
  const float m0v = mu[1024 + hc], m1v = mu[1792 + 1024 + hc];
  for (int hf = 0; hf < 2; ++hf) {
    const int tw0 = gch * 128 + wave * 32 + hf * 16;
    float yv[16];
#pragma unroll
    for (int tk = 0; tk < 16; ++tk) yv[tk] = *yl_ptr(p, tw0 + tk, 0, hc) + *yl_ptr(p, tw0 + tk, 1, hc);
    for (int d = 0; d < 2; ++d) {
      const int oi = (d == 0) ? cidx : nch - 1 - cidx;
      const float* Sp = nullptr;
      if (oi == 0) {
        if (gch >= 64) Sp = p.in[5] + ((long)(((((gch - 64) >> 5) * 2 + e) * 2 + d) * 8 + h)) * 4096;
      } else {
        const int gp = (d == 0) ? gch - 1 : gch + 1;
        Sp = tb_ptr(p, gp * 8 + h, d, 1);
      }
      if (Sp != nullptr) {
        float S[64];
#pragma unroll
        for (int q = 0; q < 16; ++q) {
          const f32x4 v = *(const f32x4*)(Sp + lane * 64 + q * 4);
          S[q * 4] = v[0]; S[q * 4 + 1] = v[1]; S[q * 4 + 2] = v[2]; S[q * 4 + 3] = v[3];
        }
        f32x4 qv[4];
#pragma unroll
        for (int i = 0; i < 4; ++i) {
          const int idx = lane + 64 * i, r = idx >> 4, c4 = idx & 15;
          qv[i] = *(const f32x4*)(qt + ((long)(tw0 + r) * 2 + d) * 512 + h * 64 + c4 * 4);
        }
        __builtin_amdgcn_wave_barrier();
#pragma unroll
        for (int i = 0; i < 4; ++i) *(f32x4*)(qbuf + (lane + 64 * i) * 4) = qv[i];
        __builtin_amdgcn_wave_barrier();
#pragma unroll
        for (int r = 0; r < 16; ++r) {
          float y0 = 0.f, y1 = 0.f;
#pragma unroll
          for (int q = 0; q < 16; ++q) {
            const f32x4 v = *(const f32x4*)(qbuf + r * 64 + q * 4);
            y0 += S[q * 4] * v[0]; y1 += S[q * 4 + 1] * v[1]; y0 += S[q * 4 + 2] * v[2]; y1 += S[q * 4 + 3] * v[3];
          }
          yv[r] += y0 + y1;
        }
        __builtin_amdgcn_wave_barrier();
      }
    }
    float rkl = 0.f;
    if (lane < 16) rkl = rkb[(tw0 + lane) * 16 + h] + rkb[(tw0 + lane) * 16 + 8 + h];
    auto ldrow = [&](int r, float& a, float& b, float& c) {
      const bool ok = (r >= seq0) && (r < seq0 + slen);
      const u16* rp = proj + (long)(ok ? r : tw0) * 3328;
      const float x = bf2f(rp[cg0]), y = bf2f(rp[cg1]), z = bf2f(rp[cv]);
      a = ok ? x : 0.f; b = ok ? y : 0.f; c = ok ? z : 0.f;
    };
    float pg0, pg1, pvv, cg0v, cg1v, cvv, ng0, ng1, nvv;
    ldrow(tw0 - 1, pg0, pg1, pvv);
    ldrow(tw0, cg0v, cg1v, cvv);
    ldrow(tw0 + 1, ng0, ng1, nvv);
    float vshv[16];
#pragma unroll
    for (int tk = 0; tk < 16; ++tk) {
      float fg0, fg1, fvv;
      ldrow(tw0 + tk + 2, fg0, fg1, fvv);
      const float gv0 = sigmoidf_(cg0v + m0g0 * (pg0 - cg0v) + m1g0 * (ng0 - cg0v));
      const float gv1 = sigmoidf_(cg1v + m0g1 * (pg1 - cg1v) + m1g1 * (ng1 - cg1v));
      vshv[tk] = cvv + m0v * (pvv - cvv) + m1v * (nvv - cvv);
      pg0 = cg0v; pg1 = cg1v; pvv = cvv; cg0v = ng0; cg1v = ng1; cvv = nvv; ng0 = fg0; ng1 = fg1; nvv = fvv;
      SGw[tk * 144 + lane] = f2bf(gv0);
      SGw[tk * 144 + 64 + lane] = f2bf(gv1);
    }
    __builtin_amdgcn_wave_barrier();
    {
      bf16x8 af[4];
#pragma unroll
      for (int ks = 0; ks < 4; ++ks) af[ks] = *(const bf16x8*)(SGw + l16 * 144 + ks * 32 + quad * 8);
#pragma unroll
      for (int nt = 0; nt < 4; ++nt) {
        f32x4 dacc = (f32x4){0.f, 0.f, 0.f, 0.f};
#pragma unroll
        for (int ks = 0; ks < 4; ++ks) {
          const bf16x8 bfr = *(const bf16x8*)(G2T + (nt * 16 + l16) * 144 + ks * 32 + quad * 8);
          dacc = __builtin_amdgcn_mfma_f32_16x16x32_bf16(af[ks], bfr, dacc, 0, 0, 0);
        }
#pragma unroll
        for (int j = 0; j < 4; ++j) dout[(quad * 4 + j) * 64 + nt * 16 + l16] = dacc[j];
      }
    }
    __builtin_amdgcn_wave_barrier();
#pragma unroll
    for (int tk = 0; tk < 16; ++tk) {
      const int tok = tw0 + tk;
      const float rk = __int_as_float(__builtin_amdgcn_readlane(__float_as_int(rkl), tk));
      const float gate = dout[tk * 64 + lane];
      const float y = yv[tk];
      const float mean = wave_sum(y) * (1.f / 64.f);
      const float dv = y - mean;
      const float var = wave_sum(dv * dv) * (1.f / 64.f);
      const float yn = dv * rsqrtf(var + 64e-5f) * lnw + lnb;
      mix[(long)tok * 1024 + 512 + hc] = f2bf((yn + rk * vshv[tk]) * gate);
    }
    __builtin_amdgcn_wave_barrier();
  }
}

#define XB_TMO      128
#define XB_XCNT(j)  (256  + 64 * (j))
#define XB_XSUB(j)  (1280 + 64 * (j))
#define XB_XGEN(j)  (2304 + 64 * (j))
#define XB_TOP      3328
#define XB_TOPGEN   3392
#define XCD_BAR_WORDS 3456
#define XB_SPIN_CAP (1u << 22)
#define LAS __attribute__((address_space(3)))
__device__ __forceinline__ unsigned xb_ld(unsigned* p)              { return __hip_atomic_load(p, __ATOMIC_RELAXED, __HIP_MEMORY_SCOPE_AGENT); }
__device__ __forceinline__ unsigned xb_add(unsigned* p, unsigned v) { return __hip_atomic_fetch_add(p, v, __ATOMIC_RELAXED, __HIP_MEMORY_SCOPE_AGENT); }
__device__ __forceinline__ unsigned xb_xcc_id() { return (unsigned)__builtin_amdgcn_s_getreg((3 << 11) | 20) & 0xFu; }
#define XB_SPIN(cond, bar) do { unsigned _sp = 0; while (cond) { __builtin_amdgcn_s_sleep(1); \
    if ((++_sp & 255u) == 0u) { if (xb_ld(&(bar)[XB_TMO])) break; if (_sp > XB_SPIN_CAP) { atomicAdd(&(bar)[XB_TMO], 1u); break; } } } } while (0)
struct XcdBarrier { unsigned* bar; unsigned x; volatile LAS unsigned* st; };
__device__ __forceinline__ XcdBarrier xcd_barrier_post(unsigned* bar, volatile LAS unsigned* st) {
  XcdBarrier b; b.bar = bar; b.x = xb_xcc_id(); b.st = st;
  if (threadIdx.x == 0) (void)xb_add(&bar[XB_XCNT(b.x)], 1u);
  return b;
}
__device__ __forceinline__ void xcd_barrier_complete(unsigned* bar, unsigned x, unsigned& nloc, unsigned& nx) {
  const unsigned G = gridDim.x * gridDim.y * gridDim.z;
  unsigned sum, cnt, mine, sp = 0u;
  for (;;) {
    sum = 0u; cnt = 0u; mine = 0u;
#pragma unroll
    for (unsigned j = 0; j < 16; ++j) { const unsigned c = xb_ld(&bar[XB_XCNT(j)]); sum += c; cnt += (c > 0u) ? 1u : 0u; mine = (j == x) ? c : mine; }
    if (sum == G) break;
    __builtin_amdgcn_s_sleep(1);
    if ((++sp & 255u) == 0u) { if (xb_ld(&bar[XB_TMO])) break; if (sp > XB_SPIN_CAP) { atomicAdd(&bar[XB_TMO], 1u); break; } }
  }
  nloc = mine > 0u ? mine : 1u; nx = cnt > 0u ? cnt : 1u;
}
__device__ __forceinline__ void xcd_barrier(const XcdBarrier& b0) {
  XcdBarrier b; b.bar = b0.bar; b.st = b0.st; b.x = (unsigned)__builtin_amdgcn_readfirstlane((int)xb_xcc_id());
  asm volatile("s_waitcnt vmcnt(0)" ::: "memory");
  __syncthreads();
  if (threadIdx.x == 0) {
    unsigned* bar = b.bar;
    __builtin_amdgcn_s_waitcnt(0);
    unsigned nloc = b.st[0], nx = b.st[1];
    if (nloc == 0u) { xcd_barrier_complete(bar, b.x, nloc, nx); b.st[0] = nloc; b.st[1] = nx; }
    const unsigned old = xb_add(&bar[XB_XSUB(b.x)], 1u);
    const unsigned gen = old / nloc;
    if (old + 1u == (gen + 1u) * nloc) {
      __builtin_amdgcn_fence(__ATOMIC_RELEASE, "agent");
      asm volatile("s_waitcnt vmcnt(0)" ::: "memory");
      const unsigned og = xb_add(&bar[XB_TOP], 1u);
      const unsigned tg = og / nx;
      if (og + 1u == (tg + 1u) * nx) xb_add(&bar[XB_TOPGEN], 1u);
      else XB_SPIN(xb_ld(&bar[XB_TOPGEN]) == tg, bar);
      __builtin_amdgcn_fence(__ATOMIC_ACQUIRE, "agent");
      xb_add(&bar[XB_XGEN(b.x)], 1u);
      asm volatile("s_waitcnt vmcnt(0)" ::: "memory");
    } else {
      XB_SPIN(xb_ld(&bar[XB_XGEN(b.x)]) == gen, bar);
      __builtin_amdgcn_fence(__ATOMIC_ACQUIRE, "agent");
      asm volatile("s_waitcnt vmcnt(0)" ::: "memory");
    }
  }
  __syncthreads();
}

__device__ __forceinline__ void norm_job(const P& p, int job, const float* gvec, const float* modl, int shift_idx) {
  const int t = otid();
  const int row = job * 4 + (t >> 6), lane = t & 63;
  const int grp = row < NCTX ? 0 : 1 + ((row - NCTX) >> 12);
  const float* modv = modl + grp * 6144;
  const float* x = p.out + (long)row * 1024;
  u16* H = (u16*)(p.ws + WS_MIX) + (long)row * 1024;
  float4 v[4];
  float ss = 0.f;
#pragma unroll
  for (int i = 0; i < 4; ++i) {
    v[i] = *(const float4*)(x + (i * 64 + lane) * 4);
    ss += v[i].x * v[i].x + v[i].y * v[i].y + v[i].z * v[i].z + v[i].w * v[i].w;
  }
  ss = wave_sum(ss);
  const float r = rsqrtf(ss * (1.f / 1024.f) + 1e-6f);
#pragma unroll
  for (int i = 0; i < 4; ++i) {
    const int k = (i * 64 + lane) * 4;
    const float4 g = *(const float4*)(gvec + k);
    const float4 sc = *(const float4*)(modv + (shift_idx + 1) * 1024 + k);
    const float4 sh = *(const float4*)(modv + shift_idx * 1024 + k);
    u32x2 o;
    o.x = pack2(v[i].x * r * g.x * (1.f + sc.x) + sh.x, v[i].y * r * g.y * (1.f + sc.y) + sh.y);
    o.y = pack2(v[i].z * r * g.z * (1.f + sc.z) + sh.z, v[i].w * r * g.w * (1.f + sc.w) + sh.w);
    *(u32x2*)(H + k) = o;
  }
}

__device__ __forceinline__ void final_job(const P& p, int job) {
  const int t = otid();
  const int row = job * 4 + (t >> 6), lane = t & 63;
  float* x = p.out + (long)row * 1024;
  float4 v[4];
  float ss = 0.f;
#pragma unroll
  for (int i = 0; i < 4; ++i) {
    v[i] = *(const float4*)(x + (i * 64 + lane) * 4);
    ss += v[i].x * v[i].x + v[i].y * v[i].y + v[i].z * v[i].z + v[i].w * v[i].w;
  }
  ss = wave_sum(ss);
  const float r = rsqrtf(ss * (1.f / 1024.f) + 1e-6f);
#pragma unroll
  for (int i = 0; i < 4; ++i) {
    const float4 g = *(const float4*)(p.in[13] + (i * 64 + lane) * 4);
    float4 o;
    o.x = v[i].x * r * g.x; o.y = v[i].y * r * g.y; o.z = v[i].z * r * g.z; o.w = v[i].w * r * g.w;
    *(float4*)(x + (i * 64 + lane) * 4) = o;
  }
}

#ifndef PHMASK
#define PHMASK 0xffff
#endif
#define PHON(k) (((PHMASK) >> (k)) & 1)
#ifndef DUPMASK
#define DUPMASK 0
#endif
#define NREP(k) ((((DUPMASK) >> (k)) & 1) ? 2 : 1)
__global__ void __launch_bounds__(256, 2) fwd_megakernel(P p) {
  cg::grid_group grid = cg::this_grid();
  __shared__ __attribute__((aligned(16))) char smem[SMEM_BYTES];
  __shared__ uint4 xb_words;
  if (threadIdx.x == 0) xb_words = make_uint4(0u, 0u, 0u, 0u);
  __syncthreads();
  XcdBarrier xb = xcd_barrier_post((unsigned*)(p.ws + WS_BAR), (volatile LAS unsigned*)&xb_words);
  const int nb = gridDim.x, bid0 = blockIdx.x;
  int bid = bid0;
  asm volatile("" : "+s"(bid));
  float* mod = (float*)(p.ws + WS_MOD);
  u16* big = (u16*)(p.ws + WS_BIG);
  u16* mix = (u16*)(p.ws + WS_MIX);

  for (int rep = 0; rep < NREP(0); ++rep)
  for (int job = bid; job < 384 + N_CONV_JOBS + 3072 + 4096 + 128; job += nb) {
    if (!PHON(0)) break;
    if (job >= 384 + N_CONV_JOBS + 3072 + 4096) loracvt_job(p, job - (384 + N_CONV_JOBS + 3072 + 4096));
    else if (job < 384) adaln_job(p, smem, job);
    else if (job < 384 + N_CONV_JOBS) conv_job(p, smem, job - 384);
    else if (job < 384 + N_CONV_JOBS + 3072) cachecvt_job(p, job - 384 - N_CONV_JOBS);
    else xcopy_job(p, job - 384 - N_CONV_JOBS - 3072);
  }
  if (p.ws == nullptr) grid.sync();
  xcd_barrier(xb);

  for (int l = 0; l < 4; ++l) {
    int bid = bid0;
    asm volatile("" : "+s"(bid));
    const float* modl = mod + l * 3 * 6144;
    const int sub = l >> 1;
    const bool even = (l & 1) == 0;
    for (int lj = bid >> 3; lj < 512; lj += (nb >> 3)) norm_job(p, (bid & 7) * 512 + lj, p.in[11] + l * 1024, modl, 0);
    xcd_barrier(xb);
    if (even) {
      if (PHON(1)) gemm_phase<0, 0, 256>(p, smem, mix, 1024, (const u16*)(p.ws + WS_WIN) + (long)sub * 3328 * 1024, 3328,
                                    nullptr, modl, 0, 0, sub, big);
    } else {
      if (PHON(7)) gemm_phase<0, 1, 128>(p, smem, mix, 1024, (const u16*)(p.ws + WS_WQKV) + (long)sub * 3072 * 1024, 3072,
                                    nullptr, modl, 0, 0, sub, big);
    }
    xcd_barrier(xb);
    if (even) {
      const int e = sub;
      for (int rep = 0; rep < NREP(2); ++rep)
      for (int job = bid; job < 3072; job += nb) {
        if (job < 1024) { if (PHON(2)) rwkv_scan_unit(p, smem, e, job); }
        else if (!PHON(3)) {}
        else if (job < 2048) {
          const int j = job - 1024;
          const int b = j >> 9, h = (j >> 6) & 7, qi = j & 63;
          int r0 = qi - 4; r0 = r0 < 0 ? 0 : (r0 > 56 ? 56 : r0);
          const long tq = NCTX + b * 4096 + qi * 64, tk = NCTX + b * 4096 + r0 * 64;
          attn_job<1, 64, true>(smem, big + tq * 3328 + h * 64, 3328,
                                (const u16*)(p.ws + WS_CNK) + (long)(b * 2 + e) * 512 * 512 + h * 64,
                                (const u16*)(p.ws + WS_CNV) + (long)(b * 2 + e) * 512 * 512 + h * 64, 512, 512,
                                big + tk * 3328 + 512 + h * 64, big + tk * 3328 + 1024 + h * 64, 3328, 512,
                                p.in[16] + (long)(e * 8 + h) * 15 * 31, qi, r0, 0.f, 0.f, nullptr,
                                mix + tq * 1024 + h * 64, 1024);
        } else {
          const int j = job - 2048;
          const int b = j >> 5, h = (j >> 2) & 7, qb = j & 3;
          const long tq = b * 256 + qb * 64, tk = b * 256;
          attn_job<1, 64, false>(smem, big + tq * 3328 + h * 64, 3328,
                                 big + tk * 3328 + 512 + h * 64, big + tk * 3328 + 1024 + h * 64, 3328, 256,
                                 nullptr, nullptr, 0, 0, nullptr, 0, 0, 0.f, 0.f, nullptr,
                                 mix + tq * 1024 + h * 64, 1024);
        }
      }
      xcd_barrier(xb);
      for (int ph = 0; ph < 2; ++ph) {
        if (ph == 0 && PHON(4)) {
          if (nb > 256) {
            if (bid < 128) rwkv_e3_job(p, smem, e, bid + 2048);
            else for (int job = bid - 128; job < 2048; job += nb - 128) rwkv_e3_job(p, smem, e, job);
          } else {
            for (int job = bid; job < 2176; job += nb) rwkv_e3_job(p, smem, e, job < 128 ? job + 2048 : job - 128);
          }
        }
        if (PHON(5))
          for (int u = bid; u < 512; u += nb) rwkv_e4_unit(p, smem, e, (ph == 0 ? 0 : 512) + u);
        if (ph == 0) xcd_barrier(xb);
      }
    } else {
      const int o = sub;
      const float lam_init = 0.8f - 0.6f * __expf(-0.3f * (float)l);
      float d0 = 0.f, d1 = 0.f;
      for (int i = 0; i < 64; ++i) {
        d0 += p.in[30][o * 128 + i] * p.in[31][o * 128 + i];
        d1 += p.in[30][o * 128 + 64 + i] * p.in[31][o * 128 + 64 + i];
      }
      const float lam = __expf(d0) - __expf(d1) + lam_init;
      for (int rep = 0; rep < NREP(8); ++rep)
      if (PHON(8)) for (int job = bid; job < 2048; job += nb) {
        long tq, tk; int h, n0, n1; const u16 *k0, *v0; int st0;
        if (job < 1024) {
          const int x = job & 7, lj = job >> 3;
          const int pair = x + 8 * (lj >> 6), qb = lj & 63;
          const int b = pair >> 3; h = pair & 7;
          tq = NCTX + b * 4096 + qb * 64; tk = NCTX + b * 4096;
          k0 = (const u16*)(p.ws + WS_CDK) + (long)(b * 2 + o) * 512 * 1024 + h * 128;
          v0 = (const u16*)(p.ws + WS_CDV) + (long)(b * 2 + o) * 512 * 1024 + h * 128;
          st0 = 1024; n0 = 512; n1 = 4096;
        } else {
          const int j = job - 1024;
          const int b = j >> 5, qb = j & 3; h = (j >> 2) & 7;
          tq = b * 256 + qb * 64; tk = b * 256;
          k0 = big + tk * 3072 + 1024 + h * 128; v0 = big + tk * 3072 + 2048 + h * 128;
          st0 = 3072; n0 = 256; n1 = 0;
        }
        attn_job<2, 128, false>(smem, big + tq * 3072 + h * 128, 3072, k0, v0, st0, n0,
                                big + tk * 3072 + 1024 + h * 128, big + tk * 3072 + 2048 + h * 128, 3072, n1,
                                nullptr, 0, 0, lam, 1.f - lam_init, p.in[32] + o * 128,
                                mix + tq * 1024 + h * 128, 1024);
      }
    }
    xcd_barrier(xb);
    for (int g = 0; g < 2; ++g) {
      if (g == 1) {
        for (int lj = bid >> 3; lj < 512; lj += (nb >> 3)) norm_job(p, (bid & 7) * 512 + lj, p.in[12] + l * 1024, modl, 3);
        xcd_barrier(xb);
        for (int rep = 0; rep < NREP(9); ++rep)
        if (PHON(9)) gemm_phase<0, 3, 256>(p, smem, mix, 1024, (const u16*)(p.ws + WS_W13) + (long)l * 5632 * 1024, 5632,
                                      nullptr, modl, 3, 0, 0, big);
        xcd_barrier(xb);
      }
      const u16* A2 = g == 0 ? mix : big;
      const int K2 = g == 0 ? 1024 : 2816;
      const u16* B2 = g == 0 ? (even ? (const u16*)(p.ws + WS_WOE) + (long)sub * 1024 * 1024 : (const u16*)(p.ws + WS_WOD) + (long)sub * 1024 * 1024)
                             : (const u16*)(p.ws + WS_W2) + (long)l * 1024 * 2816;
      if (PHON(6)) gemm_phase<0, 2, 256>(p, smem, A2, K2, B2, 1024, nullptr, modl, 0, g == 0 ? 2 : 5, 0, nullptr);
      xcd_barrier(xb);
    }
  }
  if (PHON(10)) for (int lj = bid >> 3; lj < 512; lj += (nb >> 3)) final_job(p, (bid & 7) * 512 + lj);
}

extern "C" void kernel_launch(void* const* d_in, const int* in_sizes, int n_in, void* d_out, int out_size,
                              void* d_ws, size_t ws_size, hipStream_t stream) {
  static int grid_blocks = 0;
  if (!grid_blocks) {
    int dev = 0, cus = 0, per_cu = 0;
    (void)hipGetDevice(&dev);
    (void)hipDeviceGetAttribute(&cus, hipDeviceAttributeMultiprocessorCount, dev);
    (void)hipOccupancyMaxActiveBlocksPerMultiprocessor(&per_cu, fwd_megakernel, 256, 0);
    (void)per_cu;
    grid_blocks = cus * 2;
  }
  if (ws_size < (size_t)WS_TOTAL) { fprintf(stderr, "workspace too small: %zu < %ld\n", ws_size, (long)WS_END); return; }
  P p{};
  for (int i = 0; i < 36; ++i) p.in[i] = (const float*)d_in[i];
  p.out = (float*)d_out;
  p.ws = (char*)d_ws;
  (void)hipMemsetAsync((char*)d_ws + WS_BAR, 0, XCD_BAR_WORDS * 4, stream);
  void* args[] = {&p};
  hipError_t e = hipLaunchCooperativeKernel((void*)fwd_megakernel, dim3(grid_blocks), dim3(256), args, 0, stream);
  if (e != hipSuccess) fprintf(stderr, "cooperative launch failed: %s (grid %d)\n", hipGetErrorString(e), grid_blocks);
}
```

```cpp
#include <hip/hip_runtime.h>
#include <hip/hip_cooperative_groups.h>
#include <cstdio>
namespace cg = cooperative_groups;

typedef unsigned short u16;
typedef __attribute__((ext_vector_type(8))) short bf16x8;
typedef __attribute__((ext_vector_type(4))) float f32x4;
typedef __attribute__((ext_vector_type(4))) unsigned u32x4;
typedef __attribute__((ext_vector_type(2))) unsigned u32x2;

#define NTOK 16384
#define NCTX 8192
#define OUT_NAK 16777216L
#define OUT_NAV 25165824L
#define OUT_ST  33554432L
#define OUT_DK  37748736L
#define OUT_DV  54525952L
#define WS_WIN   0L
#define WS_WOE   13631488L
#define WS_WQKV  17825792L
#define WS_WOD   30408704L
#define WS_W13   34603008L
#define WS_W2    80740352L
#define WS_CNK   103809024L
#define WS_CNV   105906176L
#define WS_CDK   108003328L
#define WS_CDV   112197632L
#define WS_MOD   116391936L
#define WS_ROWSS 116686848L
#define WS_RKB   117735424L
#define WS_MIX   118784000L
#define WS_BIG   152338432L
#define WS_TB    261390336L
#define WS_QT    328499200L
#define WS_END   395608064L
#define WS_BAR   395624448L
#define WS_WT    395640832L
#define WS_TOTAL 396165120L

struct P {
  const float* in[36];
  float* out;
  char* ws;
};

#define SMEM_BYTES 61440

typedef __attribute__((ext_vector_type(2))) float f32x2_t;
typedef __attribute__((ext_vector_type(2))) __bf16 bf16x2_t;
__device__ __forceinline__ u16 f2bf(float f) { return __builtin_bit_cast(u16, (__bf16)f); }
__device__ __forceinline__ float bf2f(u16 h) { return __uint_as_float(((unsigned)h) << 16); }
__device__ __forceinline__ unsigned pack2(float a, float b) {
  const f32x2_t v = {a, b};
  return __builtin_bit_cast(unsigned, __builtin_convertvector(v, bf16x2_t));
}
template <int CTRL>
__device__ __forceinline__ float dpp_mov(float v) {
  return __int_as_float(__builtin_amdgcn_update_dpp(0, __float_as_int(v), CTRL, 0xf, 0xf, false));
}
__device__ __forceinline__ float g16_sum(float v) {
  v += dpp_mov<0xB1>(v);
  v += dpp_mov<0x4E>(v);
  v += dpp_mov<0x124>(v);
  v += dpp_mov<0x128>(v);
  return v;
}
__device__ __forceinline__ float g16_max(float v) {
  v = fmaxf(v, dpp_mov<0xB1>(v));
  v = fmaxf(v, dpp_mov<0x4E>(v));
  v = fmaxf(v, dpp_mov<0x124>(v));
  v = fmaxf(v, dpp_mov<0x128>(v));
  return v;
}
__device__ __forceinline__ float wave_sum(float v) {
  v = g16_sum(v);
  const float r0 = __int_as_float(__builtin_amdgcn_readlane(__float_as_int(v), 0));
  const float r1 = __int_as_float(__builtin_amdgcn_readlane(__float_as_int(v), 16));
  const float r2 = __int_as_float(__builtin_amdgcn_readlane(__float_as_int(v), 32));
  const float r3 = __int_as_float(__builtin_amdgcn_readlane(__float_as_int(v), 48));
  return (r0 + r1) + (r2 + r3);
}
__device__ __forceinline__ int otid() { int t = threadIdx.x; asm volatile("" : "+v"(t)); return t; }
__device__ __forceinline__ float sigmoidf_(float x) { return __builtin_amdgcn_rcpf(1.f + __expf(-x)); }

struct ConvT { const float* src; u16* dst; int K, N, mode, kt, nt; };
__device__ __forceinline__ ConvT conv_params(const P& p, int job) {
  ConvT c;
  if (job < 1664) {
    int e = job / 832, r = job % 832;
    c.src = p.in[14] + (long)e * 1024 * 3328; c.K = 1024; c.N = 3328; c.dst = (u16*)(p.ws + WS_WIN) + (long)e * 3328 * 1024; c.mode = 0; c.kt = r / 52; c.nt = r % 52;
    return c;
  }
  job -= 1664;
  if (job < 512) {
    int e = job / 256, r = job % 256;
    c.src = p.in[15] + (long)e * 1024 * 1024; c.K = 1024; c.N = 1024; c.dst = (u16*)(p.ws + WS_WOE) + (long)e * 1024 * 1024; c.mode = 0; c.kt = r / 16; c.nt = r % 16;
    return c;
  }
  job -= 512;
  if (job < 1536) {
    int e = job / 768, r = job % 768;
    c.src = p.in[28] + (long)e * 1024 * 3072; c.K = 1024; c.N = 3072; c.dst = (u16*)(p.ws + WS_WQKV) + (long)e * 3072 * 1024; c.mode = 0; c.kt = r / 48; c.nt = r % 48;
    return c;
  }
  job -= 1536;
  if (job < 512) {
    int e = job / 256, r = job % 256;
    c.src = p.in[29] + (long)e * 1024 * 1024; c.K = 1024; c.N = 1024; c.dst = (u16*)(p.ws + WS_WOD) + (long)e * 1024 * 1024; c.mode = 0; c.kt = r / 16; c.nt = r % 16;
    return c;
  }
  job -= 512;
  if (job < 2816) {
    int l = job / 704, r = job % 704;
    c.src = p.in[33] + (long)l * 1024 * 2816; c.K = 1024; c.N = 2816; c.dst = (u16*)(p.ws + WS_W13) + (long)l * 5632 * 1024; c.mode = 1; c.kt = r / 44; c.nt = r % 44;
    return c;
  }
  job -= 2816;
  if (job < 2816) {
    int l = job / 704, r = job % 704;
    c.src = p.in[34] + (long)l * 1024 * 2816; c.K = 1024; c.N = 2816; c.dst = (u16*)(p.ws + WS_W13) + (long)l * 5632 * 1024; c.mode = 2; c.kt = r / 44; c.nt = r % 44;
    return c;
  }
  job -= 2816;
  {
    int l = job / 704, r = job % 704;
    c.src = p.in[35] + (long)l * 2816 * 1024; c.K = 2816; c.N = 1024; c.dst = (u16*)(p.ws + WS_W2) + (long)l * 1024 * 2816; c.mode = 0; c.kt = r / 16; c.nt = r % 16;
  }
  return c;
}
__device__ __forceinline__ void conv_job(const P& p, char* smem, int job2) {
  const int tid = otid();
  float* tile = (float*)smem;
  ConvT c[2];
  c[0] = conv_params(p, 2 * job2);
  c[1] = conv_params(p, 2 * job2 + 1);
  float v[2][16];
#pragma unroll
  for (int t = 0; t < 2; ++t)
#pragma unroll
    for (int i = 0; i < 16; ++i) {
      const int kl = (tid >> 6) + 4 * i, nl = tid & 63;
      v[t][i] = c[t].src[(long)(c[t].kt * 64 + kl) * c[t].N + c[t].nt * 64 + nl];
    }
  __syncthreads();
#pragma unroll
  for (int t = 0; t < 2; ++t)
#pragma unroll
    for (int i = 0; i < 16; ++i) {
      const int kl = (tid >> 6) + 4 * i, nl = tid & 63;
      tile[t * 4160 + kl * 65 + nl] = v[t][i];
    }
  __syncthreads();
#pragma unroll
  for (int t = 0; t < 2; ++t)
#pragma unroll
    for (int i = 0; i < 2; ++i) {
      const int task = tid + 256 * i;
      const int kg = task & 7, nl = task >> 3;
      const int n = c[t].nt * 64 + nl;
      int nd = n;
      if (c[t].mode == 1) nd = (n >> 5) * 64 + (n & 31);
      else if (c[t].mode == 2) nd = (n >> 5) * 64 + 32 + (n & 31);
      const float* tt = tile + t * 4160;
      u32x4 o;
      o.x = pack2(tt[(kg * 8 + 0) * 65 + nl], tt[(kg * 8 + 1) * 65 + nl]);
      o.y = pack2(tt[(kg * 8 + 2) * 65 + nl], tt[(kg * 8 + 3) * 65 + nl]);
      o.z = pack2(tt[(kg * 8 + 4) * 65 + nl], tt[(kg * 8 + 5) * 65 + nl]);
      o.w = pack2(tt[(kg * 8 + 6) * 65 + nl], tt[(kg * 8 + 7) * 65 + nl]);
      *(u32x4*)(c[t].dst + (long)nd * c[t].K + c[t].kt * 64 + kg * 8) = o;
    }
}
#define N_CONV_JOBS 6336

__device__ __forceinline__ void adaln_job(const P& p, char* smem, int job) {
  const int l = job / 96, cgp = job % 96;
  const int tid = otid();
  float* sil = (float*)smem;
  float* red = sil + 3072;
  __syncthreads();
  for (int i = tid; i < 3072; i += 256) {
    int v = i >> 10, k = i & 1023;
    float c = (v == 0) ? p.in[8][k] : p.in[2][(v - 1) * 1024 + k];
    sil[i] = c * sigmoidf_(c);
  }
  __syncthreads();
  const int kq = tid >> 6, cl = tid & 63;
  const float* w = p.in[9] + (long)l * 1024 * 6144 + cgp * 64 + cl;
  float a0 = 0.f, a1 = 0.f, a2 = 0.f;
#pragma unroll 16
  for (int k = kq * 256; k < kq * 256 + 256; ++k) {
    float wv = w[(long)k * 6144];
    a0 += sil[k] * wv; a1 += sil[1024 + k] * wv; a2 += sil[2048 + k] * wv;
  }
  red[(kq * 3 + 0) * 64 + cl] = a0; red[(kq * 3 + 1) * 64 + cl] = a1; red[(kq * 3 + 2) * 64 + cl] = a2;
  __syncthreads();
  if (tid < 192) {
    int v = tid >> 6;
    float s = red[(0 * 3 + v) * 64 + cl] + red[(1 * 3 + v) * 64 + cl] + red[(2 * 3 + v) * 64 + cl] + red[(3 * 3 + v) * 64 + cl];
    s += p.in[10][l * 6144 + cgp * 64 + cl];
    ((float*)(p.ws + WS_MOD))[(l * 3 + v) * 6144 + cgp * 64 + cl] = s;
  }
}

__device__ __forceinline__ void cachecvt_job(const P& p, int job) {
  const float* src; u16* dst; int j;
  if (job < 512) { src = p.in[3]; dst = (u16*)(p.ws + WS_CNK); j = job; }
  else if (job < 1024) { src = p.in[4]; dst = (u16*)(p.ws + WS_CNV); j = job - 512; }
  else if (job < 2048) { src = p.in[6]; dst = (u16*)(p.ws + WS_CDK); j = job - 1024; }
  else { src = p.in[7]; dst = (u16*)(p.ws + WS_CDV); j = job - 2048; }
  long off = (long)j * 2048 + otid() * 8;
  float4 a = *(const float4*)(src + off), b = *(const float4*)(src + off + 4);
  uint4 v; v.x = pack2(a.x, a.y); v.y = pack2(a.z, a.w); v.z = pack2(b.x, b.y); v.w = pack2(b.z, b.w);
  *(uint4*)(dst + off) = v;
}


__device__ __forceinline__ void loracvt_job(const P& p, int job) {
  u16* dst = (u16*)(p.ws + WS_WT);
#pragma unroll
  for (int i = 0; i < 8; ++i) {
    const int g = job * 2048 + i * 256 + otid();
    const int k = g & 63, n = (g >> 6) & 511, mat = (g >> 15) & 1, ed = g >> 16;
    const float* src = mat ? p.in[21] : p.in[19];
    dst[g] = f2bf(src[((long)ed * 64 + k) * 512 + n]);
  }
}

__device__ __forceinline__ void xcopy_job(const P& p, int job) {
  const int row = job * 4 + (otid() >> 6), lane = otid() & 63;
  const float* src = (row < NCTX) ? p.in[0] + (long)row * 1024 : p.in[1] + (long)(row - NCTX) * 1024;
  float* dst = p.out + (long)row * 1024;
  float ss = 0.f;
#pragma unroll
  for (int i = 0; i < 4; ++i) {
    float4 v = *(const float4*)(src + (i * 64 + lane) * 4);
    ss += v.x * v.x + v.y * v.y + v.z * v.z + v.w * v.w;
    *(float4*)(dst + (i * 64 + lane) * 4) = v;
  }
}

template <int AM, int EPI, int BM>
__device__ __forceinline__ void gemm_phase(const P& p, char* smem, const void* Aptr, int K, const u16* Bt, int N,
                           const float* gvec, const float* modl, int shift_idx, int gate_idx, int sub, u16* dst) {
  const int tid = otid(), lane = tid & 63, wave = tid >> 6, wm = wave >> 1, wn = wave & 1;
  const int quad = lane >> 4, l16 = lane & 15;
  u16* As = (u16*)smem;
  u16* Bs = As + BM * 80;
  constexpr int MI = BM / 32;
  const int NT = N >> 7, ntiles = (16384 / BM) * NT, ntk = K >> 6;
  float* X = p.out;
  const float* rowss = (const float*)(p.ws + WS_ROWSS);
  const int MPX = (16384 / BM) / 8, LB = gridDim.x >> 3, xcd = blockIdx.x & 7;
  (void)ntiles;
  for (int lt = blockIdx.x >> 3; lt < MPX * NT; lt += LB) {
    const int mt = xcd * MPX + lt % MPX, nt = lt / MPX;
    const int row0 = mt * BM, col0 = nt * 128;
    const int grp = row0 < NCTX ? 0 : 1 + ((row0 - NCTX) >> 12);
    const float* modv = modl + grp * 6144;
    f32x4 acc[MI][4];
#pragma unroll
    for (int i = 0; i < MI; ++i)
#pragma unroll
      for (int j = 0; j < 4; ++j) acc[i][j] = (f32x4){0.f, 0.f, 0.f, 0.f};
    f32x4 ar[8]; u32x4 ab[MI]; u32x4 bb[4]; float rinv[8];
    if (AM == 1) {
#pragma unroll
      for (int i = 0; i < 8; ++i) {
        const float4* rp = (const float4*)(rowss + (long)(row0 + (tid >> 4) + 16 * i) * 16);
        float4 s0 = rp[0], s1 = rp[1], s2 = rp[2], s3 = rp[3];
        float s = (s0.x + s0.y + s0.z + s0.w) + (s1.x + s1.y + s1.z + s1.w) + (s2.x + s2.y + s2.z + s2.w) + (s3.x + s3.y + s3.z + s3.w);
        rinv[i] = rsqrtf(s * (1.f / 1024.f) + 1e-6f);
      }
    }
    if (AM == 1) {
#pragma unroll
      for (int i = 0; i < 8; ++i)
        ar[i] = *(const f32x4*)((const float*)Aptr + (long)(row0 + (tid >> 4) + 16 * i) * 1024 + (tid & 15) * 4);
    } else {
#pragma unroll
      for (int i = 0; i < MI; ++i)
        ab[i] = *(const u32x4*)((const u16*)Aptr + (long)(row0 + (tid >> 3) + 32 * i) * K + (tid & 7) * 8);
    }
#pragma unroll
    for (int i = 0; i < 4; ++i)
      bb[i] = *(const u32x4*)(Bt + (long)(col0 + (tid >> 3) + 32 * i) * K + (tid & 7) * 8);

    for (int kt = 0; kt < ntk; ++kt) {
      __syncthreads();
      if (AM == 1) {
        const int k = kt * 64 + (tid & 15) * 4;
        float4 g = *(const float4*)(gvec + k);
        float4 sc = *(const float4*)(modv + (shift_idx + 1) * 1024 + k);
        float4 sh = *(const float4*)(modv + shift_idx * 1024 + k);
        g.x *= (1.f + sc.x); g.y *= (1.f + sc.y); g.z *= (1.f + sc.z); g.w *= (1.f + sc.w);
#pragma unroll
        for (int i = 0; i < 8; ++i) {
          float r = rinv[i];
          u32x2 v;
          v.x = pack2(ar[i].x * r * g.x + sh.x, ar[i].y * r * g.y + sh.y);
          v.y = pack2(ar[i].z * r * g.z + sh.z, ar[i].w * r * g.w + sh.w);
          *(u32x2*)(As + ((tid >> 4) + 16 * i) * 80 + (tid & 15) * 4) = v;
        }
      } else {
#pragma unroll
        for (int i = 0; i < MI; ++i) *(u32x4*)(As + ((tid >> 3) + 32 * i) * 80 + (tid & 7) * 8) = ab[i];
      }
#pragma unroll
      for (int i = 0; i < 4; ++i) *(u32x4*)(Bs + ((tid >> 3) + 32 * i) * 80 + (tid & 7) * 8) = bb[i];
      __syncthreads();
      if (kt + 1 < ntk) {
        const int kn = (kt + 1) * 64;
        if (AM == 1) {
#pragma unroll
          for (int i = 0; i < 8; ++i)
            ar[i] = *(const f32x4*)((const float*)Aptr + (long)(row0 + (tid >> 4) + 16 * i) * 1024 + kn + (tid & 15) * 4);
        } else {
#pragma unroll
          for (int i = 0; i < MI; ++i)
            ab[i] = *(const u32x4*)((const u16*)Aptr + (long)(row0 + (tid >> 3) + 32 * i) * K + kn + (tid & 7) * 8);
        }
#pragma unroll
        for (int i = 0; i < 4; ++i)
          bb[i] = *(const u32x4*)(Bt + (long)(col0 + (tid >> 3) + 32 * i) * K + kn + (tid & 7) * 8);
      }
      __builtin_amdgcn_sched_barrier(0);
#pragma unroll
      for (int ks = 0; ks < 2; ++ks) {
        bf16x8 b[4];
#pragma unroll
        for (int i = 0; i < 4; ++i) b[i] = *(const bf16x8*)(Bs + (wn * 64 + i * 16 + l16) * 80 + ks * 32 + quad * 8);
        bf16x8 af[3];
        af[0] = *(const bf16x8*)(As + (wm * (BM / 2) + 0 * 16 + l16) * 80 + ks * 32 + quad * 8);
        af[1] = *(const bf16x8*)(As + (wm * (BM / 2) + 1 * 16 + l16) * 80 + ks * 32 + quad * 8);
#pragma unroll
        for (int i = 0; i < MI; ++i) {
          if (i + 2 < MI) af[(i + 2) % 3] = *(const bf16x8*)(As + (wm * (BM / 2) + (i + 2) * 16 + l16) * 80 + ks * 32 + quad * 8);
#pragma unroll
          for (int j = 0; j < 4; ++j) acc[i][j] = __builtin_amdgcn_mfma_f32_16x16x32_bf16(b[j], af[i % 3], acc[i][j], 0, 0, 0);
        }
      }
    }
    const int cw = col0 + wn * 64;
    if (EPI == 0) {
      const int e = sub;
#pragma unroll
      for (int mi = 0; mi < MI; ++mi) {
        const int row = row0 + wm * (BM / 2) + mi * 16 + l16;
#pragma unroll
        for (int ni = 0; ni < 4; ++ni) {
          const int col = cw + ni * 16 + quad * 4;
          const f32x4 v = acc[mi][ni];
          u32x2 o; o.x = pack2(v[0], v[1]); o.y = pack2(v[2], v[3]);
          *(u32x2*)(dst + (long)row * 3328 + col) = o;
          if (row < NCTX && cw >= 512 && cw < 1536) {
            const int b = row >> 8, t = row & 255;
            if (cw < 1024) *(f32x4*)(p.out + OUT_NAK + ((long)((b * 2 + e) * 256 + t)) * 512 + col - 512) = v;
            else *(f32x4*)(p.out + OUT_NAV + ((long)((b * 2 + e) * 256 + t)) * 512 + col - 1024) = v;
          }
        }
      }
    } else if (EPI == 1) {
      const int o = sub;
      float inv[4];
#pragma unroll
      for (int j = 0; j < 4; ++j) inv[j] = exp2f(-(float)(quad * 4 + j) * (13.287712379549449f / 16.f));
#pragma unroll
      for (int mi = 0; mi < MI; ++mi) {
        const int row = row0 + wm * (BM / 2) + mi * 16 + l16;
        f32x4 v0 = acc[mi][0], v1 = acc[mi][1], v2 = acc[mi][2], v3 = acc[mi][3];
        if (row >= NCTX && cw < 2048) {
          const int tp = (row - NCTX) & 4095;
#pragma unroll
          for (int j = 0; j < 4; ++j) {
            const float a0 = (float)(tp >> 6) * inv[j], a1 = (float)(tp & 63) * inv[j];
            const float c0 = __cosf(a0), s0 = __sinf(a0), c1 = __cosf(a1), s1 = __sinf(a1);
            const float n0 = v0[j] * c0 - v1[j] * s0, n1 = v0[j] * s0 + v1[j] * c0;
            const float n2 = v2[j] * c1 - v3[j] * s1, n3 = v2[j] * s1 + v3[j] * c1;
            v0[j] = n0; v1[j] = n1; v2[j] = n2; v3[j] = n3;
          }
        }
        f32x4 vv[4] = {v0, v1, v2, v3};
#pragma unroll
        for (int ni = 0; ni < 4; ++ni) {
          const int col = cw + ni * 16 + quad * 4;
          u32x2 ob; ob.x = pack2(vv[ni][0], vv[ni][1]); ob.y = pack2(vv[ni][2], vv[ni][3]);
          *(u32x2*)(dst + (long)row * 3072 + col) = ob;
          if (row < NCTX && cw >= 1024) {
            const int b = row >> 8, t = row & 255;
            if (cw < 2048) *(f32x4*)(p.out + OUT_DK + ((long)((b * 2 + o) * 256 + t)) * 1024 + col - 1024) = vv[ni];
            else *(f32x4*)(p.out + OUT_DV + ((long)((b * 2 + o) * 256 + t)) * 1024 + col - 2048) = vv[ni];
          }
        }
      }
    } else if (EPI == 2) {
      f32x4 gt[4];
#pragma unroll
      for (int ni = 0; ni < 4; ++ni) gt[ni] = *(const f32x4*)(modv + gate_idx * 1024 + cw + ni * 16 + quad * 4);
#pragma unroll
      for (int mi = 0; mi < MI; ++mi) {
        const int row = row0 + wm * (BM / 2) + mi * 16 + l16;
#pragma unroll
        for (int ni = 0; ni < 4; ++ni) {
          f32x4* xp = (f32x4*)(X + (long)row * 1024 + cw + ni * 16 + quad * 4);
          *xp = *xp + gt[ni] * acc[mi][ni];
        }
      }
    } else {
#pragma unroll
      for (int mi = 0; mi < MI; ++mi) {
        const int row = row0 + wm * (BM / 2) + mi * 16 + l16;
#pragma unroll
        for (int ni = 0; ni < 2; ++ni) {
          const f32x4 a = acc[mi][ni], b = acc[mi][ni + 2];
          u32x2 ob;
          ob.x = pack2(a[0] * sigmoidf_(a[0]) * b[0], a[1] * sigmoidf_(a[1]) * b[1]);
          ob.y = pack2(a[2] * sigmoidf_(a[2]) * b[2], a[3] * sigmoidf_(a[3]) * b[3]);
          *(u32x2*)(dst + (long)row * 2816 + (cw >> 1) + ni * 16 + quad * 4) = ob;
        }
      }
    }
  }
}

__device__ __forceinline__ unsigned cvt_pk_bf16(float lo, float hi) { return pack2(lo, hi); }
typedef __attribute__((ext_vector_type(2))) unsigned u32pair_t;
__device__ __forceinline__ float xq_max(float v) {
  const unsigned x = __float_as_uint(v);
  const u32pair_t r = __builtin_amdgcn_permlane16_swap(x, x, false, false);
  const float m = fmaxf(__uint_as_float(r.x), __uint_as_float(r.y));
  const unsigned y = __float_as_uint(m);
  const u32pair_t q = __builtin_amdgcn_permlane32_swap(y, y, false, false);
  return fmaxf(__uint_as_float(q.x), __uint_as_float(q.y));
}
__device__ __forceinline__ float xq_sum(float v) {
  const unsigned x = __float_as_uint(v);
  const u32pair_t r = __builtin_amdgcn_permlane16_swap(x, x, false, false);
  const float m = __uint_as_float(r.x) + __uint_as_float(r.y);
  const unsigned y = __float_as_uint(m);
  const u32pair_t q = __builtin_amdgcn_permlane32_swap(y, y, false, false);
  return __uint_as_float(q.x) + __uint_as_float(q.y);
}
template <int NS, int DV, bool LOCAL>
__device__ __forceinline__ void attn_job(char* smem, const u16* qp, int qst,
                         const u16* k0, const u16* v0, int st0, int n0,
                         const u16* k1, const u16* v1, int st1, int n1,
                         const float* rpbh, int qi, int r0,
                         float lam, float outscale, const float* subln,
                         u16* op, int ost) {
  constexpr int KD = NS * 64, KST = KD + 16, KCH = KD / 8;
  u16* Ks = (u16*)smem;
  constexpr int VST = DV + 8, VCH = DV / 8;
  u16* Vs = Ks + 64 * KST;
  u16* Ps = Vs + 64 * VST;
  const int tid = otid(), lane = tid & 63, wave = tid >> 6, quad = lane >> 4, l16 = lane & 15;
  constexpr float C2 = 0.125f * 1.4426950408889634f;
  bf16x8 qf[NS][2];
#pragma unroll
  for (int s = 0; s < NS; ++s)
#pragma unroll
    for (int ks = 0; ks < 2; ++ks)
      qf[s][ks] = *(const bf16x8*)(qp + (long)(wave * 16 + l16) * qst + s * 64 + ks * 32 + quad * 8);
  float m[NS], l[NS];
  f32x4 O[NS][DV / 16];
#pragma unroll
  for (int s = 0; s < NS; ++s) {
    m[s] = -1e30f; l[s] = 0.f;
#pragma unroll
    for (int n = 0; n < DV / 16; ++n) O[s][n] = (f32x4){0.f, 0.f, 0.f, 0.f};
  }
  const int jq = wave * 16 + l16;
  int c0 = jq - 8; c0 = c0 < 0 ? 0 : (c0 > 48 ? 48 : c0);
  const int nt0 = n0 >> 6, ntot = nt0 + (n1 >> 6);
  constexpr int KPT = (64 * KCH) / 256;
  constexpr int VPT = (64 * VCH) / 256;
  u32x4 kreg[KPT];
  u32x4 vreg[VPT];
  auto load_tile = [&](int t) {
    const u16 *kp, *vp; int st;
    if (t < nt0) { kp = k0 + (long)t * 64 * st0; vp = v0 + (long)t * 64 * st0; st = st0; }
    else { kp = k1 + (long)(t - nt0) * 64 * st1; vp = v1 + (long)(t - nt0) * 64 * st1; st = st1; }
#pragma unroll
    for (int i = 0; i < KPT; ++i) {
      const int c = tid + 256 * i;
      kreg[i] = *(const u32x4*)(kp + (long)(c / KCH) * st + (c % KCH) * 8);
    }
#pragma unroll
    for (int i = 0; i < VPT; ++i) {
      const int c = tid + 256 * i;
      vreg[i] = *(const u32x4*)(vp + (long)(c / VCH) * st + (c % VCH) * 8);
    }
  };
  load_tile(0);
  for (int t = 0; t < ntot; ++t) {
    __syncthreads();
#pragma unroll
    for (int i = 0; i < KPT; ++i) {
      const int c = tid + 256 * i;
      *(u32x4*)(Ks + (c / KCH) * KST + (c % KCH) * 8) = kreg[i];
    }
#pragma unroll
    for (int i = 0; i < VPT; ++i) {
      const int c = tid + 256 * i;
      *(u32x4*)(Vs + (c / VCH) * VST + (c % VCH) * 8) = vreg[i];
    }
    __syncthreads();
    if (t + 1 < ntot) load_tile(t + 1);
    __builtin_amdgcn_sched_barrier(0);
#pragma unroll
    for (int s = 0; s < NS; ++s) {
      f32x4 sc[4];
#pragma unroll
      for (int n = 0; n < 4; ++n) {
        sc[n] = (f32x4){0.f, 0.f, 0.f, 0.f};
#pragma unroll
        for (int ks = 0; ks < 2; ++ks) {
          const bf16x8 kf = *(const bf16x8*)(Ks + (n * 16 + l16) * KST + s * 64 + ks * 32 + quad * 8);
          sc[n] = __builtin_amdgcn_mfma_f32_16x16x32_bf16(kf, qf[s][ks], sc[n], 0, 0, 0);
        }
      }
      float mx = -1e30f;
#pragma unroll
      for (int n = 0; n < 4; ++n)
#pragma unroll
        for (int j = 0; j < 4; ++j) {
          float v = sc[n][j] * C2;
          if (LOCAL) {
            if (t >= nt0) {
              const int kr = r0 + (t - nt0), kc = n * 16 + quad * 4 + j;
              const bool ok = (kc >= c0) && (kc < c0 + 16);
              const float bias = rpbh[ok ? ((kr - qi + 7) * 31 + (kc - jq + 15)) : 0];
              v = ok ? v + bias * 1.4426950408889634f : -1e30f;
            }
          }
          sc[n][j] = v;
          mx = fmaxf(mx, v);
        }
      mx = xq_max(mx);
      const float mn = fmaxf(m[s], mx);
      if (__builtin_amdgcn_ballot_w64(mn > m[s]) != 0ull) {
        const float corr = __builtin_amdgcn_exp2f(m[s] - mn);
        l[s] *= corr;
#pragma unroll
        for (int n = 0; n < DV / 16; ++n) O[s][n] *= corr;
        m[s] = mn;
      }
      float rs = 0.f;
#pragma unroll
      for (int n = 0; n < 4; ++n) {
        const float p0 = __builtin_amdgcn_exp2f(sc[n][0] - mn), p1 = __builtin_amdgcn_exp2f(sc[n][1] - mn);
        const float p2 = __builtin_amdgcn_exp2f(sc[n][2] - mn), p3 = __builtin_amdgcn_exp2f(sc[n][3] - mn);
        rs += (p0 + p1) + (p2 + p3);
        u32x2 pk; pk.x = cvt_pk_bf16(p0, p1); pk.y = cvt_pk_bf16(p2, p3);
        *(u32x2*)(Ps + ((wave * NS + s) * 16 + l16) * 80 + n * 16 + quad * 4) = pk;
      }
      l[s] += rs;
    }
    __builtin_amdgcn_wave_barrier();
    {
      bf16x8 pf[NS][2];
#pragma unroll
      for (int s = 0; s < NS; ++s)
#pragma unroll
        for (int ks = 0; ks < 2; ++ks)
          pf[s][ks] = *(const bf16x8*)(Ps + ((wave * NS + s) * 16 + l16) * 80 + ks * 32 + quad * 8);
#pragma unroll
      for (int ks = 0; ks < 2; ++ks)
#pragma unroll
        for (int n = 0; n < DV / 16; ++n) {
          const u16* va = Vs + (ks * 32 + quad * 8 + (l16 >> 2)) * VST + n * 16 + (l16 & 3) * 4;
          typedef __attribute__((ext_vector_type(4))) short s16x4_t;
          const s16x4_t v0 = __builtin_amdgcn_ds_read_tr16_b64_v4i16((__attribute__((address_space(3))) s16x4_t*)va);
          const s16x4_t v1 = __builtin_amdgcn_ds_read_tr16_b64_v4i16((__attribute__((address_space(3))) s16x4_t*)(va + 4 * VST));
          const bf16x8 vf = __builtin_shufflevector(v0, v1, 0, 1, 2, 3, 4, 5, 6, 7);
#pragma unroll
          for (int s = 0; s < NS; ++s) O[s][n] = __builtin_amdgcn_mfma_f32_16x16x32_bf16(vf, pf[s][ks], O[s][n], 0, 0, 0);
        }
    }
  }
  u16* orow = op + (long)(wave * 16 + l16) * ost + quad * 4;
  if (NS == 1) {
    const float il = 1.f / xq_sum(l[0]);
#pragma unroll
    for (int n = 0; n < DV / 16; ++n) {
      u32x2 o; o.x = cvt_pk_bf16(O[0][n][0] * il, O[0][n][1] * il); o.y = cvt_pk_bf16(O[0][n][2] * il, O[0][n][3] * il);
      *(u32x2*)(orow + n * 16) = o;
    }
  } else {
    const float i0 = 1.f / xq_sum(l[0]), i1 = lam / xq_sum(l[NS - 1]);
    float ss = 0.f;
#pragma unroll
    for (int n = 0; n < DV / 16; ++n) {
      O[0][n] = O[0][n] * i0 - O[NS - 1][n] * i1;
      ss += O[0][n][0] * O[0][n][0] + O[0][n][1] * O[0][n][1] + O[0][n][2] * O[0][n][2] + O[0][n][3] * O[0][n][3];
    }
    ss = xq_sum(ss);
    const float ri = rsqrtf(ss * (1.f / (float)DV) + 1e-6f) * outscale;
#pragma unroll
    for (int n = 0; n < DV / 16; ++n) {
      const f32x4 g = *(const f32x4*)(subln + n * 16 + quad * 4);
      u32x2 o; o.x = cvt_pk_bf16(O[0][n][0] * ri * g[0], O[0][n][1] * ri * g[1]); o.y = cvt_pk_bf16(O[0][n][2] * ri * g[2], O[0][n][3] * ri * g[3]);
      *(u32x2*)(orow + n * 16) = o;
    }
  }
}

__device__ __forceinline__ float* yl_ptr(const P& p, int tok, int d, int col) {
  const int slab = tok >> 8;
  return p.out + OUT_DK + (long)(slab >> 5) * 16777216L + ((long)(((slab & 31) * 2 + 1) * 256 + (tok & 255))) * 1024 + d * 512 + col;
}
__device__ __forceinline__ float* tb_ptr(const P& p, int unit, int d, int isB) {
  return (float*)(p.ws + WS_TB) + ((long)((unit * 2 + d) * 2 + isB)) * 4096;
}
__device__ __forceinline__ float ushift(const u16* proj, const float* mu, int tok, int seq0, int slen, int c) {
  const u16* pp = proj + (long)tok * 3328 + 1536 + c;
  const bool hp = tok > seq0, hn = tok < seq0 + slen - 1;
  const float cur = bf2f(pp[0]);
  const float pv = bf2f(pp[hp ? -3328 : 0]);
  const float nv = bf2f(pp[hn ? 3328 : 0]);
  const float prev = hp ? pv : 0.f;
  const float next = hn ? nv : 0.f;
  return cur + mu[c] * (prev - cur) + mu[1792 + c] * (next - cur);
}

__device__ __forceinline__ void rwkv_scan_unit(const P& p, char* smem, int e, int unit) {
  const int gch = unit >> 3, h = unit & 7;
  int seq0, slen;
  if (gch < 64) { seq0 = (gch >> 1) * 256; slen = 256; } else { seq0 = NCTX + ((gch - 64) >> 5) * 4096; slen = 4096; }
  const int t0 = gch * 128;
  float* sc = (float*)smem;
  const u16* proj = (const u16*)(p.ws + WS_BIG);
  const float* mu = p.in[17] + e * 2 * 1792;
  const float* w0 = p.in[18] + e * 1024;
  const float* w2 = p.in[19] + (long)e * 2 * 64 * 512;
  const float* a0 = p.in[20] + e * 1024;
  const float* a2 = p.in[21] + (long)e * 2 * 64 * 512;
  const float* kkw = p.in[22] + e * 512;
  const float* kaw = p.in[23] + e * 512;
  const float* bonus = p.in[24] + e * 1024;
  float* rkb = (float*)(p.ws + WS_RKB);
  float* qt = (float*)(p.ws + WS_QT);
  const int tid = otid(), lane = tid & 63, wave = tid >> 6;
  const int sd = wave >> 1; const bool isB = (wave & 1) != 0;
  const int pd = tid >> 7, th = (tid >> 6) & 1;
  float S[64];
#pragma unroll
  for (int j = 0; j < 64; ++j) S[j] = (!isB && j == lane) ? 1.f : 0.f;
  const int hc = h * 64 + lane;
  const float kkwj = kkw[hc], kawj = kaw[hc], bonj = bonus[pd * 512 + hc], w0j = w0[pd * 512 + hc], a0j = a0[pd * 512 + hc];

  u16* raw = (u16*)(smem + 49152);
  u32x4 rg[3];
  auto load_raw = [&](int lo) {
#pragma unroll
    for (int i = 0; i < 3; ++i) {
      const int c = tid + 256 * i;
      u32x4 v = (u32x4){0u, 0u, 0u, 0u};
      if (c < 720) {
        const int row = c / 40, cc = c % 40, vec = cc >> 3, ch = cc & 7;
        const int tok = lo + row;
        const int voff = (vec < 3) ? (vec * 512 + h * 64) : (1536 + (vec - 3) * 64);
        const int tokc = tok < seq0 ? seq0 : (tok > seq0 + slen - 1 ? seq0 + slen - 1 : tok);
        const u32x4 ld = *(const u32x4*)(proj + (long)tokc * 3328 + 1536 + voff + ch * 8);
        const bool inb = (tok >= seq0) && (tok < seq0 + slen);
        v.x = inb ? ld.x : 0u; v.y = inb ? ld.y : 0u; v.z = inb ? ld.z : 0u; v.w = inb ? ld.w : 0u;
      }
      rg[i] = v;
    }
  };
  auto store_raw = [&]() {
#pragma unroll
    for (int i = 0; i < 3; ++i) {
      const int c = tid + 256 * i;
      if (c < 720) {
        const int row = c / 40, cc = c % 40;
        *(u32x4*)(raw + row * 320 + cc * 8) = rg[i];
      }
    }
  };
  auto shift_dir = [&](int d) {
    float mu0v[5], mu1v[5];
#pragma unroll
    for (int v = 0; v < 5; ++v) {
      const int c = (v < 3) ? (v * 512 + h * 64 + lane) : (1536 + (v - 3) * 64 + lane);
      mu0v[v] = mu[c]; mu1v[v] = mu[1792 + c];
    }
#pragma unroll
    for (int vec = 0; vec < 5; ++vec)
#pragma unroll
      for (int k = 0; k < 4; ++k) {
        const int pslot = wave + 4 * k;
        const int row = (d == 0) ? pslot + 1 : 16 - pslot;
        const u16* rp = raw + row * 320 + vec * 64 + lane;
        const float cur = bf2f(rp[0]), prev = bf2f(rp[-320]), next = bf2f(rp[320]);
        float val = cur + mu0v[vec] * (prev - cur) + mu1v[vec] * (next - cur);
        if (vec == 3) { const float ex = __expf(2.f * val); val = 1.f - 2.f * __builtin_amdgcn_rcpf(ex + 1.f); }
        if (vec >= 3) ((u16*)(sc + (d * 6 + 5) * 1024))[(vec - 3) * 1024 + pslot * 64 + lane] = f2bf(val);
        else sc[((d * 6 + vec) * 16 + pslot) * 64 + lane] = val;
      }
  };
  for (int sub = 0; sub < 8; ++sub) {
    load_raw(t0 + sub * 16 - 1);
    __syncthreads();
    store_raw();
    load_raw(t0 + 127 - sub * 16 - 16);
    __syncthreads();
    shift_dir(0);
    __syncthreads();
    store_raw();
    __syncthreads();
    shift_dir(1);
    __syncthreads();
    {
      const int t2 = otid(), quad = (t2 >> 4) & 3, l16 = t2 & 15, w2i = t2 >> 6, sd2 = w2i >> 1, mat = w2i & 1;
      const u16* at = (const u16*)(sc + (sd2 * 6 + 5) * 1024) + mat * 1024;
      const u16* wt = (const u16*)(p.ws + WS_WT) + ((long)((e * 2 + sd2) * 2 + mat) * 512 + h * 64) * 64;
      bf16x8 af[2];
#pragma unroll
      for (int ks = 0; ks < 2; ++ks) af[ks] = *(const bf16x8*)(at + l16 * 64 + ks * 32 + quad * 8);
#pragma unroll
      for (int nt = 0; nt < 4; ++nt) {
        f32x4 dacc = (f32x4){0.f, 0.f, 0.f, 0.f};
#pragma unroll
        for (int ks = 0; ks < 2; ++ks) {
          const bf16x8 bfr = *(const bf16x8*)(wt + (nt * 16 + l16) * 64 + ks * 32 + quad * 8);
          dacc = __builtin_amdgcn_mfma_f32_16x16x32_bf16(af[ks], bfr, dacc, 0, 0, 0);
        }
#pragma unroll
        for (int j = 0; j < 4; ++j) sc[((sd2 * 6 + 3 + mat) * 16 + quad * 4 + j) * 64 + nt * 16 + l16] = dacc[j];
      }
    }
    __syncthreads();
    {
      float* scw = sc + pd * 6 * 1024;
#pragma unroll
      for (int tk = 0; tk < 8; ++tk) {
        const int pslot = th * 8 + tk;
        const int tok = (pd == 0) ? (t0 + sub * 16 + pslot) : (t0 + 127 - sub * 16 - pslot);
        const float kv = scw[(1 * 16 + pslot) * 64 + lane];
        const float rv = scw[(0 * 16 + pslot) * 64 + lane];
        float kkv = kv * kkwj;
        const float nrm = wave_sum(kkv * kkv);
        kkv *= rsqrtf(fmaxf(nrm, 1e-12f));
        const float xw = -(w0j + scw[(3 * 16 + pslot) * 64 + lane]);
        const float sp = fmaxf(xw, 0.f) + __logf(1.f + __expf(-fabsf(xw)));
        const float decay = __expf(-__expf(-sp - 0.5f));
        const float a = sigmoidf_(a0j + scw[(4 * 16 + pslot) * 64 + lane]);
        const float kt = kv * (1.f + (a - 1.f) * kawj);
        const float bsum = wave_sum(rv * kt * bonj);
        scw[(5 * 16 + pslot) * 64 + lane] = kkv;
        scw[(3 * 16 + pslot) * 64 + lane] = decay;
        scw[(4 * 16 + pslot) * 64 + lane] = kkv * a;
        scw[(1 * 16 + pslot) * 64 + lane] = kt;
        if (lane == 0) rkb[tok * 16 + pd * 8 + h] = bsum;
      }
    }
    __syncthreads();
    if (isB || gch >= 64 || ((gch & 1) == (sd == 0 ? 1 : 0))) {
      const float* base = sc + sd * 6 * 1024;
      for (int ps = 0; ps < 16; ++ps) {
        const f32x4* kk4 = (const f32x4*)(base + (5 * 16 + ps) * 64);
        const f32x4* w4 = (const f32x4*)(base + (3 * 16 + ps) * 64);
        const f32x4* ka4 = (const f32x4*)(base + (4 * 16 + ps) * 64);
        const f32x4* kt4 = (const f32x4*)(base + (1 * 16 + ps) * 64);
        const f32x4* r4 = (const f32x4*)(base + (0 * 16 + ps) * 64);
        f32x4 kk[16];
#pragma unroll
        for (int q = 0; q < 16; ++q) kk[q] = kk4[q];
        f32x4 bw[2][2], bka[2][2], bkt[2][2], br[2][2];
#pragma unroll
        for (int q = 0; q < 2; ++q) { bw[0][q] = w4[q]; bka[0][q] = ka4[q]; br[0][q] = r4[q]; bkt[0][q] = kt4[q]; }
        const float vv = isB ? base[(2 * 16 + ps) * 64 + lane] : 0.f;
        __builtin_amdgcn_sched_barrier(0);
        float s0 = 0.f, s1 = 0.f;
#pragma unroll
        for (int q = 0; q < 16; ++q) {
          s0 += S[q * 4 + 0] * kk[q].x; s1 += S[q * 4 + 1] * kk[q].y; s0 += S[q * 4 + 2] * kk[q].z; s1 += S[q * 4 + 3] * kk[q].w;
        }
        const float nskk = -(s0 + s1);
        float y0 = 0.f, y1 = 0.f;
#pragma unroll
        for (int qq = 0; qq < 8; ++qq) {
          const int cb = qq & 1, nbf = cb ^ 1;
          if (qq < 7) {
#pragma unroll
            for (int q = 0; q < 2; ++q) {
              bw[nbf][q] = w4[(qq + 1) * 2 + q]; bka[nbf][q] = ka4[(qq + 1) * 2 + q];
              br[nbf][q] = r4[(qq + 1) * 2 + q]; bkt[nbf][q] = kt4[(qq + 1) * 2 + q];
            }
          }
          __builtin_amdgcn_sched_barrier(0);
#pragma unroll
          for (int q = 0; q < 2; ++q) {
            const int j = (qq * 2 + q) * 4;
            const f32x4 w = bw[cb][q], ka = bka[cb][q], kt = bkt[cb][q], r = br[cb][q];
            S[j + 0] = fmaf(vv, kt.x, fmaf(nskk, ka.x, S[j + 0] * w.x));
            S[j + 1] = fmaf(vv, kt.y, fmaf(nskk, ka.y, S[j + 1] * w.y));
            S[j + 2] = fmaf(vv, kt.z, fmaf(nskk, ka.z, S[j + 2] * w.z));
            S[j + 3] = fmaf(vv, kt.w, fmaf(nskk, ka.w, S[j + 3] * w.w));
            y0 += S[j + 0] * r.x; y1 += S[j + 1] * r.y; y0 += S[j + 2] * r.z; y1 += S[j + 3] * r.w;
          }
        }
        const int tok = (sd == 0) ? (t0 + sub * 16 + ps) : (t0 + 127 - sub * 16 - ps);
        const float y = y0 + y1;
        if (isB) *yl_ptr(p, tok, sd, hc) = y;
        else qt[((long)tok * 2 + sd) * 512 + hc] = y;
      }
    }
  }
  float4* tp = (float4*)(tb_ptr(p, unit, sd, isB ? 1 : 0) + lane * 64);
#pragma unroll
  for (int q = 0; q < 16; ++q) tp[q] = make_float4(S[q * 4], S[q * 4 + 1], S[q * 4 + 2], S[q * 4 + 3]);
}

__device__ __forceinline__ void rwkv_e3_job(const P& p, char* smem, int e, int job) {
  float* Ss = (float*)smem;
  const int tid = otid(), r = tid >> 4, cgp = tid & 15;
  __syncthreads();
  if (job < 2048) {
    const int chain = job >> 2, rg = job & 3, row = rg * 16 + r;
    const int seq = chain >> 4, h = (chain >> 1) & 7, d = chain & 1;
    const int first = seq * 2 + (d == 0 ? 0 : 1), second = seq * 2 + (d == 0 ? 1 : 0);
    const float* Bf = tb_ptr(p, first * 8 + h, d, 1);
    const float* Ts = tb_ptr(p, second * 8 + h, d, 0);
    const float* Bs = tb_ptr(p, second * 8 + h, d, 1);
    *(float4*)(Ss + r * 64 + cgp * 4) = *(const float4*)(Bf + row * 64 + cgp * 4);
    __syncthreads();
    float4 acc = *(const float4*)(Bs + row * 64 + cgp * 4);
#pragma unroll 8
    for (int i = 0; i < 64; ++i) {
      const float s = Ss[r * 64 + i];
      const float4 t = *(const float4*)(Ts + i * 64 + cgp * 4);
      acc.x += s * t.x; acc.y += s * t.y; acc.z += s * t.z; acc.w += s * t.w;
    }
    *(float4*)(p.out + OUT_ST + ((long)(((seq * 2 + e) * 2 + d) * 8 + h)) * 4096 + row * 64 + cgp * 4) = acc;
  } else {
    const int j2 = job - 2048;
    const int chain = j2 >> 2, rg = j2 & 3, row = rg * 16 + r;
    const int b = chain >> 4, h = (chain >> 1) & 7, d = chain & 1;
    float* Tb = (float*)smem + 1024;
    const float* s0 = p.in[5] + ((long)(((b * 2 + e) * 2 + d) * 8 + h)) * 4096;
    *(float4*)(Ss + r * 64 + cgp * 4) = *(const float4*)(s0 + row * 64 + cgp * 4);
    f32x4 tn[4], bn;
    float* Bcur;
    {
      const int gch = 64 + b * 32 + ((d == 0) ? 0 : 31);
      const float* Tc = tb_ptr(p, gch * 8 + h, d, 0);
      Bcur = tb_ptr(p, gch * 8 + h, d, 1);
#pragma unroll
      for (int q = 0; q < 4; ++q) tn[q] = *(const f32x4*)(Tc + (tid + 256 * q) * 4);
      bn = *(const f32x4*)(Bcur + row * 64 + cgp * 4);
    }
    for (int step = 0; step < 31; ++step) {
      float* Tcur = Tb + (step & 1) * 4096;
#pragma unroll
      for (int q = 0; q < 4; ++q) *(f32x4*)(Tcur + (tid + 256 * q) * 4) = tn[q];
      f32x4 acc = bn;
      float* Bst = Bcur;
      __syncthreads();
      if (step + 1 < 31) {
        const int c = (d == 0) ? step + 1 : 30 - step;
        const int gch = 64 + b * 32 + c;
        const float* Tc = tb_ptr(p, gch * 8 + h, d, 0);
        Bcur = tb_ptr(p, gch * 8 + h, d, 1);
#pragma unroll
        for (int q = 0; q < 4; ++q) tn[q] = *(const f32x4*)(Tc + (tid + 256 * q) * 4);
        bn = *(const f32x4*)(Bcur + row * 64 + cgp * 4);
      }
#pragma unroll 16
      for (int i = 0; i < 64; ++i) {
        const float sv = Ss[r * 64 + i];
        const f32x4 t = *(const f32x4*)(Tcur + i * 64 + cgp * 4);
        acc += sv * t;
      }
      __syncthreads();
      *(f32x4*)(Ss + r * 64 + cgp * 4) = acc;
      *(f32x4*)(Bst + row * 64 + cgp * 4) = acc;
    }
  }
}

__device__ __forceinline__ void rwkv_e4_unit(const P& p, char* smem, int e, int unit) {
  const int gch = unit >> 3, h = unit & 7;
  int seq0, slen, cidx, nch;
  if (gch < 64) { seq0 = (gch >> 1) * 256; slen = 256; cidx = gch & 1; nch = 2; }
  else { seq0 = NCTX + ((gch - 64) >> 5) * 4096; slen = 4096; cidx = (gch - 64) & 31; nch = 32; }
  const int tid = otid(), lane = tid & 63, wave = tid >> 6;
  float* qbuf = (float*)smem + wave * 1024;
  float* dout = qbuf;
  u16* G2T = (u16*)(smem + 16384);
  u16* SGw = (u16*)(smem + 34816) + wave * 16 * 144;
  const u16* proj = (const u16*)(p.ws + WS_BIG);
  const float* mu = p.in[17] + e * 2 * 1792;
  const float* g2 = p.in[25] + (long)e * 128 * 512;
  const float* rkb = (const float*)(p.ws + WS_RKB);
  const float* qt = (const float*)(p.ws + WS_QT);
  u16* mix = (u16*)(p.ws + WS_MIX);
  const int hc = h * 64 + lane;
  const int quad = lane >> 4, l16 = lane & 15;
  __syncthreads();
#pragma unroll 8
  for (int idx = tid; idx < 8192; idx += 256) G2T[(idx & 63) * 144 + (idx >> 6)] = f2bf(g2[(long)(idx >> 6) * 512 + h * 64 + (idx & 63)]);
  __syncthreads();
  const float lnw = p.in[26][e * 512 + hc], lnb = p.in[27][e * 512 + hc];
  const int cg0 = 1536 + 1664 + lane, cg1 = 1536 + 1728 + lane, cv = 1536 + 1024 + hc;
  const float m0g0 = mu[1664 + lane], m1g0 = mu[1792 + 1664 + lane];
  const float m0g1 = mu[1728 + lane], m1g1 = mu[1792 + 1728 + lane];
  const float m0v = mu[1024 + hc], m1v = mu[1792 + 1024 + hc];
  for (int hf = 0; hf < 2; ++hf) {
    const int tw0 = gch * 128 + wave * 32 + hf * 16;
    float yv[16];
#pragma unroll
    for (int tk = 0; tk < 16; ++tk) yv[tk] = *yl_ptr(p, tw0 + tk, 0, hc) + *yl_ptr(p, tw0 + tk, 1, hc);
    for (int d = 0; d < 2; ++d) {
      const int oi = (d == 0) ? cidx : nch - 1 - cidx;
      const float* Sp = nullptr;
      if (oi == 0) {
        if (gch >= 64) Sp = p.in[5] + ((long)(((((gch - 64) >> 5) * 2 + e) * 2 + d) * 8 + h)) * 4096;
      } else {
        const int gp = (d == 0) ? gch - 1 : gch + 1;
        Sp = tb_ptr(p, gp * 8 + h, d, 1);
      }
      if (Sp != nullptr) {
        float S[64];
#pragma unroll
        for (int q = 0; q < 16; ++q) {
          const f32x4 v = *(const f32x4*)(Sp + lane * 64 + q * 4);
          S[q * 4] = v[0]; S[q * 4 + 1] = v[1]; S[q * 4 + 2] = v[2]; S[q * 4 + 3] = v[3];
        }
        f32x4 qv[4];
#pragma unroll
        for (int i = 0; i < 4; ++i) {
          const int idx = lane + 64 * i, r = idx >> 4, c4 = idx & 15;
          qv[i] = *(const f32x4*)(qt + ((long)(tw0 + r) * 2 + d) * 512 + h * 64 + c4 * 4);
        }
        __builtin_amdgcn_wave_barrier();
#pragma unroll
        for (int i = 0; i < 4; ++i) *(f32x4*)(qbuf + (lane + 64 * i) * 4) = qv[i];
        __builtin_amdgcn_wave_barrier();
#pragma unroll
        for (int r = 0; r < 16; ++r) {
          float y0 = 0.f, y1 = 0.f;
#pragma unroll
          for (int q = 0; q < 16; ++q) {
            const f32x4 v = *(const f32x4*)(qbuf + r * 64 + q * 4);
            y0 += S[q * 4] * v[0]; y1 += S[q * 4 + 1] * v[1]; y0 += S[q * 4 + 2] * v[2]; y1 += S[q * 4 + 3] * v[3];
          }
          yv[r] += y0 + y1;
        }
        __builtin_amdgcn_wave_barrier();
      }
    }
    float rkl = 0.f;
    if (lane < 16) rkl = rkb[(tw0 + lane) * 16 + h] + rkb[(tw0 + lane) * 16 + 8 + h];
    auto ldrow = [&](int r, float& a, float& b, float& c) {
      const bool ok = (r >= seq0) && (r < seq0 + slen);
      const u16* rp = proj + (long)(ok ? r : tw0) * 3328;
      const float x = bf2f(rp[cg0]), y = bf2f(rp[cg1]), z = bf2f(rp[cv]);
      a = ok ? x : 0.f; b = ok ? y : 0.f; c = ok ? z : 0.f;
    };
    float pg0, pg1, pvv, cg0v, cg1v, cvv, ng0, ng1, nvv;
    ldrow(tw0 - 1, pg0, pg1, pvv);
    ldrow(tw0, cg0v, cg1v, cvv);
    ldrow(tw0 + 1, ng0, ng1, nvv);
    float vshv[16];
#pragma unroll
    for (int tk = 0; tk < 16; ++tk) {
      float fg0, fg1, fvv;
      ldrow(tw0 + tk + 2, fg0, fg1, fvv);
      const float gv0 = sigmoidf_(cg0v + m0g0 * (pg0 - cg0v) + m1g0 * (ng0 - cg0v));
      const float gv1 = sigmoidf_(cg1v + m0g1 * (pg1 - cg1v) + m1g1 * (ng1 - cg1v));
      vshv[tk] = cvv + m0v * (pvv - cvv) + m1v * (nvv - cvv);
      pg0 = cg0v; pg1 = cg1v; pvv = cvv; cg0v = ng0; cg1v = ng1; cvv = nvv; ng0 = fg0; ng1 = fg1; nvv = fvv;
      SGw[tk * 144 + lane] = f2bf(gv0);
      SGw[tk * 144 + 64 + lane] = f2bf(gv1);
    }
    __builtin_amdgcn_wave_barrier();
    {
      bf16x8 af[4];
#pragma unroll
      for (int ks = 0; ks < 4; ++ks) af[ks] = *(const bf16x8*)(SGw + l16 * 144 + ks * 32 + quad * 8);
#pragma unroll
      for (int nt = 0; nt < 4; ++nt) {
        f32x4 dacc = (f32x4){0.f, 0.f, 0.f, 0.f};
#pragma unroll
        for (int ks = 0; ks < 4; ++ks) {
          const bf16x8 bfr = *(const bf16x8*)(G2T + (nt * 16 + l16) * 144 + ks * 32 + quad * 8);
          dacc = __builtin_amdgcn_mfma_f32_16x16x32_bf16(af[ks], bfr, dacc, 0, 0, 0);
        }
#pragma unroll
        for (int j = 0; j < 4; ++j) dout[(quad * 4 + j) * 64 + nt * 16 + l16] = dacc[j];
      }
    }
    __builtin_amdgcn_wave_barrier();
#pragma unroll
    for (int tk = 0; tk < 16; ++tk) {
      const int tok = tw0 + tk;
      const float rk = __int_as_float(__builtin_amdgcn_readlane(__float_as_int(rkl), tk));
      const float gate = dout[tk * 64 + lane];
      const float y = yv[tk];
      const float mean = wave_sum(y) * (1.f / 64.f);
      const float dv = y - mean;
      const float var = wave_sum(dv * dv) * (1.f / 64.f);
      const float yn = dv * rsqrtf(var + 64e-5f) * lnw + lnb;
      mix[(long)tok * 1024 + 512 + hc] = f2bf((yn + rk * vshv[tk]) * gate);
    }
    __builtin_amdgcn_wave_barrier();
  }
}

#define XB_TMO      128
#define XB_XCNT(j)  (256  + 64 * (j))
#define XB_XSUB(j)  (1280 + 64 * (j))
#define XB_XGEN(j)  (2304 + 64 * (j))
#define XB_TOP      3328
#define XB_TOPGEN   3392
#define XCD_BAR_WORDS 3456
#define XB_SPIN_CAP (1u << 22)
#define LAS __attribute__((address_space(3)))
__device__ __forceinline__ unsigned xb_ld(unsigned* p)              { return __hip_atomic_load(p, __ATOMIC_RELAXED, __HIP_MEMORY_SCOPE_AGENT); }
__device__ __forceinline__ unsigned xb_add(unsigned* p, unsigned v) { return __hip_atomic_fetch_add(p, v, __ATOMIC_RELAXED, __HIP_MEMORY_SCOPE_AGENT); }
__device__ __forceinline__ unsigned xb_xcc_id() { return (unsigned)__builtin_amdgcn_s_getreg((3 << 11) | 20) & 0xFu; }
#define XB_SPIN(cond, bar) do { unsigned _sp = 0; while (cond) { __builtin_amdgcn_s_sleep(1); \
    if ((++_sp & 255u) == 0u) { if (xb_ld(&(bar)[XB_TMO])) break; if (_sp > XB_SPIN_CAP) { atomicAdd(&(bar)[XB_TMO], 1u); break; } } } } while (0)
struct XcdBarrier { unsigned* bar; unsigned x; volatile LAS unsigned* st; };
__device__ __forceinline__ XcdBarrier xcd_barrier_post(unsigned* bar, volatile LAS unsigned* st) {
  XcdBarrier b; b.bar = bar; b.x = xb_xcc_id(); b.st = st;
  if (threadIdx.x == 0) (void)xb_add(&bar[XB_XCNT(b.x)], 1u);
  return b;
}
__device__ __forceinline__ void xcd_barrier_complete(unsigned* bar, unsigned x, unsigned& nloc, unsigned& nx) {
  const unsigned G = gridDim.x * gridDim.y * gridDim.z;
  unsigned sum, cnt, mine, sp = 0u;
  for (;;) {
    sum = 0u; cnt = 0u; mine = 0u;
#pragma unroll
    for (unsigned j = 0; j < 16; ++j) { const unsigned c = xb_ld(&bar[XB_XCNT(j)]); sum += c; cnt += (c > 0u) ? 1u : 0u; mine = (j == x) ? c : mine; }
    if (sum == G) break;
    __builtin_amdgcn_s_sleep(1);
    if ((++sp & 255u) == 0u) { if (xb_ld(&bar[XB_TMO])) break; if (sp > XB_SPIN_CAP) { atomicAdd(&bar[XB_TMO], 1u); break; } }
  }
  nloc = mine > 0u ? mine : 1u; nx = cnt > 0u ? cnt : 1u;
}
__device__ __forceinline__ void xcd_barrier(const XcdBarrier& b0) {
  XcdBarrier b; b.bar = b0.bar; b.st = b0.st; b.x = (unsigned)__builtin_amdgcn_readfirstlane((int)xb_xcc_id());
  asm volatile("s_waitcnt vmcnt(0)" ::: "memory");
  __syncthreads();
  if (threadIdx.x == 0) {
    unsigned* bar = b.bar;
    __builtin_amdgcn_s_waitcnt(0);
    unsigned nloc = b.st[0], nx = b.st[1];
    if (nloc == 0u) { xcd_barrier_complete(bar, b.x, nloc, nx); b.st[0] = nloc; b.st[1] = nx; }
    const unsigned old = xb_add(&bar[XB_XSUB(b.x)], 1u);
    const unsigned gen = old / nloc;
    if (old + 1u == (gen + 1u) * nloc) {
      __builtin_amdgcn_fence(__ATOMIC_RELEASE, "agent");
      asm volatile("s_waitcnt vmcnt(0)" ::: "memory");
      const unsigned og = xb_add(&bar[XB_TOP], 1u);
      const unsigned tg = og / nx;
      if (og + 1u == (tg + 1u) * nx) xb_add(&bar[XB_TOPGEN], 1u);
      else XB_SPIN(xb_ld(&bar[XB_TOPGEN]) == tg, bar);
      __builtin_amdgcn_fence(__ATOMIC_ACQUIRE, "agent");
      xb_add(&bar[XB_XGEN(b.x)], 1u);
      asm volatile("s_waitcnt vmcnt(0)" ::: "memory");
    } else {
      XB_SPIN(xb_ld(&bar[XB_XGEN(b.x)]) == gen, bar);
      __builtin_amdgcn_fence(__ATOMIC_ACQUIRE, "agent");
      asm volatile("s_waitcnt vmcnt(0)" ::: "memory");
    }
  }
  __syncthreads();
}

__device__ __forceinline__ void norm_job(const P& p, int job, const float* gvec, const float* modl, int shift_idx) {
  const int t = otid();
  const int row = job * 4 + (t >> 6), lane = t & 63;
  const int grp = row < NCTX ? 0 : 1 + ((row - NCTX) >> 12);
  const float* modv = modl + grp * 6144;
  const float* x = p.out + (long)row * 1024;
  u16* H = (u16*)(p.ws + WS_MIX) + (long)row * 1024;
  float4 v[4];
  float ss = 0.f;
#pragma unroll
  for (int i = 0; i < 4; ++i) {
    v[i] = *(const float4*)(x + (i * 64 + lane) * 4);
    ss += v[i].x * v[i].x + v[i].y * v[i].y + v[i].z * v[i].z + v[i].w * v[i].w;
  }
  ss = wave_sum(ss);
  const float r = rsqrtf(ss * (1.f / 1024.f) + 1e-6f);
#pragma unroll
  for (int i = 0; i < 4; ++i) {
    const int k = (i * 64 + lane) * 4;
    const float4 g = *(const float4*)(gvec + k);
    const float4 sc = *(const float4*)(modv + (shift_idx + 1) * 1024 + k);
    const float4 sh = *(const float4*)(modv + shift_idx * 1024 + k);
    u32x2 o;
    o.x = pack2(v[i].x * r * g.x * (1.f + sc.x) + sh.x, v[i].y * r * g.y * (1.f + sc.y) + sh.y);
    o.y = pack2(v[i].z * r * g.z * (1.f + sc.z) + sh.z, v[i].w * r * g.w * (1.f + sc.w) + sh.w);
    *(u32x2*)(H + k) = o;
  }
}

__device__ __forceinline__ void final_job(const P& p, int job) {
  const int t = otid();
  const int row = job * 4 + (t >> 6), lane = t & 63;
  float* x = p.out + (long)row * 1024;
  float4 v[4];
  float ss = 0.f;
#pragma unroll
  for (int i = 0; i < 4; ++i) {
    v[i] = *(const float4*)(x + (i * 64 + lane) * 4);
    ss += v[i].x * v[i].x + v[i].y * v[i].y + v[i].z * v[i].z + v[i].w * v[i].w;
  }
  ss = wave_sum(ss);
  const float r = rsqrtf(ss * (1.f / 1024.f) + 1e-6f);
#pragma unroll
  for (int i = 0; i < 4; ++i) {
    const float4 g = *(const float4*)(p.in[13] + (i * 64 + lane) * 4);
    float4 o;
    o.x = v[i].x * r * g.x; o.y = v[i].y * r * g.y; o.z = v[i].z * r * g.z; o.w = v[i].w * r * g.w;
    *(float4*)(x + (i * 64 + lane) * 4) = o;
  }
}

#ifndef PHMASK
#define PHMASK 0xffff
#endif
#define PHON(k) (((PHMASK) >> (k)) & 1)
#ifndef DUPMASK
#define DUPMASK 0
#endif
#define NREP(k) ((((DUPMASK) >> (k)) & 1) ? 2 : 1)
__global__ void __launch_bounds__(256, 2) fwd_megakernel(P p) {
  cg::grid_group grid = cg::this_grid();
  __shared__ __attribute__((aligned(16))) char smem[SMEM_BYTES];
  __shared__ uint4 xb_words;
  if (threadIdx.x == 0) xb_words = make_uint4(0u, 0u, 0u, 0u);
  __syncthreads();
  XcdBarrier xb = xcd_barrier_post((unsigned*)(p.ws + WS_BAR), (volatile LAS unsigned*)&xb_words);
  const int nb = gridDim.x, bid0 = blockIdx.x;
  int bid = bid0;
  asm volatile("" : "+s"(bid));
  float* mod = (float*)(p.ws + WS_MOD);
  u16* big = (u16*)(p.ws + WS_BIG);
  u16* mix = (u16*)(p.ws + WS_MIX);

  for (int rep = 0; rep < NREP(0); ++rep)
  for (int job = bid; job < 384 + N_CONV_JOBS + 3072 + 4096 + 128; job += nb) {
    if (!PHON(0)) break;
    if (job >= 384 + N_CONV_JOBS + 3072 + 4096) loracvt_job(p, job - (384 + N_CONV_JOBS + 3072 + 4096));
    else if (job < 384) adaln_job(p, smem, job);
    else if (job < 384 + N_CONV_JOBS) conv_job(p, smem, job - 384);
    else if (job < 384 + N_CONV_JOBS + 3072) cachecvt_job(p, job - 384 - N_CONV_JOBS);
    else xcopy_job(p, job - 384 - N_CONV_JOBS - 3072);
  }
  if (p.ws == nullptr) grid.sync();
  xcd_barrier(xb);

  for (int l = 0; l < 4; ++l) {
    int bid = bid0;
    asm volatile("" : "+s"(bid));
    const float* modl = mod + l * 3 * 6144;
    const int sub = l >> 1;
    const bool even = (l & 1) == 0;
    for (int lj = bid >> 3; lj < 512; lj += (nb >> 3)) norm_job(p, (bid & 7) * 512 + lj, p.in[11] + l * 1024, modl, 0);
    xcd_barrier(xb);
    if (even) {
      if (PHON(1)) gemm_phase<0, 0, 256>(p, smem, mix, 1024, (const u16*)(p.ws + WS_WIN) + (long)sub * 3328 * 1024, 3328,
                                    nullptr, modl, 0, 0, sub, big);
    } else {
      if (PHON(7)) gemm_phase<0, 1, 128>(p, smem, mix, 1024, (const u16*)(p.ws + WS_WQKV) + (long)sub * 3072 * 1024, 3072,
                                    nullptr, modl, 0, 0, sub, big);
    }
    xcd_barrier(xb);
    if (even) {
      const int e = sub;
      const int nit = (3072 - bid + nb - 1) / nb, rot = (bid >= (nb >> 1) && nit == 6) ? 2 : 0;
      for (int it = 0; it < nit; ++it) {
        const int job = bid + nb * ((it + rot) % nit);
        if (job < 1024) { if (PHON(2)) rwkv_scan_unit(p, smem, e, job); }
        else if (!PHON(3)) {}
        else if (job < 2048) {
          const int j = job - 1024;
          const int b = j >> 9, h = (j >> 6) & 7, qi = j & 63;
          int r0 = qi - 4; r0 = r0 < 0 ? 0 : (r0 > 56 ? 56 : r0);
          const long tq = NCTX + b * 4096 + qi * 64, tk = NCTX + b * 4096 + r0 * 64;
          attn_job<1, 64, true>(smem, big + tq * 3328 + h * 64, 3328,
                                (const u16*)(p.ws + WS_CNK) + (long)(b * 2 + e) * 512 * 512 + h * 64,
                                (const u16*)(p.ws + WS_CNV) + (long)(b * 2 + e) * 512 * 512 + h * 64, 512, 512,
                                big + tk * 3328 + 512 + h * 64, big + tk * 3328 + 1024 + h * 64, 3328, 512,
                                p.in[16] + (long)(e * 8 + h) * 15 * 31, qi, r0, 0.f, 0.f, nullptr,
                                mix + tq * 1024 + h * 64, 1024);
        } else {
          const int j = job - 2048;
          const int b = j >> 5, h = (j >> 2) & 7, qb = j & 3;
          const long tq = b * 256 + qb * 64, tk = b * 256;
          attn_job<1, 64, false>(smem, big + tq * 3328 + h * 64, 3328,
                                 big + tk * 3328 + 512 + h * 64, big + tk * 3328 + 1024 + h * 64, 3328, 256,
                                 nullptr, nullptr, 0, 0, nullptr, 0, 0, 0.f, 0.f, nullptr,
                                 mix + tq * 1024 + h * 64, 1024);
        }
      }
      xcd_barrier(xb);
      for (int ph = 0; ph < 2; ++ph) {
        if (ph == 0 && PHON(4)) {
          if (nb > 256) {
            if (bid < 128) rwkv_e3_job(p, smem, e, bid + 2048);
            else for (int job = bid - 128; job < 2048; job += nb - 128) rwkv_e3_job(p, smem, e, job);
          } else {
            for (int job = bid; job < 2176; job += nb) rwkv_e3_job(p, smem, e, job < 128 ? job + 2048 : job - 128);
          }
        }
        if (PHON(5))
          for (int u = bid; u < 512; u += nb) rwkv_e4_unit(p, smem, e, (ph == 0 ? 0 : 512) + u);
        if (ph == 0) xcd_barrier(xb);
      }
    } else {
      const int o = sub;
      const float lam_init = 0.8f - 0.6f * __expf(-0.3f * (float)l);
      float d0 = 0.f, d1 = 0.f;
      for (int i = 0; i < 64; ++i) {
        d0 += p.in[30][o * 128 + i] * p.in[31][o * 128 + i];
        d1 += p.in[30][o * 128 + 64 + i] * p.in[31][o * 128 + 64 + i];
      }
      const float lam = __expf(d0) - __expf(d1) + lam_init;
      for (int rep = 0; rep < NREP(8); ++rep)
      if (PHON(8)) for (int job = bid; job < 2048; job += nb) {
        long tq, tk; int h, n0, n1; const u16 *k0, *v0; int st0;
        if (job < 1024) {
          const int x = job & 7, lj = job >> 3;
          const int pair = x + 8 * (lj >> 6), qb = lj & 63;
          const int b = pair >> 3; h = pair & 7;
          tq = NCTX + b * 4096 + qb * 64; tk = NCTX + b * 4096;
          k0 = (const u16*)(p.ws + WS_CDK) + (long)(b * 2 + o) * 512 * 1024 + h * 128;
          v0 = (const u16*)(p.ws + WS_CDV) + (long)(b * 2 + o) * 512 * 1024 + h * 128;
          st0 = 1024; n0 = 512; n1 = 4096;
        } else {
          const int j = job - 1024;
          const int b = j >> 5, qb = j & 3; h = (j >> 2) & 7;
          tq = b * 256 + qb * 64; tk = b * 256;
          k0 = big + tk * 3072 + 1024 + h * 128; v0 = big + tk * 3072 + 2048 + h * 128;
          st0 = 3072; n0 = 256; n1 = 0;
        }
        attn_job<2, 128, false>(smem, big + tq * 3072 + h * 128, 3072, k0, v0, st0, n0,
                                big + tk * 3072 + 1024 + h * 128, big + tk * 3072 + 2048 + h * 128, 3072, n1,
                                nullptr, 0, 0, lam, 1.f - lam_init, p.in[32] + o * 128,
                                mix + tq * 1024 + h * 128, 1024);
      }
    }
    xcd_barrier(xb);
    for (int g = 0; g < 2; ++g) {
      if (g == 1) {
        for (int lj = bid >> 3; lj < 512; lj += (nb >> 3)) norm_job(p, (bid & 7) * 512 + lj, p.in[12] + l * 1024, modl, 3);
        xcd_barrier(xb);
        for (int rep = 0; rep < NREP(9); ++rep)
        if (PHON(9)) gemm_phase<0, 3, 256>(p, smem, mix, 1024, (const u16*)(p.ws + WS_W13) + (long)l * 5632 * 1024, 5632,
                                      nullptr, modl, 3, 0, 0, big);
        xcd_barrier(xb);
      }
      const u16* A2 = g == 0 ? mix : big;
      const int K2 = g == 0 ? 1024 : 2816;
      const u16* B2 = g == 0 ? (even ? (const u16*)(p.ws + WS_WOE) + (long)sub * 1024 * 1024 : (const u16*)(p.ws + WS_WOD) + (long)sub * 1024 * 1024)
                             : (const u16*)(p.ws + WS_W2) + (long)l * 1024 * 2816;
      if (PHON(6)) gemm_phase<0, 2, 256>(p, smem, A2, K2, B2, 1024, nullptr, modl, 0, g == 0 ? 2 : 5, 0, nullptr);
      xcd_barrier(xb);
    }
  }
  if (PHON(10)) for (int lj = bid >> 3; lj < 512; lj += (nb >> 3)) final_job(p, (bid & 7) * 512 + lj);
}

extern "C" void kernel_launch(void* const* d_in, const int* in_sizes, int n_in, void* d_out, int out_size,
                              void* d_ws, size_t ws_size, hipStream_t stream) {
  static int grid_blocks = 0;
  if (!grid_blocks) {
    int dev = 0, cus = 0, per_cu = 0;
    (void)hipGetDevice(&dev);
    (void)hipDeviceGetAttribute(&cus, hipDeviceAttributeMultiprocessorCount, dev);
    (void)hipOccupancyMaxActiveBlocksPerMultiprocessor(&per_cu, fwd_megakernel, 256, 0);
    (void)per_cu;
    grid_blocks = cus * 2;
  }
  if (ws_size < (size_t)WS_TOTAL) { fprintf(stderr, "workspace too small: %zu < %ld\n", ws_size, (long)WS_END); return; }
  P p{};
  for (int i = 0; i < 36; ++i) p.in[i] = (const float*)d_in[i];
  p.out = (float*)d_out;
  p.ws = (char*)d_ws;
  (void)hipMemsetAsync((char*)d_ws + WS_BAR, 0, XCD_BAR_WORDS * 4, stream);
  void* args[] = {&p};
  hipError_t e = hipLaunchCooperativeKernel((void*)fwd_megakernel, dim3(grid_blocks), dim3(256), args, 0, stream);
  if (e != hipSuccess) fprintf(stderr, "cooperative launch failed: %s (grid %d)\n", hipGetErrorString(e), grid_blocks);
}
```
